# Optimizing an MI355X kernel written in HIP

```python
import jax, jax.numpy as jnp
from jax import lax
import numpy as np

D_MODEL = 1024
BATCH = 2
SEQ = 16384
DEPTH = 1

DA_GROUPS = ((128, 1), (512, 4), (2048, 16))
DA_HEADS = 4
DA_HEAD_DIM = 128
DA_WIDTH = DA_HEADS * DA_HEAD_DIM
DA_BLOCK = 128
GLA_HEADS = 4
GLA_KEY_DIM = D_MODEL // 2
GLA_VALUE_DIM = D_MODEL
GLA_DK = GLA_KEY_DIM // GLA_HEADS
GLA_DV = GLA_VALUE_DIM // GLA_HEADS
GLA_GATE_RANK = 16
GLA_GATE_NORMALIZER = 16.0
GLA_CHUNK = 64
N_EXPERTS = 32
TOP_K = 4
D_FF = D_MODEL
SWIGLU_ALPHA = 1.702
SWIGLU_LIMIT = 7.0
MOE_BLOCK = 128
RMS_EPS = 1e-5
NEG_INF = -1e30
IN_SPLITS = (3 * len(DA_GROUPS) * DA_WIDTH, GLA_KEY_DIM, GLA_KEY_DIM, GLA_VALUE_DIM,
             GLA_VALUE_DIM, GLA_GATE_RANK, 2 * D_MODEL)
IN_WIDTH = sum(IN_SPLITS)
IN_OFFSETS = tuple(sum(IN_SPLITS[:i + 1]) for i in range(len(IN_SPLITS) - 1))

kernel_name = "hybrid_dilated_gla_moe_block"


def rms_norm(x, w):
    x32 = x.astype(jnp.float32)
    y = x32 * lax.rsqrt(jnp.mean(x32 * x32, axis=-1, keepdims=True) + RMS_EPS)
    return (y * w.astype(jnp.float32)).astype(x.dtype)


def dilated_window_attention(q, k, v, window, dilation):
    bsz, seq, n_h, e = q.shape
    steps = window // dilation
    span = dilation * DA_BLOCK
    s_pad = -(-seq // span) * span
    sub_len = s_pad // dilation
    n_blk = sub_len // DA_BLOCK

    def to_blocks(t):
        t = jnp.pad(t, ((0, 0), (0, s_pad - seq), (0, 0), (0, 0)))
        t = t.reshape(bsz, sub_len, dilation, n_h, e).transpose(0, 2, 3, 1, 4)
        return t.reshape(bsz, dilation, n_h, n_blk, DA_BLOCK, e).astype(jnp.float32)

    def with_prev(t):
        prev = jnp.pad(t, ((0, 0), (0, 0), (0, 0), (1, 0), (0, 0), (0, 0)))[:, :, :, :-1]
        return jnp.concatenate([prev, t], axis=4)

    qb = to_blocks(q)
    kb = with_prev(to_blocks(k))
    vb = with_prev(to_blocks(v))
    s = jnp.einsum('bdhnqe,bdhnke->bdhnqk', qb, kb) * (e ** -0.5)
    qi = jnp.arange(DA_BLOCK)[:, None]
    kj = jnp.arange(2 * DA_BLOCK)[None, :]
    dist = qi + DA_BLOCK - kj
    band = (dist >= 0) & (dist <= steps)
    has_prev = (jnp.arange(n_blk)[:, None, None] > 0) | (kj >= DA_BLOCK)[None]
    mask = band[None] & has_prev
    s = jnp.where(mask, s, NEG_INF)
    m = jnp.max(s, axis=-1, keepdims=True)
    p = jnp.exp(s - m)
    l = jnp.sum(p, axis=-1, keepdims=True)
    o = jnp.einsum('bdhnqk,bdhnke->bdhnqe', p, vb) / l
    lse = (m + jnp.log(l))[..., 0]
    o = o.reshape(bsz, dilation, n_h, sub_len, e).transpose(0, 3, 1, 2, 4)
    o = o.reshape(bsz, s_pad, n_h, e)[:, :seq]
    lse = lse.reshape(bsz, dilation, n_h, sub_len).transpose(0, 3, 1, 2)
    lse = lse.reshape(bsz, s_pad, n_h)[:, :seq]
    return o, lse


def dilated_mixer(a_qkv):
    bsz, seq, _ = a_qkv.shape
    a = a_qkv.reshape(bsz, seq, len(DA_GROUPS), 3, DA_HEADS, DA_HEAD_DIM)
    outs, lses = [], []
    for gi, (window, dilation) in enumerate(DA_GROUPS):
        o, lse = dilated_window_attention(a[:, :, gi, 0], a[:, :, gi, 1], a[:, :, gi, 2],
                                          window, dilation)
        outs.append(o)
        lses.append(lse)
    w = jax.nn.softmax(jnp.stack(lses, axis=0), axis=0)
    o = jnp.sum(w[..., None] * jnp.stack(outs, axis=0), axis=0)
    return o.reshape(bsz, seq, DA_WIDTH).astype(a_qkv.dtype)


def gla_chunked(q, k, v, g):
    bsz, n_h, seq, dk = q.shape
    dv = v.shape[-1]
    c = GLA_CHUNK
    n_c = seq // c
    q, k, g = (t.reshape(bsz, n_h, n_c, c, dk) for t in (q, k, g))
    v = v.reshape(bsz, n_h, n_c, c, dv)
    b = jnp.cumsum(g, axis=3)
    b_last = b[:, :, :, -1:, :]
    q_e = q * jnp.exp(b)
    k_e = k * jnp.exp(-b)
    k_to_end = k * jnp.exp(b_last - b)
    causal = jnp.tril(jnp.ones((c, c), dtype=bool))
    att = jnp.where(causal, jnp.einsum('bhncd,bhnsd->bhncs', q_e, k_e), 0.0)
    o_intra = jnp.einsum('bhncs,bhnse->bhnce', att, v)
    decay = jnp.exp(b_last[:, :, :, 0, :])

    def step(state, inp):
        qc, kc, vc, dc = inp
        o = jnp.einsum('bhcd,bhde->bhce', qc, state)
        state = dc[..., None] * state + jnp.einsum('bhcd,bhce->bhde', kc, vc)
        return state, o

    xs = (jnp.moveaxis(q_e, 2, 0), jnp.moveaxis(k_to_end, 2, 0),
          jnp.moveaxis(v, 2, 0), jnp.moveaxis(decay, 2, 0))
    _, o_inter = lax.scan(step, jnp.zeros((bsz, n_h, dk, dv), jnp.float32), xs)
    o = o_intra + jnp.moveaxis(o_inter, 0, 2)
    return o.reshape(bsz, n_h, seq, dv)


def gla_mixer(gq, gk, gv, gog, glr, w_gk2, b_gk2, norm_w):
    bsz, seq, _ = gq.shape
    forget = jax.nn.log_sigmoid((glr @ w_gk2 + b_gk2).astype(jnp.float32)) / GLA_GATE_NORMALIZER

    def heads(t, d):
        return t.reshape(bsz, seq, GLA_HEADS, d).transpose(0, 2, 1, 3).astype(jnp.float32)

    o = gla_chunked(heads(gq, GLA_DK) * (GLA_DK ** -0.5), heads(gk, GLA_DK),
                    heads(gv, GLA_DV), heads(forget, GLA_DK))
    o = o.transpose(0, 2, 1, 3)
    o = o * lax.rsqrt(jnp.mean(o * o, axis=-1, keepdims=True) + RMS_EPS) * norm_w.astype(jnp.float32)
    o = o.reshape(bsz, seq, GLA_VALUE_DIM) * jax.nn.silu(gog.astype(jnp.float32))
    return o.astype(gq.dtype)


def moe_ffn(h, w_router, b_router, w_up, b_up, w_down, b_down):
    bsz, seq, d = h.shape
    n_tok = bsz * seq
    n_asg = n_tok * TOP_K
    xt = h.reshape(n_tok, d)
    logits = (xt @ w_router + b_router).astype(jnp.float32)
    top_val, top_idx = lax.top_k(logits, TOP_K)
    gate = jax.nn.softmax(top_val, axis=-1)
    e_flat = top_idx.reshape(-1)
    g_flat = gate.reshape(-1)
    order = jnp.argsort(e_flat)
    e_sorted = e_flat[order]
    tok_sorted = order // TOP_K
    counts = jnp.bincount(e_flat, length=N_EXPERTS)
    padded = (counts + MOE_BLOCK - 1) // MOE_BLOCK * MOE_BLOCK
    pad_end = jnp.cumsum(padded)
    pad_start = pad_end - padded
    start = jnp.cumsum(counts) - counts
    dest = pad_start[e_sorted] + (jnp.arange(n_asg) - start[e_sorted])
    n_rows = (n_asg + N_EXPERTS * (MOE_BLOCK - 1) + MOE_BLOCK - 1) // MOE_BLOCK * MOE_BLOCK
    n_blocks = n_rows // MOE_BLOCK
    row_tok = jnp.zeros((n_rows,), jnp.int32).at[dest].set(tok_sorted.astype(jnp.int32))
    row_w = jnp.zeros((n_rows,), jnp.float32).at[dest].set(g_flat[order])
    block_e = jnp.minimum(jnp.searchsorted(pad_end, jnp.arange(n_blocks) * MOE_BLOCK, side='right'),
                          N_EXPERTS - 1)
    xin = xt[row_tok].reshape(n_blocks, MOE_BLOCK, d)

    def expert_block(args):
        xb, e = args
        hu = xb @ w_up[e] + b_up[e]
        x_glu = jnp.minimum(hu[:, :D_FF], SWIGLU_LIMIT)
        x_lin = jnp.clip(hu[:, D_FF:], -SWIGLU_LIMIT, SWIGLU_LIMIT)
        act = x_glu * jax.nn.sigmoid(SWIGLU_ALPHA * x_glu) * (x_lin + 1.0)
        return act @ w_down[e] + b_down[e]

    yb = lax.map(expert_block, (xin, block_e)).reshape(n_rows, d)
    y = jnp.zeros((n_tok, d), h.dtype).at[row_tok].add(yb * row_w[:, None].astype(h.dtype))
    return y.reshape(bsz, seq, d)


def hybrid_layer(h, ln1_w, w_in, w_gk2, b_gk2, gla_norm_w, w_proj_a, w_proj_b, w_out,
                 ln2_w, w_router, b_router, w_up, b_up, w_down, b_down):
    xn = rms_norm(h, ln1_w)
    proj = xn @ w_in
    a_qkv, gq, gk, gv, gog, glr, merge = jnp.split(proj, list(IN_OFFSETS), axis=-1)
    o_a = dilated_mixer(a_qkv)
    o_b = gla_mixer(gq, gk, gv, gog, glr, w_gk2, b_gk2, gla_norm_w)
    gate_a, gate_b = jnp.split(jax.nn.sigmoid(merge), 2, axis=-1)
    mixed = gate_a * (o_a @ w_proj_a) + gate_b * (o_b @ w_proj_b)
    h = h + mixed @ w_out
    h = h + moe_ffn(rms_norm(h, ln2_w), w_router, b_router, w_up, b_up, w_down, b_down)
    return h


def setup_inputs(seed: int = 0) -> dict:
    key = jax.random.key(seed)
    ks = jax.random.split(key, 17)
    f32 = jnp.float32

    def nrm(k, shape, fan_in):
        return jax.random.normal(k, shape, f32) * (fan_in ** -0.5)

    def gain(k, shape):
        return 1.0 + 0.02 * jax.random.normal(k, shape, f32)

    def small(k, shape, scale):
        return scale * jax.random.normal(k, shape, f32)

    return {
        'x': jax.random.normal(ks[0], (BATCH, SEQ, D_MODEL), f32),
        'ln1_w': gain(ks[1], (DEPTH, D_MODEL)),
        'w_in': nrm(ks[2], (DEPTH, D_MODEL, IN_WIDTH), D_MODEL),
        'w_gk2': nrm(ks[3], (DEPTH, GLA_GATE_RANK, GLA_KEY_DIM), GLA_GATE_RANK),
        'b_gk2': small(ks[4], (DEPTH, GLA_KEY_DIM), 0.1),
        'gla_norm_w': gain(ks[5], (DEPTH, GLA_DV)),
        'w_proj_a': nrm(ks[6], (DEPTH, DA_WIDTH, D_MODEL), DA_WIDTH),
        'w_proj_b': nrm(ks[7], (DEPTH, GLA_VALUE_DIM, D_MODEL), GLA_VALUE_DIM),
        'w_out': nrm(ks[8], (DEPTH, D_MODEL, D_MODEL), D_MODEL),
        'ln2_w': gain(ks[9], (DEPTH, D_MODEL)),
        'w_router': nrm(ks[10], (DEPTH, D_MODEL, N_EXPERTS), D_MODEL),
        'b_router': small(ks[11], (DEPTH, N_EXPERTS), 0.01),
        'w_up': nrm(ks[12], (DEPTH, N_EXPERTS, D_MODEL, 2 * D_FF), D_MODEL),
        'b_up': small(ks[13], (DEPTH, N_EXPERTS, 2 * D_FF), 0.02),
        'w_down': nrm(ks[14], (DEPTH, N_EXPERTS, D_FF, D_MODEL), D_FF),
        'b_down': small(ks[15], (DEPTH, N_EXPERTS, D_MODEL), 0.02),
        'lnf_w': gain(ks[16], (D_MODEL,)),
    }


def reference(x, ln1_w, w_in, w_gk2, b_gk2, gla_norm_w, w_proj_a, w_proj_b, w_out,
              ln2_w, w_router, b_router, w_up, b_up, w_down, b_down, lnf_w):
    h = x
    for layer in range(DEPTH):
        h = hybrid_layer(h, ln1_w[layer], w_in[layer], w_gk2[layer], b_gk2[layer],
                         gla_norm_w[layer], w_proj_a[layer], w_proj_b[layer], w_out[layer],
                         ln2_w[layer], w_router[layer], b_router[layer], w_up[layer],
                         b_up[layer], w_down[layer], b_down[layer])
    return rms_norm(h, lnf_w)
```

```cpp
#include <hip/hip_runtime.h>
#include <cstdio>
#include <cstdint>

#ifndef MK_N_LAUNCHES
#define MK_N_LAUNCHES 1
#endif
#ifndef BRINGUP
#define BRINGUP 0
#endif

#define DI __device__ __forceinline__
#define LAS __attribute__((address_space(3)))
#define GAS __attribute__((address_space(1)))
typedef unsigned short bf16;
typedef short bf16x8 __attribute__((ext_vector_type(8)));
typedef short s16x4 __attribute__((ext_vector_type(4)));
typedef short v4i16_t __attribute__((ext_vector_type(4)));
typedef float f32x4 __attribute__((ext_vector_type(4)));
typedef float f32x2 __attribute__((ext_vector_type(2)));
typedef unsigned u32x4 __attribute__((ext_vector_type(4)));
typedef unsigned u32x2 __attribute__((ext_vector_type(2)));
typedef __bf16 bf16v2 __attribute__((ext_vector_type(2)));
typedef GAS unsigned gu32;
#define RLX_AGENT __ATOMIC_RELAXED, __HIP_MEMORY_SCOPE_AGENT
#define LDS_WAIT() asm volatile("s_waitcnt lgkmcnt(0)" ::: "memory")
#define VM_WAIT() asm volatile("s_waitcnt vmcnt(0)" ::: "memory")

DI unsigned pk2(float a, float b) { bf16v2 v; v.x = (__bf16)a; v.y = (__bf16)b; return __builtin_bit_cast(unsigned, v); }
DI float bflo(unsigned w) { return __uint_as_float(w << 16); }
DI float bfhi(unsigned w) { return __uint_as_float(w & 0xffff0000u); }
DI float bf2f(bf16 b) { return __uint_as_float(((unsigned)b) << 16); }
DI bf16 f2bf(float f) { return (bf16)(pk2(f, 0.f) & 0xffffu); }
DI float sigmoidf_fast(float z) { return __builtin_amdgcn_rcpf(1.0f + __builtin_amdgcn_exp2f(-1.4426950408889634f * z)); }
DI bf16x8 cat8(s16x4 lo, s16x4 hi) { bf16x8 r; r[0] = lo[0]; r[1] = lo[1]; r[2] = lo[2]; r[3] = lo[3]; r[4] = hi[0]; r[5] = hi[1]; r[6] = hi[2]; r[7] = hi[3]; return r; }
#define MFMA16(a, b, c) __builtin_amdgcn_mfma_f32_16x16x32_bf16((a), (b), (c), 0, 0, 0)

constexpr int T = 32768, SEQ = 16384, D = 1024, NP = 10240, IN_W = 9744;
constexpr int C_GQ = 4608, C_GK = 5120, C_GV = 5632, C_GOG = 6656, C_GF = 7680, C_MA = 8192, C_MB = 9216;
constexpr int NEXP = 32, NASG = T * 4, MAXTILES = 544;
constexpr float RMS_EPS = 1e-5f;

namespace pg8 {
#define PG8_LAS __attribute__((address_space(3)))
typedef unsigned short bf16_t;
constexpr int BM = 256, BK = 64, HALF = 128, HTB = HALF * BK * 2, STAGE_BYTES = 8 * HTB, NXCD = 8, WGM = 8;
__host__ __device__ __forceinline__ int lds_byte(int r, int c) { const int st = (r >> 4) * 2 + (c >> 5), rr = r & 15, cc = c & 31, ob = rr * 64 + cc * 2; return st * 1024 + (ob ^ (((ob >> 9) & 1) << 5)); }
__host__ __device__ __forceinline__ void stage_rc(int b, int& R, int& C) { const int st = b / 1024, sb = b % 1024, swz = sb ^ (((sb >> 9) & 1) << 5); R = (st >> 1) * 16 + swz / 64; C = (st & 1) * 32 + (swz % 64) / 2; }
__host__ __device__ __forceinline__ int perm32(int rho) { const int n = rho >> 4, i = rho & 15; return 8 * (i >> 2) + 4 * n + (i & 3); }

struct Unit { int pm, pn, e; };
struct Gemm { const bf16_t* A; const bf16_t* Bt; int M, N, K; size_t bstride; };

struct StaticOrder {
    int nM, nN, nwg, G, c;
    __host__ __device__ void init(int M, int N, int G_, int c_) { nM = M / BM; nN = N / BM; nwg = nM * nN; G = G_; c = c_; }
    __host__ __device__ bool next(int i, Unit& u) const {
        const long L = (long)i * G + c; if (L >= nwg) return false;
        int wgid = (int)L; { const int q = nwg / NXCD, r = nwg % NXCD, xcd = wgid % NXCD, off = wgid / NXCD; wgid = (xcd < r ? xcd * (q + 1) : r * (q + 1) + (xcd - r) * q) + off; }
        const int nig = WGM * nN, gid = wgid / nig, fm = gid * WGM, gsz = (nM - fm) < WGM ? (nM - fm) : WGM;
        u.pm = fm + ((wgid % nig) % gsz); u.pn = (wgid % nig) / gsz; u.e = 0; return true;
    }
};
struct MoeOrder : StaticOrder {
    const PG8_LAS int* ts;
    __device__ __forceinline__ bool next(int i, Unit& u) const {
        if (!StaticOrder::next(i, u)) return false;
        int e = 0;
#pragma unroll 1
        while (e < 31 && u.pm >= ts[e + 1]) ++e;
        u.e = e; return true;
    }
};

struct EpiStoreBf16 {
    static constexpr bool PERM = true;
    bf16_t* O; int ldc; const float* bias; int bias_estride;
    __device__ __forceinline__ void operator()(const f32x4 (&acc)[2][2][4][2], const Unit& u, int wr, int wc, int fr, int fq) const {
        const int row0 = u.pm * BM + wr * 64 + fr, col0 = u.pn * BM + wc * 32 + 8 * fq;
        f32x4 bv[2][2];
#pragma unroll
        for (int bj = 0; bj < 2; ++bj)
#pragma unroll
            for (int n = 0; n < 2; ++n) bv[bj][n] = bias ? *(const f32x4*)(bias + (size_t)u.e * bias_estride + col0 + bj * HALF + 4 * n) : (f32x4){0.f, 0.f, 0.f, 0.f};
#pragma unroll
        for (int ai = 0; ai < 2; ++ai)
#pragma unroll
            for (int m = 0; m < 4; ++m) { bf16_t* rowp = O + (size_t)(row0 + ai * HALF + m * 16) * ldc + col0;
#pragma unroll
                for (int bj = 0; bj < 2; ++bj) { const f32x4 v0 = acc[ai][bj][m][0] + bv[bj][0], v1 = acc[ai][bj][m][1] + bv[bj][1];
                    u32x4 w; w.x = pk2(v0[0], v0[1]); w.y = pk2(v0[2], v0[3]); w.z = pk2(v1[0], v1[1]); w.w = pk2(v1[2], v1[3]);
                    *(u32x4*)(rowp + bj * HALF) = w; } }
    }
};
template <bool ADD> struct EpiGate {
    static constexpr bool PERM = true;
    bf16_t* O; const bf16_t* G; int ldg;
    __device__ __forceinline__ void operator()(const f32x4 (&acc)[2][2][4][2], const Unit& u, int wr, int wc, int fr, int fq) const {
        const int row0 = u.pm * BM + wr * 64 + fr, col0 = u.pn * BM + wc * 32 + 8 * fq;
#pragma unroll
        for (int ai = 0; ai < 2; ++ai)
#pragma unroll
            for (int m = 0; m < 4; ++m) { const size_t r = (size_t)(row0 + ai * HALF + m * 16);
#pragma unroll
                for (int bj = 0; bj < 2; ++bj) { const u32x4 gw = *(const u32x4*)(G + r * ldg + col0 + bj * HALF);
                    u32x4 ow = {0u, 0u, 0u, 0u}; if (ADD) ow = *(const u32x4*)(O + r * D + col0 + bj * HALF);
                    const f32x4 v0 = acc[ai][bj][m][0], v1 = acc[ai][bj][m][1]; u32x4 w;
                    w.x = pk2((ADD ? bflo(ow.x) : 0.f) + sigmoidf_fast(bflo(gw.x)) * v0[0], (ADD ? bfhi(ow.x) : 0.f) + sigmoidf_fast(bfhi(gw.x)) * v0[1]);
                    w.y = pk2((ADD ? bflo(ow.y) : 0.f) + sigmoidf_fast(bflo(gw.y)) * v0[2], (ADD ? bfhi(ow.y) : 0.f) + sigmoidf_fast(bfhi(gw.y)) * v0[3]);
                    w.z = pk2((ADD ? bflo(ow.z) : 0.f) + sigmoidf_fast(bflo(gw.z)) * v1[0], (ADD ? bfhi(ow.z) : 0.f) + sigmoidf_fast(bfhi(gw.z)) * v1[1]);
                    w.w = pk2((ADD ? bflo(ow.w) : 0.f) + sigmoidf_fast(bflo(gw.w)) * v1[2], (ADD ? bfhi(ow.w) : 0.f) + sigmoidf_fast(bfhi(gw.w)) * v1[3]);
                    *(u32x4*)(O + r * D + col0 + bj * HALF) = w; } }
    }
};
struct EpiResF32 {
    static constexpr bool PERM = false;
    const float* base; float* C;
    __device__ __forceinline__ void operator()(const f32x4 (&acc)[2][2][4][2], const Unit& u, int wr, int wc, int fr, int fq) const {
        const int row0 = u.pm * BM + wr * 64 + fr, col0 = u.pn * BM + wc * 32 + 4 * fq;
#pragma unroll
        for (int ai = 0; ai < 2; ++ai)
#pragma unroll
            for (int m = 0; m < 4; ++m) { const size_t off = (size_t)(row0 + ai * HALF + m * 16) * D + col0;
#pragma unroll
                for (int bj = 0; bj < 2; ++bj)
#pragma unroll
                    for (int n = 0; n < 2; ++n) *(f32x4*)(C + off + bj * HALF + n * 16) = *(const f32x4*)(base + off + bj * HALF + n * 16) + acc[ai][bj][m][n]; }
    }
};
struct EpiSwiGLU {
    static constexpr bool PERM = true;
    bf16_t* O; const float* bup;
    __device__ __forceinline__ void operator()(const f32x4 (&acc)[2][2][4][2], const Unit& u, int wr, int wc, int fr, int fq) const {
        const int row0 = u.pm * BM + wr * 64 + fr, x0 = wc * 32 + 8 * fq;
        const float* bg = bup + (size_t)u.e * 2048 + u.pn * 128 + x0; const float* bl = bg + 1024;
        const f32x4 bgv[2] = {*(const f32x4*)bg, *(const f32x4*)(bg + 4)}, blv[2] = {*(const f32x4*)bl, *(const f32x4*)(bl + 4)};
#pragma unroll
        for (int ai = 0; ai < 2; ++ai)
#pragma unroll
            for (int m = 0; m < 4; ++m) { float r[8];
#pragma unroll
                for (int n = 0; n < 2; ++n) { const f32x4 gv = acc[ai][0][m][n] + bgv[n], lv = acc[ai][1][m][n] + blv[n];
#pragma unroll
                    for (int j = 0; j < 4; ++j) { const float xg = fminf(gv[j], 7.0f), xl = fminf(fmaxf(lv[j], -7.0f), 7.0f); r[4 * n + j] = xg * sigmoidf_fast(1.702f * xg) * (xl + 1.0f); } }
                u32x4 w; w.x = pk2(r[0], r[1]); w.y = pk2(r[2], r[3]); w.z = pk2(r[4], r[5]); w.w = pk2(r[6], r[7]);
                *(u32x4*)(O + (size_t)(row0 + ai * HALF + m * 16) * D + u.pn * 128 + x0) = w; }
    }
};

template <class Epi, class Sched, bool ALIGN_EPI = true, bool SP2 = true>
__device__ __forceinline__ void gemm_phase(PG8_LAS unsigned char* lds, const Gemm g, const Sched& S, const Epi& E) {
    const int tid = threadIdx.x, wid = __builtin_amdgcn_readfirstlane(tid >> 6), lane = tid & 63, wr = wid >> 2, wc = wid & 3, fr = lane & 15, fq = lane >> 4;
    const int K = g.K, nt = K / BK;
    unsigned voffA[2], voffB[2];
#pragma unroll
    for (int i = 0; i < 2; ++i) { int R, C; stage_rc(tid * 16 + i * 8192, R, C); const int Rb = Epi::PERM ? ((R & ~31) + perm32(R & 31)) : R;
        voffA[i] = (unsigned)(R * K + C) * 2u; voffB[i] = (unsigned)(Rb * K + C) * 2u; }
    const size_t kstep = (size_t)(BK * 2), hstep = (size_t)HALF * K * 2, tstep = 2 * hstep, estep = g.bstride * 2;
    const unsigned ldsw = (unsigned)wid * 1024u;
    const int aoff = lds_byte(wr * 64 + fr, fq * 8), boff = lds_byte(wc * 32 + fr, fq * 8);
#define PG8_SA(b, h) (((b) * 2 + (h)) * HTB)
#define PG8_SB(b, h) ((4 + (b) * 2 + (h)) * HTB)
#define PG8_STAGE(bufoff, gbase, voff) do { _Pragma("unroll") for (int _i = 0; _i < 2; ++_i) \
        __builtin_amdgcn_global_load_lds((const unsigned*)((const char*)(gbase) + (voff)[_i]), (PG8_LAS unsigned*)(lds + (bufoff) + ldsw + _i * 8192), 16, 0, 0); } while (0)
#define PG8_LDA(dst, b, h) do { _Pragma("unroll") for (int m = 0; m < 4; ++m) _Pragma("unroll") for (int k = 0; k < 2; ++k) dst[m][k] = *(const PG8_LAS bf16x8*)(lds + PG8_SA(b, h) + aoff + m * 2048 + k * 1024); } while (0)
#define PG8_LDB(dst, b, h) do { _Pragma("unroll") for (int n = 0; n < 2; ++n) _Pragma("unroll") for (int k = 0; k < 2; ++k) dst[n][k] = *(const PG8_LAS bf16x8*)(lds + PG8_SB(b, h) + boff + n * 2048 + k * 1024); } while (0)
#define PG8_MMA(ai, bj, At, Bt) do { __builtin_amdgcn_s_setprio(1); _Pragma("unroll") for (int m = 0; m < 4; ++m) _Pragma("unroll") for (int n = 0; n < 2; ++n) _Pragma("unroll") for (int k = 0; k < 2; ++k) \
        acc[ai][bj][m][n] = __builtin_amdgcn_mfma_f32_16x16x32_bf16(Bt[n][k], At[m][k], acc[ai][bj][m][n], 0, 0, 0); __builtin_amdgcn_s_setprio(0); } while (0)
#define PG8_WAIT_V(n) asm volatile("s_waitcnt vmcnt(" #n ")" ::: "memory")
#define PG8_WAIT_L(n) asm volatile("s_waitcnt lgkmcnt(" #n ")" ::: "memory")
#define PG8_BAR __builtin_amdgcn_s_barrier()
#define PG8_SCHED __builtin_amdgcn_sched_barrier(0)
    Unit cur, nxt; int ui = 0;
    if (!S.next(0, cur)) return;
    f32x4 acc[2][2][4][2];
#pragma unroll
    for (int a = 0; a < 2; ++a)
#pragma unroll
        for (int b = 0; b < 2; ++b)
#pragma unroll
            for (int m = 0; m < 4; ++m)
#pragma unroll
                for (int n = 0; n < 2; ++n) acc[a][b][m][n] = (f32x4){0.f, 0.f, 0.f, 0.f};
    bf16x8 At[4][2], B0[2][2], B1[2][2];
    const char* cA = (const char*)g.A + (size_t)cur.pm * tstep; const char* cB = (const char*)g.Bt + (size_t)cur.e * estep + (size_t)cur.pn * tstep;
    if constexpr (SP2) {
        PG8_STAGE(PG8_SB(0, 0), cB, voffB); PG8_STAGE(PG8_SB(0, 1), cB + hstep, voffB); PG8_STAGE(PG8_SA(0, 0), cA, voffA); PG8_STAGE(PG8_SA(0, 1), cA + hstep, voffA);
        if (wr == 1) PG8_BAR;
        PG8_WAIT_V(2); PG8_BAR;
        PG8_STAGE(PG8_SB(1, 0), cB + kstep, voffB); PG8_STAGE(PG8_SA(1, 0), cA + kstep, voffA); PG8_STAGE(PG8_SB(1, 1), cB + hstep + kstep, voffB);
        PG8_WAIT_V(6); PG8_BAR;
    } else {
        PG8_STAGE(PG8_SB(0, 0), cB, voffB); PG8_STAGE(PG8_SA(0, 0), cA, voffA); PG8_STAGE(PG8_SB(0, 1), cB + hstep, voffB); PG8_STAGE(PG8_SA(0, 1), cA + hstep, voffA);
        if (wr == 1) PG8_BAR;
        PG8_WAIT_V(4); PG8_BAR;
        PG8_STAGE(PG8_SB(1, 0), cB + kstep, voffB); PG8_STAGE(PG8_SA(1, 0), cA + kstep, voffA); PG8_STAGE(PG8_SB(1, 1), cB + hstep + kstep, voffB);
        PG8_WAIT_V(6); PG8_BAR;
    }
    for (;;) {
        const bool has_next = S.next(ui + 1, nxt);
        const char* nA = has_next ? (const char*)g.A + (size_t)nxt.pm * tstep : cA; const char* nB = has_next ? (const char*)g.Bt + (size_t)nxt.e * estep + (size_t)nxt.pn * tstep : cB;
        for (int t = 0; t < nt; t += 2) {
            const bool last = (t == nt - 2);
            const char* a1 = cA + (size_t)(t + 1) * kstep;
            const char* a2 = last ? nA : cA + (size_t)(t + 2) * kstep; const char* b2 = last ? nB : cB + (size_t)(t + 2) * kstep;
            const char* a3 = a2 + kstep; const char* b3 = b2 + kstep;
            if constexpr (SP2) {
            PG8_LDB(B0, 0, 0); PG8_LDB(B1, 0, 1); PG8_SCHED; PG8_LDA(At, 0, 0); PG8_STAGE(PG8_SA(1, 1), a1 + hstep, voffA);
            PG8_WAIT_V(8); PG8_WAIT_L(0); PG8_BAR; PG8_MMA(0, 0, At, B0); PG8_MMA(0, 1, At, B1); PG8_BAR; PG8_SCHED;
            PG8_LDA(At, 0, 1); PG8_STAGE(PG8_SB(0, 0), b2, voffB); PG8_STAGE(PG8_SB(0, 1), b2 + hstep, voffB); PG8_STAGE(PG8_SA(0, 0), a2, voffA);
            PG8_WAIT_V(8); PG8_WAIT_L(0); PG8_BAR; PG8_MMA(1, 0, At, B0); PG8_MMA(1, 1, At, B1); PG8_BAR; PG8_SCHED;
            PG8_LDB(B0, 1, 0); PG8_LDB(B1, 1, 1); PG8_SCHED; PG8_LDA(At, 1, 0); PG8_STAGE(PG8_SA(0, 1), a2 + hstep, voffA);
            PG8_WAIT_V(8); PG8_WAIT_L(0); PG8_BAR; PG8_MMA(0, 0, At, B0); PG8_MMA(0, 1, At, B1); PG8_BAR; PG8_SCHED;
            PG8_LDA(At, 1, 1); PG8_STAGE(PG8_SB(1, 0), b3, voffB); PG8_STAGE(PG8_SB(1, 1), b3 + hstep, voffB); PG8_STAGE(PG8_SA(1, 0), a3, voffA);
            PG8_WAIT_V(8); PG8_WAIT_L(0); PG8_BAR; PG8_MMA(1, 0, At, B0); PG8_MMA(1, 1, At, B1); PG8_BAR; PG8_SCHED;
            } else {
            PG8_LDB(B0, 0, 0); PG8_SCHED; PG8_LDA(At, 0, 0); PG8_STAGE(PG8_SA(1, 1), a1 + hstep, voffA);
            PG8_WAIT_L(8); PG8_BAR; PG8_WAIT_L(0); PG8_MMA(0, 0, At, B0); PG8_BAR; PG8_SCHED;
            PG8_LDB(B1, 0, 1); PG8_STAGE(PG8_SB(0, 0), b2, voffB);
            PG8_BAR; PG8_WAIT_L(0); PG8_MMA(0, 1, At, B1); PG8_BAR;
            PG8_LDA(At, 0, 1); PG8_STAGE(PG8_SA(0, 0), a2, voffA);
            PG8_BAR; PG8_WAIT_L(0); PG8_MMA(1, 0, At, B0); PG8_BAR; PG8_SCHED;
            PG8_STAGE(PG8_SB(0, 1), b2 + hstep, voffB);
            PG8_WAIT_V(6); PG8_BAR; PG8_MMA(1, 1, At, B1); PG8_BAR;
            PG8_LDB(B0, 1, 0); PG8_SCHED; PG8_LDA(At, 1, 0); PG8_STAGE(PG8_SA(0, 1), a2 + hstep, voffA);
            PG8_WAIT_L(8); PG8_BAR; PG8_WAIT_L(0); PG8_MMA(0, 0, At, B0); PG8_BAR; PG8_SCHED;
            PG8_LDB(B1, 1, 1); PG8_STAGE(PG8_SB(1, 0), b3, voffB);
            PG8_BAR; PG8_WAIT_L(0); PG8_MMA(0, 1, At, B1); PG8_BAR;
            PG8_LDA(At, 1, 1); PG8_STAGE(PG8_SA(1, 0), a3, voffA);
            PG8_BAR; PG8_WAIT_L(0); PG8_MMA(1, 0, At, B0); PG8_BAR; PG8_SCHED;
            PG8_STAGE(PG8_SB(1, 1), b3 + hstep, voffB);
            PG8_WAIT_V(6); PG8_BAR; PG8_MMA(1, 1, At, B1); PG8_BAR;
            }
        }
        if constexpr (ALIGN_EPI) { if (wr == 0) PG8_BAR; }
        E(acc, cur, wr, wc, fr, fq);
        if (!has_next) break;
#pragma unroll
        for (int a = 0; a < 2; ++a)
#pragma unroll
            for (int b = 0; b < 2; ++b)
#pragma unroll
                for (int m = 0; m < 4; ++m)
#pragma unroll
                    for (int n = 0; n < 2; ++n) acc[a][b][m][n] = (f32x4){0.f, 0.f, 0.f, 0.f};
        cur = nxt; cA = nA; cB = nB; ++ui;
        if constexpr (ALIGN_EPI) { if (wr == 1) PG8_BAR; }
    }
    PG8_WAIT_V(0);
    if constexpr (!ALIGN_EPI) { if (wr == 0) PG8_BAR; }
    PG8_BAR;
#undef PG8_SA
#undef PG8_SB
#undef PG8_STAGE
#undef PG8_LDA
#undef PG8_LDB
#undef PG8_MMA
#undef PG8_WAIT_V
#undef PG8_WAIT_L
#undef PG8_BAR
#undef PG8_SCHED
}
}

constexpr size_t MiB = 1u << 20;
constexpr size_t WS_CTL = 0, CTL_ZERO_BYTES = 1 * MiB;
constexpr size_t WS_ASG_E = 1 * MiB, WS_ASG_SLOT = WS_ASG_E + (size_t)NASG * 4, WS_ASG_G = WS_ASG_SLOT + (size_t)NASG * 4, WS_ASG_ROW = WS_ASG_G + (size_t)NASG * 4;
constexpr size_t WS_WRT = 3 * MiB;
constexpr size_t WS_WPA = 4 * MiB, WS_WPB = 5 * MiB, WS_WOUT = 7 * MiB, WS_WIN = 9 * MiB;
constexpr size_t WS_WUP = 29 * MiB, WS_WDN = 157 * MiB;
constexpr size_t WS_XN = 221 * MiB;
constexpr size_t WS_GSTATE = WS_XN, WS_GDEC = WS_XN + 32 * MiB;
constexpr size_t WS_OA = 285 * MiB, WS_OB = 317 * MiB;
constexpr size_t WS_HN = WS_OB;
constexpr size_t WS_PROJ = 381 * MiB;
constexpr size_t WS_XG = WS_PROJ, WS_ACT = WS_PROJ + 272 * MiB, WS_YB = WS_XG;
constexpr size_t WS_END = 1021 * MiB;
static_assert(WS_PROJ + (size_t)T * NP * 2 == WS_END && WS_ACT + (size_t)MAXTILES * 256 * D * 2 <= WS_END, "d_ws map");
constexpr size_t OUT_OG = 0, OUT_LSE = 96 * MiB;
constexpr int CW_BAR = 4096, CW_CNT = 512;
constexpr int RING_BYTES = 131072, MISC_OFF = RING_BYTES, TBL_OFF = RING_BYTES + 512, LDS_BYTES = 147456;

#define XB_TMO      128
#define XB_XCNT(j)  (256  + 64 * (j))
#define XB_XSUB(j)  (1280 + 64 * (j))
#define XB_XGEN(j)  (2304 + 64 * (j))
#define XB_TOP      3328
#define XB_TOPGEN   3392
#define XCD_BAR_WORDS 3456
#define XB_SPIN_CAP (1u << 18)
__device__ __forceinline__ unsigned xb_ld(unsigned* p)              { return __hip_atomic_load(p, __ATOMIC_RELAXED, __HIP_MEMORY_SCOPE_AGENT); }
__device__ __forceinline__ unsigned xb_add(unsigned* p, unsigned v) { return __hip_atomic_fetch_add(p, v, __ATOMIC_RELAXED, __HIP_MEMORY_SCOPE_AGENT); }
__device__ __forceinline__ unsigned xb_xcc_id() { return (unsigned)__builtin_amdgcn_s_getreg((3 << 11) | 20) & 0xFu; }
#define XB_SPIN(cond, bar) do { unsigned _sp = 0; while (cond) { __builtin_amdgcn_s_sleep(1); \
    if ((++_sp & 255u) == 0u) { if (xb_ld(&(bar)[XB_TMO])) break; if (_sp > XB_SPIN_CAP) { atomicAdd(&(bar)[XB_TMO], 1u); break; } } } } while (0)
struct XcdBarrier { unsigned* bar; unsigned x; volatile LAS unsigned* st; };
__device__ __forceinline__ XcdBarrier xcd_barrier_post(unsigned* bar, volatile LAS unsigned* st) {
    XcdBarrier b; b.bar = bar; b.x = xb_xcc_id(); b.st = st;
    if (threadIdx.x == 0) (void)xb_add(&bar[XB_XCNT(b.x)], 1u);
    return b;
}
__device__ __forceinline__ void xcd_barrier_complete(unsigned* bar, unsigned x, unsigned& nloc, unsigned& nx) {
    const unsigned G = gridDim.x * gridDim.y * gridDim.z;
    unsigned sum, cnt, mine, sp = 0u;
    for (;;) {
        sum = 0u; cnt = 0u; mine = 0u;
#pragma unroll
        for (unsigned j = 0; j < 16; ++j) { const unsigned c = xb_ld(&bar[XB_XCNT(j)]); sum += c; cnt += (c > 0u) ? 1u : 0u; mine = (j == x) ? c : mine; }
        if (sum == G) break;
        __builtin_amdgcn_s_sleep(1);
        if ((++sp & 255u) == 0u) { if (xb_ld(&bar[XB_TMO])) break; if (sp > XB_SPIN_CAP) { atomicAdd(&bar[XB_TMO], 1u); break; } }
    }
    nloc = mine > 0u ? mine : 1u; nx = cnt > 0u ? cnt : 1u;
}
__device__ __forceinline__ void xcd_barrier(const XcdBarrier& b) {
    asm volatile("s_waitcnt vmcnt(0)" ::: "memory");
    __syncthreads();
    if (threadIdx.x == 0) {
        unsigned* bar = b.bar;
        __builtin_amdgcn_s_waitcnt(0);
        unsigned nloc = b.st[0], nx = b.st[1];
        if (nloc == 0u) { xcd_barrier_complete(bar, b.x, nloc, nx); b.st[0] = nloc; b.st[1] = nx; }
        const unsigned old = xb_add(&bar[XB_XSUB(b.x)], 1u);
        const unsigned gen = old / nloc;
        if (old + 1u == (gen + 1u) * nloc) {
            __builtin_amdgcn_fence(__ATOMIC_RELEASE, "agent");
            asm volatile("s_waitcnt vmcnt(0)" ::: "memory");
            const unsigned og = xb_add(&bar[XB_TOP], 1u);
            const unsigned tg = og / nx;
            if (og + 1u == (tg + 1u) * nx) xb_add(&bar[XB_TOPGEN], 1u);
            else XB_SPIN(xb_ld(&bar[XB_TOPGEN]) == tg, bar);
            __builtin_amdgcn_fence(__ATOMIC_ACQUIRE, "agent");
            xb_add(&bar[XB_XGEN(b.x)], 1u);
            asm volatile("s_waitcnt vmcnt(0)" ::: "memory");
        } else {
            XB_SPIN(xb_ld(&bar[XB_XGEN(b.x)]) == gen, bar);
            __builtin_amdgcn_fence(__ATOMIC_ACQUIRE, "agent");
            asm volatile("s_waitcnt vmcnt(0)" ::: "memory");
        }
    }
    __syncthreads();
}

DI float wave_sum(float v) {
#pragma unroll
    for (int o = 1; o < 64; o <<= 1) v += __shfl_xor(v, o);
    return v;
}
DI unsigned offb(unsigned row, unsigned ch) { return 256u * row + 16u * (ch ^ (((row & 3u) << 2) | ((row >> 2) & 3u))); }
DI s16x4 vtr(const LAS unsigned char* p) { return __builtin_bit_cast(s16x4, __builtin_amdgcn_ds_read_tr16_b64_v4i16((LAS v4i16_t*)p)); }
DI s16x4 tr4(const LAS unsigned char* img, int rowbase, int c, int lane) { const int q = (lane & 15) >> 2, p = lane & 3; return vtr(img + offb((unsigned)(rowbase + q), (unsigned)(2 * c + (p >> 1))) + 8 * (p & 1)); }

struct Ptrs {
    const float *x, *ln1, *w_in, *w_gk2, *b_gk2, *gnorm, *wpa, *wpb, *wout, *ln2, *wr, *br, *wup, *bup, *wdn, *bdn, *lnf;
    float* out; unsigned char* ws; gu32* ctl;
};

DI void p0_tile(const float* W, int ldw, int k0, int sc0, bf16* WT, int K, int dr0, LAS float* scr, int lane) {
#pragma unroll 8
    for (int i = 0; i < 32; ++i) { const int kk = 2 * i + (lane >> 5); scr[kk * 33 + (lane & 31)] = W[(size_t)(k0 + kk) * ldw + sc0 + (lane & 31)]; }
    LDS_WAIT(); asm volatile("" ::: "memory");
    const int c = lane & 7;
#pragma unroll
    for (int j = 0; j < 4; ++j) { const int n = (lane >> 3) + 8 * j; const LAS float* s = scr + (8 * c) * 33 + n;
        u32x4 o; o.x = pk2(s[0 * 33], s[1 * 33]); o.y = pk2(s[2 * 33], s[3 * 33]); o.z = pk2(s[4 * 33], s[5 * 33]); o.w = pk2(s[6 * 33], s[7 * 33]);
        *(u32x4*)(WT + (size_t)(dr0 + n) * K + k0 + 8 * c) = o; }
    LDS_WAIT(); asm volatile("" ::: "memory");
}
DI void rms_row_to_bf16(const float* xrow, const float* w, bf16* orow, int lane) {
    const f32x4* xr = (const f32x4*)xrow + lane; const f32x4* wr = (const f32x4*)w + lane;
    f32x4 v[4]; float s = 0.f;
#pragma unroll
    for (int j = 0; j < 4; ++j) { v[j] = xr[64 * j]; s += (v[j].x * v[j].x + v[j].y * v[j].y) + (v[j].z * v[j].z + v[j].w * v[j].w); }
    const float rstd = 1.f / sqrtf(wave_sum(s) * (1.f / D) + RMS_EPS);
    u32x2* o8 = (u32x2*)orow + lane;
#pragma unroll
    for (int j = 0; j < 4; ++j) { const f32x4 ww = wr[64 * j]; u32x2 o; o.x = pk2(v[j].x * rstd * ww.x, v[j].y * rstd * ww.y); o.y = pk2(v[j].z * rstd * ww.z, v[j].w * rstd * ww.w); o8[64 * j] = o; }
}
DI void p0_prologue(const Ptrs& P, LAS unsigned char* lds, int vcu, int G, int tid) {
    const int lane = tid & 63, wave = tid >> 6;
    LAS float* scr = (LAS float*)(lds + wave * 16384);
    const int gw = vcu * 8 + wave, NGW = G * 8;
    bf16* WIN_T = (bf16*)(P.ws + WS_WIN); bf16* WPA_T = (bf16*)(P.ws + WS_WPA); bf16* WPB_T = (bf16*)(P.ws + WS_WPB); bf16* WOUT_T = (bf16*)(P.ws + WS_WOUT);
    bf16* WRT = (bf16*)(P.ws + WS_WRT); bf16* WUP_T = (bf16*)(P.ws + WS_WUP); bf16* WDN_T = (bf16*)(P.ws + WS_WDN); bf16* XN = (bf16*)(P.ws + WS_XN);
#if BRINGUP != 1
    constexpr int I_UP = 32 * 1024, I_DN = 32 * 512, I_IN1 = 16 * 240, I_IN2 = 16 * 64, I_PA = 8 * 32, I_PB = 16 * 32, I_OUT = 16 * 32, I_R = 16;
    constexpr int NITEMS = I_UP + I_DN + I_IN1 + I_IN2 + I_PA + I_PB + I_OUT + I_R;
    for (int it = gw; it < NITEMS; it += NGW) {
        int r = it;
        if (r < I_UP) { const int e = r >> 10, q = r & 1023, kb = q >> 6, nb = q & 63, c0 = 32 * nb;
            const int dr0 = (c0 < 1024) ? 256 * (c0 >> 7) + (c0 & 127) : 256 * ((c0 - 1024) >> 7) + 128 + (c0 & 127);
            p0_tile(P.wup + (size_t)e * 1024 * 2048, 2048, 64 * kb, c0, WUP_T + (size_t)e * 2048 * 1024, 1024, dr0, scr, lane); continue; } r -= I_UP;
        if (r < I_DN) { const int e = r >> 9, q = r & 511, kb = q >> 5, nb = q & 31;
            p0_tile(P.wdn + (size_t)e * 1024 * 1024, 1024, 64 * kb, 32 * nb, WDN_T + (size_t)e * 1024 * 1024, 1024, 32 * nb, scr, lane); continue; } r -= I_DN;
        if (r < I_IN1) { const int kb = r / 240, nb = r % 240; p0_tile(P.w_in, IN_W, 64 * kb, 32 * nb, WIN_T, 1024, 32 * nb, scr, lane); continue; } r -= I_IN1;
        if (r < I_IN2) { const int kb = r >> 6, nb = r & 63; p0_tile(P.w_in, IN_W, 64 * kb, 7696 + 32 * nb, WIN_T, 1024, C_MA + 32 * nb, scr, lane); continue; } r -= I_IN2;
        if (r < I_PA) { const int kb = r >> 5, nb = r & 31; p0_tile(P.wpa, 1024, 64 * kb, 32 * nb, WPA_T, 512, 32 * nb, scr, lane); continue; } r -= I_PA;
        if (r < I_PB) { const int kb = r >> 5, nb = r & 31; p0_tile(P.wpb, 1024, 64 * kb, 32 * nb, WPB_T, 1024, 32 * nb, scr, lane); continue; } r -= I_PB;
        if (r < I_OUT) { const int kb = r >> 5, nb = r & 31; p0_tile(P.wout, 1024, 64 * kb, 32 * nb, WOUT_T, 1024, 32 * nb, scr, lane); continue; } r -= I_OUT;
        p0_tile(P.wr, 32, 64 * r, 0, WRT, 1024, 0, scr, lane);
    }
    for (int idx = (vcu * 512 + tid); idx < 512 * 128; idx += G * 512) { const int j = idx >> 7, k0 = (idx & 127) * 8; float a[8];
#pragma unroll
        for (int i = 0; i < 8; ++i) a[i] = 0.f;
#pragma unroll 4
        for (int r = 0; r < 16; ++r) { const float w2 = P.w_gk2[r * 512 + j];
#pragma unroll
            for (int i = 0; i < 8; ++i) a[i] += P.w_in[(size_t)(k0 + i) * IN_W + 7680 + r] * w2; }
        u32x4 o; o.x = pk2(a[0], a[1]); o.y = pk2(a[2], a[3]); o.z = pk2(a[4], a[5]); o.w = pk2(a[6], a[7]);
        *(u32x4*)(WIN_T + (size_t)(C_GF + j) * 1024 + k0) = o; }
    for (int m = gw; m < T; m += NGW) rms_row_to_bf16(P.x + (size_t)m * D, P.ln1, XN + (size_t)m * D, lane);
#endif
}

DI void attn_unit(const bf16* PROJ, bf16* OG, float* LSE, LAS unsigned char* lds, int unit, int tid) {
    const int lane = tid & 63, w = tid >> 6, i = lane & 15, g4 = lane >> 4;
    const int grp = unit >> 10, idx = unit & 1023, b = idx >> 9, h = (idx >> 7) & 3, q7 = idx & 127;
    const int dsh = 2 * grp, d = 1 << dsh, nblk_sh = 7 - dsh, r = q7 >> nblk_sh, n = q7 & ((1 << nblk_sh) - 1);
    LAS unsigned char* KL = lds; LAS unsigned char* VL = lds + 65536;
    const bf16* base = PROJ + (size_t)b * SEQ * NP + grp * 1536 + h * 128;
    u32x4 kreg[8], vreg[8];
#pragma unroll
    for (int ii = 0; ii < 8; ++ii) { const int id = tid + 512 * ii, row = id >> 4, ch = id & 15; const int sig = n * 128 - 128 + row;
        if (sig >= 0) { const bf16* src = base + (size_t)(sig * d + r) * NP + 8 * ch; kreg[ii] = *(const u32x4*)(src + 512); vreg[ii] = *(const u32x4*)(src + 1024); }
        else { kreg[ii] = (u32x4){0u, 0u, 0u, 0u}; vreg[ii] = (u32x4){0u, 0u, 0u, 0u}; } }
    bf16x8 qf[4];
    { const bf16* qsrc = base + (size_t)((n * 128 + 16 * w + i) * d + r) * NP + 8 * g4;
#pragma unroll
      for (int ks = 0; ks < 4; ++ks) qf[ks] = *(const bf16x8*)(qsrc + 32 * ks); }
#pragma unroll
    for (int ii = 0; ii < 8; ++ii) { const int id = tid + 512 * ii, row = id >> 4, ch = id & 15; *(LAS u32x4*)(KL + offb(row, ch)) = kreg[ii]; *(LAS u32x4*)(VL + offb(row, ch)) = vreg[ii]; }
    __syncthreads();
    const int kt0 = (w == 0) ? 0 : w - 1;
    f32x4 st[10];
#pragma unroll
    for (int tt = 0; tt < 10; ++tt) { f32x4 a = {0.f, 0.f, 0.f, 0.f};
#pragma unroll
        for (int ks = 0; ks < 4; ++ks) { const bf16x8 kf = *(const LAS bf16x8*)(KL + offb(16 * (kt0 + tt) + i, 4 * ks + g4)); a = MFMA16(kf, qf[ks], a); }
        st[tt] = a; }
    const int iq = 16 * w + i; float mx = -3.0e38f;
#pragma unroll
    for (int tt = 0; tt < 10; ++tt)
#pragma unroll
        for (int rg = 0; rg < 4; ++rg) { const int j = 16 * (kt0 + tt) + 4 * g4 + rg, dist = iq + 128 - j; const bool ok = ((unsigned)dist <= 128u) && (n > 0 || j >= 128);
            st[tt][rg] = ok ? st[tt][rg] : -__builtin_inff(); mx = fmaxf(mx, st[tt][rg]); }
    mx = fmaxf(mx, __shfl_xor(mx, 16)); mx = fmaxf(mx, __shfl_xor(mx, 32));
    constexpr float SC = 0.08838834764831845f, C2 = SC * 1.4426950408889634f; float sum = 0.f;
#pragma unroll
    for (int tt = 0; tt < 10; ++tt)
#pragma unroll
        for (int rg = 0; rg < 4; ++rg) { const float p = __builtin_amdgcn_exp2f((st[tt][rg] - mx) * C2); st[tt][rg] = p; sum += p; }
    sum += __shfl_xor(sum, 16); sum += __shfl_xor(sum, 32);
    f32x4 o[8];
#pragma unroll
    for (int c = 0; c < 8; ++c) o[c] = (f32x4){0.f, 0.f, 0.f, 0.f};
#pragma unroll
    for (int kk = 0; kk < 5; ++kk) { u32x4 pw; pw.x = pk2(st[2 * kk][0], st[2 * kk][1]); pw.y = pk2(st[2 * kk][2], st[2 * kk][3]); pw.z = pk2(st[2 * kk + 1][0], st[2 * kk + 1][1]); pw.w = pk2(st[2 * kk + 1][2], st[2 * kk + 1][3]);
        const bf16x8 pa = __builtin_bit_cast(bf16x8, pw);
#pragma unroll
        for (int c = 0; c < 8; ++c) { const s16x4 lo = tr4(VL, 16 * (kt0 + 2 * kk) + 4 * g4, c, lane), hi = tr4(VL, 16 * (kt0 + 2 * kk + 1) + 4 * g4, c, lane); o[c] = MFMA16(pa, cat8(lo, hi), o[c]); } }
    const float linv = 1.0f / sum;
    const size_t mrow0 = (size_t)b * SEQ;
#pragma unroll
    for (int rg = 0; rg < 4; ++rg) { const float li = __shfl(linv, 4 * g4 + rg); const size_t m = mrow0 + (size_t)((n * 128 + 16 * w + 4 * g4 + rg) * d + r);
        bf16* dst = OG + ((size_t)grp * T + m) * 512 + h * 128 + i;
#pragma unroll
        for (int c = 0; c < 8; ++c) dst[16 * c] = f2bf(o[c][rg] * li); }
    if (lane < 16) { const size_t m = mrow0 + (size_t)((n * 128 + iq) * d + r); LSE[((size_t)grp * T + m) * 4 + h] = mx * SC + __logf(sum); }
    __syncthreads();
}

constexpr int GL_QE = 0, GL_KM = 16384, GL_KE = 32768, GL_V = 49152, GL_ATT = 81920, GL_TOT = 91136, GL_DEC = 93184, GL_RS = 93696;
template <bool FULL> DI float gla_prep(const bf16* PROJ, const float* b_gk2, LAS unsigned char* lds, size_t mbase, int h, int tid) {
    const int j = tid & 127, tq = tid >> 7;
    const bf16* src = PROJ + (mbase + 16 * tq) * NP + h * 128 + j;
    const float bias = b_gk2[h * 128 + j];
    float c[16], kv[16], qv[16]; float run = 0.f;
#pragma unroll
    for (int ii = 0; ii < 16; ++ii) { const bf16* p = src + (size_t)ii * NP; const float xg = bf2f(p[C_GF]) + bias; kv[ii] = bf2f(p[C_GK]); if (FULL) qv[ii] = bf2f(p[C_GQ]);
        const float ls = fminf(xg, 0.f) - __logf(1.0f + __expf(-fabsf(xg))); run += ls * (1.0f / 16.0f); c[ii] = run; }
    LAS float* TOT = (LAS float*)(lds + GL_TOT);
    TOT[tq * 128 + j] = run;
    u32x4 vr[4];
#pragma unroll
    for (int ii = 0; ii < 4; ++ii) { const int id = tid + 512 * ii, row = id >> 5, c32 = id & 31; vr[ii] = *(const u32x4*)(PROJ + (mbase + row) * NP + C_GV + h * 256 + 8 * c32); }
    __syncthreads();
    float off = 0.f, blast = 0.f;
#pragma unroll
    for (int t2 = 0; t2 < 4; ++t2) { const float v = TOT[t2 * 128 + j]; blast += v; off += (t2 < tq) ? v : 0.f; }
#pragma unroll
    for (int ii = 0; ii < 16; ++ii) { const int s = 16 * tq + ii; const float bb = off + c[ii]; const unsigned o = offb(s, j >> 3) + (j & 7) * 2;
        *(LAS bf16*)(lds + GL_KE + o) = f2bf(kv[ii] * __expf(blast - bb));
        if (FULL) { *(LAS bf16*)(lds + GL_QE + o) = f2bf(qv[ii] * 0.08838834764831845f * __expf(bb)); *(LAS bf16*)(lds + GL_KM + o) = f2bf(kv[ii] * __expf(-bb)); } }
    if (tq == 0) ((LAS float*)(lds + GL_DEC))[j] = __expf(blast);
#pragma unroll
    for (int ii = 0; ii < 4; ++ii) { const int id = tid + 512 * ii, row = id >> 5, c32 = id & 31; *(LAS u32x4*)(lds + GL_V + (c32 >> 4) * 16384 + offb(row, c32 & 15)) = vr[ii]; }
    __syncthreads();
    return blast;
}
DI void gla_state_update(f32x4 (&S)[8][2], const LAS unsigned char* lds, int w, int lane) {
    const int g4 = lane >> 4; const LAS unsigned char* Vimg = lds + GL_V + (w >> 2) * 16384; const int cv = 2 * (w & 3);
#pragma unroll
    for (int mt = 0; mt < 8; ++mt) { const f32x4 dc = *(const LAS f32x4*)(lds + GL_DEC + (16 * mt + 4 * g4) * 4); S[mt][0] = S[mt][0] * dc; S[mt][1] = S[mt][1] * dc; }
#pragma unroll
    for (int ks = 0; ks < 2; ++ks) { bf16x8 bfr[2];
#pragma unroll
        for (int nt = 0; nt < 2; ++nt) bfr[nt] = cat8(tr4(Vimg, 32 * ks + 8 * g4, cv + nt, lane), tr4(Vimg, 32 * ks + 8 * g4 + 4, cv + nt, lane));
#pragma unroll
        for (int mt = 0; mt < 8; ++mt) { const bf16x8 a = cat8(tr4(lds + GL_KE, 32 * ks + 8 * g4, mt, lane), tr4(lds + GL_KE, 32 * ks + 8 * g4 + 4, mt, lane));
            S[mt][0] = MFMA16(a, bfr[0], S[mt][0]); S[mt][1] = MFMA16(a, bfr[1], S[mt][1]); } }
}
DI void gla_pass1(const Ptrs& P, LAS unsigned char* lds, int unit, int tid) {
    const int lane = tid & 63, w = tid >> 6; const int bh = unit >> 5, sc = unit & 31, b = bh >> 2, h = bh & 3;
    const bf16* PROJ = (const bf16*)(P.ws + WS_PROJ);
    f32x4 S[8][2];
#pragma unroll
    for (int mt = 0; mt < 8; ++mt) { S[mt][0] = (f32x4){0.f, 0.f, 0.f, 0.f}; S[mt][1] = (f32x4){0.f, 0.f, 0.f, 0.f}; }
    float logd = 0.f;
    for (int ci = 0; ci < 8; ++ci) { const size_t mbase = (size_t)b * SEQ + (size_t)(8 * sc + ci) * 64;
        logd += gla_prep<false>(PROJ, P.b_gk2, lds, mbase, h, tid);
        gla_state_update(S, lds, w, lane);
        __syncthreads(); }
    float* GS = (float*)(P.ws + WS_GSTATE) + (size_t)unit * 32768;
#pragma unroll
    for (int mt = 0; mt < 8; ++mt)
#pragma unroll
        for (int nt = 0; nt < 2; ++nt)
#pragma unroll
            for (int rg = 0; rg < 4; ++rg) GS[((w * 16 + mt * 2 + nt) * 4 + rg) * 64 + lane] = S[mt][nt][rg];
    if (tid < 128) ((float*)(P.ws + WS_GDEC))[unit * 128 + tid] = __expf(logd);
}
DI void gla_scan(const Ptrs& P, int vcu, int G, int tid) {
    float* GS = (float*)(P.ws + WS_GSTATE); const float* GD = (const float*)(P.ws + WS_GDEC);
    for (int cid = vcu * 512 + tid; cid < 8 * 32768; cid += G * 512) { const int bh = cid >> 15, e = cid & 32767, ln = e & 63, rg = (e >> 6) & 3, mt = ((e >> 8) & 15) >> 1, dk = 16 * mt + 4 * (ln >> 4) + rg;
        float ev[32], dv[32];
#pragma unroll
        for (int sc = 0; sc < 32; ++sc) { ev[sc] = GS[((size_t)(bh * 32 + sc) << 15) + e]; dv[sc] = GD[(bh * 32 + sc) * 128 + dk]; }
        float carry = 0.f;
#pragma unroll
        for (int sc = 0; sc < 32; ++sc) { GS[((size_t)(bh * 32 + sc) << 15) + e] = carry; carry = dv[sc] * carry + ev[sc]; } }
}
DI void gla_pass2(const Ptrs& P, LAS unsigned char* lds, int unit, int tid) {
    const int lane0 = tid & 63, w = tid >> 6; const int bh = unit >> 5, sc = unit & 31, b = bh >> 2, h = bh & 3;
    const bf16* PROJ = (const bf16*)(P.ws + WS_PROJ); bf16* OB = (bf16*)(P.ws + WS_OB);
    f32x4 S[8][2];
    { const float* GS = (const float*)(P.ws + WS_GSTATE) + (size_t)unit * 32768;
#pragma unroll
      for (int mt = 0; mt < 8; ++mt)
#pragma unroll
          for (int nt = 0; nt < 2; ++nt)
#pragma unroll
              for (int rg = 0; rg < 4; ++rg) S[mt][nt][rg] = GS[((w * 16 + mt * 2 + nt) * 4 + rg) * 64 + lane0]; }
    const float nw0 = P.gnorm[32 * w + (lane0 & 15)], nw1 = P.gnorm[32 * w + 16 + (lane0 & 15)];
    const LAS unsigned char* Vimg = lds + GL_V + (w >> 2) * 16384; const int cv = 2 * (w & 3);
    for (int ci = 0; ci < 8; ++ci) { const size_t mbase = (size_t)b * SEQ + (size_t)(8 * sc + ci) * 64;
        (void)gla_prep<true>(PROJ, P.b_gk2, lds, mbase, h, tid);
        int lane = lane0; asm volatile("" : "+v"(lane));
        const int i = lane & 15, g4 = lane >> 4;
        { const int mi = w >> 1;
#pragma unroll
          for (int nn = 0; nn < 2; ++nn) { const int nj = 2 * (w & 1) + nn; f32x4 a = {0.f, 0.f, 0.f, 0.f};
#pragma unroll
              for (int ks = 0; ks < 4; ++ks) { const bf16x8 af = *(const LAS bf16x8*)(lds + GL_QE + offb(16 * mi + i, 4 * ks + g4)), bfr = *(const LAS bf16x8*)(lds + GL_KM + offb(16 * nj + i, 4 * ks + g4)); a = MFMA16(af, bfr, a); }
#pragma unroll
              for (int rg = 0; rg < 4; ++rg) { const int sq = 16 * mi + 4 * g4 + rg, sk = 16 * nj + i; *(LAS bf16*)(lds + GL_ATT + sq * 144 + sk * 2) = f2bf(sk <= sq ? a[rg] : 0.f); } } }
        __syncthreads();
        f32x4 o[4][2];
#pragma unroll
        for (int mt = 0; mt < 4; ++mt) { o[mt][0] = (f32x4){0.f, 0.f, 0.f, 0.f}; o[mt][1] = (f32x4){0.f, 0.f, 0.f, 0.f}; }
#pragma unroll
        for (int ks = 0; ks < 2; ++ks) { bf16x8 bfr[2];
#pragma unroll
            for (int nt = 0; nt < 2; ++nt) bfr[nt] = cat8(tr4(Vimg, 32 * ks + 8 * g4, cv + nt, lane), tr4(Vimg, 32 * ks + 8 * g4 + 4, cv + nt, lane));
#pragma unroll
            for (int mt = 0; mt < 4; ++mt) { const bf16x8 a = *(const LAS bf16x8*)(lds + GL_ATT + (16 * mt + i) * 144 + 64 * ks + 16 * g4); o[mt][0] = MFMA16(a, bfr[0], o[mt][0]); o[mt][1] = MFMA16(a, bfr[1], o[mt][1]); } }
#pragma unroll
        for (int ks = 0; ks < 4; ++ks) { bf16x8 sb[2];
#pragma unroll
            for (int nt = 0; nt < 2; ++nt) { u32x4 pw; pw.x = pk2(S[2 * ks][nt][0], S[2 * ks][nt][1]); pw.y = pk2(S[2 * ks][nt][2], S[2 * ks][nt][3]); pw.z = pk2(S[2 * ks + 1][nt][0], S[2 * ks + 1][nt][1]); pw.w = pk2(S[2 * ks + 1][nt][2], S[2 * ks + 1][nt][3]); sb[nt] = __builtin_bit_cast(bf16x8, pw); }
#pragma unroll
            for (int mt = 0; mt < 4; ++mt) { const u32x2 lo = *(const LAS u32x2*)(lds + GL_QE + offb(16 * mt + i, 4 * ks + (g4 >> 1)) + (g4 & 1) * 8), hi = *(const LAS u32x2*)(lds + GL_QE + offb(16 * mt + i, 4 * ks + 2 + (g4 >> 1)) + (g4 & 1) * 8);
                u32x4 aw; aw.x = lo.x; aw.y = lo.y; aw.z = hi.x; aw.w = hi.y; const bf16x8 a = __builtin_bit_cast(bf16x8, aw);
                o[mt][0] = MFMA16(a, sb[0], o[mt][0]); o[mt][1] = MFMA16(a, sb[1], o[mt][1]); } }
        LAS float* RS = (LAS float*)(lds + GL_RS);
#pragma unroll
        for (int mt = 0; mt < 4; ++mt)
#pragma unroll
            for (int rg = 0; rg < 4; ++rg) { float ss = o[mt][0][rg] * o[mt][0][rg] + o[mt][1][rg] * o[mt][1][rg];
                ss += __shfl_xor(ss, 1); ss += __shfl_xor(ss, 2); ss += __shfl_xor(ss, 4); ss += __shfl_xor(ss, 8);
                if (i == 0) RS[w * 64 + 16 * mt + 4 * g4 + rg] = ss; }
        __syncthreads();
#pragma unroll
        for (int mt = 0; mt < 4; ++mt)
#pragma unroll
            for (int rg = 0; rg < 4; ++rg) { const int sq = 16 * mt + 4 * g4 + rg; float tot = 0.f;
#pragma unroll
                for (int w2 = 0; w2 < 8; ++w2) tot += RS[w2 * 64 + sq];
                const float rstd = 1.0f / sqrtf(tot * (1.0f / 256.0f) + RMS_EPS);
                const bf16* gp = PROJ + (mbase + sq) * NP + C_GOG + h * 256 + 32 * w + i; bf16* op = OB + (mbase + sq) * D + h * 256 + 32 * w + i;
                const float g0 = bf2f(gp[0]), g1 = bf2f(gp[16]);
                op[0] = f2bf(o[mt][0][rg] * rstd * nw0 * g0 * sigmoidf_fast(g0)); op[16] = f2bf(o[mt][1][rg] * rstd * nw1 * g1 * sigmoidf_fast(g1)); }
        gla_state_update(S, lds, w, lane);
        __syncthreads(); }
}

DI void attn_merge(const Ptrs& P, int vcu, int G, int tid) {
    const int lane = tid & 63, wave = tid >> 6, gw = vcu * 8 + wave, NGW = G * 8;
    const bf16* OG = (const bf16*)((const unsigned char*)P.out + OUT_OG); const float* LSE = (const float*)((const unsigned char*)P.out + OUT_LSE); bf16* OA = (bf16*)(P.ws + WS_OA);
    for (int m = gw; m < T; m += NGW) { const int h = lane >> 4;
        const float l0 = LSE[((size_t)0 * T + m) * 4 + h], l1 = LSE[((size_t)1 * T + m) * 4 + h], l2 = LSE[((size_t)2 * T + m) * 4 + h];
        const float mx = fmaxf(l0, fmaxf(l1, l2)); float w0 = __expf(l0 - mx), w1 = __expf(l1 - mx), w2 = __expf(l2 - mx); const float inv = 1.0f / (w0 + w1 + w2); w0 *= inv; w1 *= inv; w2 *= inv;
        const u32x4 a = *(const u32x4*)(OG + ((size_t)0 * T + m) * 512 + 8 * lane), bq = *(const u32x4*)(OG + ((size_t)1 * T + m) * 512 + 8 * lane), c = *(const u32x4*)(OG + ((size_t)2 * T + m) * 512 + 8 * lane);
        u32x4 o;
        o.x = pk2(w0 * bflo(a.x) + w1 * bflo(bq.x) + w2 * bflo(c.x), w0 * bfhi(a.x) + w1 * bfhi(bq.x) + w2 * bfhi(c.x));
        o.y = pk2(w0 * bflo(a.y) + w1 * bflo(bq.y) + w2 * bflo(c.y), w0 * bfhi(a.y) + w1 * bfhi(bq.y) + w2 * bfhi(c.y));
        o.z = pk2(w0 * bflo(a.z) + w1 * bflo(bq.z) + w2 * bflo(c.z), w0 * bfhi(a.z) + w1 * bfhi(bq.z) + w2 * bfhi(c.z));
        o.w = pk2(w0 * bflo(a.w) + w1 * bflo(bq.w) + w2 * bflo(c.w), w0 * bfhi(a.w) + w1 * bfhi(bq.w) + w2 * bfhi(c.w));
        *(u32x4*)(OA + (size_t)m * 512 + 8 * lane) = o; }
}

DI void router_phase(const Ptrs& P, LAS unsigned char* lds, int G, int tid) {
    const int lane = tid & 63, w = tid >> 6, i = lane & 15, g4 = lane >> 4;
    const float* H1 = P.out; bf16* HN = (bf16*)(P.ws + WS_HN); const bf16* WRT = (const bf16*)(P.ws + WS_WRT);
    int* ASG_E = (int*)(P.ws + WS_ASG_E); int* ASG_SLOT = (int*)(P.ws + WS_ASG_SLOT); float* ASG_G = (float*)(P.ws + WS_ASG_G);
    LAS float* LG = (LAS float*)lds; LAS int* lcnt = (LAS int*)(lds + 17408); LAS int* lbase = (LAS int*)(lds + 17536);
    unsigned* gcnt = (unsigned*)(P.ctl + CW_CNT);
    for (int tb = blockIdx.x; tb < T / 128; tb += G) {
        if (tid < 32) lcnt[tid] = 0;
        __syncthreads();
        const int t = tb * 128 + 16 * w + i; const float* hrow = H1 + (size_t)t * D + 8 * g4;
        float ss = 0.f;
#pragma unroll 8
        for (int c = 0; c < 32; ++c) { const f32x4 v0 = *(const f32x4*)(hrow + 32 * c), v1 = *(const f32x4*)(hrow + 32 * c + 4); ss += (v0.x * v0.x + v0.y * v0.y) + (v0.z * v0.z + v0.w * v0.w) + (v1.x * v1.x + v1.y * v1.y) + (v1.z * v1.z + v1.w * v1.w); }
        ss += __shfl_xor(ss, 16); ss += __shfl_xor(ss, 32);
        const float rstd = 1.0f / sqrtf(ss * (1.0f / D) + RMS_EPS);
        f32x4 a0 = {0.f, 0.f, 0.f, 0.f}, a1 = {0.f, 0.f, 0.f, 0.f};
#pragma unroll 4
        for (int c = 0; c < 32; ++c) { const f32x4 v0 = *(const f32x4*)(hrow + 32 * c), v1 = *(const f32x4*)(hrow + 32 * c + 4); const f32x4 w0 = *(const f32x4*)(P.ln2 + 32 * c + 8 * g4), w1 = *(const f32x4*)(P.ln2 + 32 * c + 8 * g4 + 4);
            u32x4 y; y.x = pk2(v0.x * rstd * w0.x, v0.y * rstd * w0.y); y.y = pk2(v0.z * rstd * w0.z, v0.w * rstd * w0.w); y.z = pk2(v1.x * rstd * w1.x, v1.y * rstd * w1.y); y.w = pk2(v1.z * rstd * w1.z, v1.w * rstd * w1.w);
            *(u32x4*)(HN + (size_t)t * D + 32 * c + 8 * g4) = y;
            const bf16x8 af = __builtin_bit_cast(bf16x8, y); const bf16x8 b0 = *(const bf16x8*)(WRT + (size_t)i * D + 32 * c + 8 * g4), b1 = *(const bf16x8*)(WRT + (size_t)(16 + i) * D + 32 * c + 8 * g4);
            a0 = MFMA16(af, b0, a0); a1 = MFMA16(af, b1, a1); }
        const float br0 = P.br[i], br1 = P.br[16 + i];
#pragma unroll
        for (int rg = 0; rg < 4; ++rg) { LG[(w * 16 + 4 * g4 + rg) * 33 + i] = a0[rg] + br0; LG[(w * 16 + 4 * g4 + rg) * 33 + 16 + i] = a1[rg] + br1; }
        LDS_WAIT(); asm volatile("" ::: "memory");
        int es[4] = {0, 0, 0, 0}, ls[4] = {0, 0, 0, 0}; float gs[4] = {0.f, 0.f, 0.f, 0.f};
        if (lane < 16) { float lg[32];
#pragma unroll
            for (int e = 0; e < 32; ++e) lg[e] = LG[(w * 16 + lane) * 33 + e];
            unsigned taken = 0u; float tv[4];
#pragma unroll
            for (int k = 0; k < 4; ++k) { float best = -3.0e38f; int bi = 0;
#pragma unroll
                for (int e = 0; e < 32; ++e) { const bool ok = !((taken >> e) & 1u) && lg[e] > best; best = ok ? lg[e] : best; bi = ok ? e : bi; }
                taken |= 1u << bi; es[k] = bi; tv[k] = best; }
            const float e1 = __expf(tv[1] - tv[0]), e2 = __expf(tv[2] - tv[0]), e3 = __expf(tv[3] - tv[0]), inv = 1.0f / (1.0f + e1 + e2 + e3);
            gs[0] = inv; gs[1] = e1 * inv; gs[2] = e2 * inv; gs[3] = e3 * inv;
#pragma unroll
            for (int k = 0; k < 4; ++k) ls[k] = atomicAdd((int*)&lcnt[es[k]], 1); }
        __syncthreads();
        if (tid < 32) lbase[tid] = (int)__hip_atomic_fetch_add(gcnt + tid, (unsigned)lcnt[tid], RLX_AGENT);
        __syncthreads();
        if (lane < 16) { const int tt = tb * 128 + 16 * w + lane;
#pragma unroll
            for (int k = 0; k < 4; ++k) { ASG_E[4 * tt + k] = es[k]; ASG_SLOT[4 * tt + k] = lbase[es[k]] + ls[k]; ASG_G[4 * tt + k] = gs[k]; } }
        __syncthreads();
    }
}
DI void moe_tables(const Ptrs& P, LAS int* ts, int tid) {
    if (tid == 0) { const unsigned* gcnt = (const unsigned*)(P.ctl + CW_CNT); int run = 0;
        for (int e = 0; e < 32; ++e) { ts[e] = run; run += (int)((__hip_atomic_load(gcnt + e, RLX_AGENT) + 255u) >> 8); } ts[32] = run; }
    __syncthreads();
}
DI void moe_gather(const Ptrs& P, LAS unsigned char* lds, int vcu, int G, int tid) {
    const int lane = tid & 63, wave = tid >> 6, gw = vcu * 8 + wave, NGW = G * 8;
    LAS int* ts = (LAS int*)(lds + TBL_OFF); moe_tables(P, ts, tid);
    const int* ASG_E = (const int*)(P.ws + WS_ASG_E); const int* ASG_SLOT = (const int*)(P.ws + WS_ASG_SLOT); int* ASG_ROW = (int*)(P.ws + WS_ASG_ROW);
    const bf16* HN = (const bf16*)(P.ws + WS_HN); bf16* XG = (bf16*)(P.ws + WS_XG);
    for (int a = gw; a < NASG; a += NGW) { const int e = ASG_E[a], row = ts[e] * 256 + ASG_SLOT[a]; if (lane == 0) ASG_ROW[a] = row;
        const u32x4* s = (const u32x4*)(HN + (size_t)(a >> 2) * D) + lane; u32x4* d = (u32x4*)(XG + (size_t)row * D) + lane; d[0] = s[0]; d[64] = s[64]; }
}
DI void final_phase(const Ptrs& P, int vcu, int G, int tid) {
    const int lane = tid & 63, wave = tid >> 6, gw = vcu * 8 + wave, NGW = G * 8;
    const int* ASG_ROW = (const int*)(P.ws + WS_ASG_ROW); const float* ASG_G = (const float*)(P.ws + WS_ASG_G); const bf16* YB = (const bf16*)(P.ws + WS_YB);
    for (int t = gw; t < T; t += NGW) {
#if BRINGUP == 1
        const f32x4* hr = (const f32x4*)(P.x + (size_t)t * D) + lane;
#else
        const f32x4* hr = (const f32x4*)(P.out + (size_t)t * D) + lane;
#endif
        f32x4 v[4];
#pragma unroll
        for (int j = 0; j < 4; ++j) v[j] = hr[64 * j];
#if BRINGUP != 1
#pragma unroll
        for (int k = 0; k < 4; ++k) { const int row = ASG_ROW[4 * t + k]; const float gk = ASG_G[4 * t + k]; const u32x2* yr = (const u32x2*)(YB + (size_t)row * D) + lane;
#pragma unroll
            for (int j = 0; j < 4; ++j) { const u32x2 y = yr[64 * j]; v[j].x += gk * bflo(y.x); v[j].y += gk * bfhi(y.x); v[j].z += gk * bflo(y.y); v[j].w += gk * bfhi(y.y); } }
#endif
        float s = 0.f;
#pragma unroll
        for (int j = 0; j < 4; ++j) s += (v[j].x * v[j].x + v[j].y * v[j].y) + (v[j].z * v[j].z + v[j].w * v[j].w);
        const float rstd = 1.f / sqrtf(wave_sum(s) * (1.f / D) + RMS_EPS);
        f32x4* orow = (f32x4*)(P.out + (size_t)t * D) + lane; const f32x4* wr = (const f32x4*)P.lnf + lane;
#pragma unroll
        for (int j = 0; j < 4; ++j) orow[64 * j] = v[j] * rstd * wr[64 * j]; }
}

constexpr int N_PHASES = 12;
struct Args { const float* in[17]; float* out; unsigned char* ws; int ph_lo, ph_hi; };
__global__ void __launch_bounds__(512, 2) fwd(Args args) {
    extern __shared__ __attribute__((aligned(16))) unsigned char lds_raw[];
    LAS unsigned char* lds = (LAS unsigned char*)lds_raw;
    const int tid = threadIdx.x, G = gridDim.x; const int bx = blockIdx.x; const int vcu = (G % 8 == 0) ? (bx % 8) * (G / 8) + bx / 8 : bx;
    Ptrs P;
    P.x = args.in[0]; P.ln1 = args.in[1]; P.w_in = args.in[2]; P.w_gk2 = args.in[3]; P.b_gk2 = args.in[4]; P.gnorm = args.in[5]; P.wpa = args.in[6]; P.wpb = args.in[7]; P.wout = args.in[8];
    P.ln2 = args.in[9]; P.wr = args.in[10]; P.br = args.in[11]; P.wup = args.in[12]; P.bup = args.in[13]; P.wdn = args.in[14]; P.bdn = args.in[15]; P.lnf = args.in[16];
    P.out = args.out; P.ws = args.ws; P.ctl = (gu32*)(args.ws + WS_CTL);
    volatile LAS unsigned* MISC = (volatile LAS unsigned*)(lds + MISC_OFF);
    for (int u = tid; u < (LDS_BYTES - MISC_OFF) / 4; u += 512) ((LAS unsigned*)(lds + MISC_OFF))[u] = 0u;
    __syncthreads();
    XcdBarrier bar; bar.bar = (unsigned*)(P.ctl + CW_BAR); bar.x = 0; bar.st = nullptr;
    if (MK_N_LAUNCHES == 1) bar = xcd_barrier_post((unsigned*)(P.ctl + CW_BAR), MISC + 8);
    const int lo = args.ph_lo, hi = args.ph_hi;
#ifndef PH_MASK
#define PH_MASK 0xFFF
#endif
#define IN(k) (((PH_MASK >> (k)) & 1) && lo <= (k) && (k) < hi)
#define SEAM(k) do { if (IN(k) && IN((k) + 1)) xcd_barrier(bar); } while (0)
    bf16* PROJ = (bf16*)(P.ws + WS_PROJ); bf16* XN = (bf16*)(P.ws + WS_XN); bf16* MIXED = XN;

    if (IN(0)) { p0_prologue(P, lds, vcu, G, tid); } SEAM(0);
#if BRINGUP == 0
    if (IN(1)) { pg8::Gemm g{XN, (const bf16*)(P.ws + WS_WIN), T, NP, D, 0}; pg8::StaticOrder S; S.init(T, NP, G, bx);
        pg8::EpiStoreBf16 E{PROJ, NP, nullptr, 0}; pg8::gemm_phase(lds, g, S, E); } SEAM(1);
    if (IN(2)) { bf16* OG = (bf16*)((unsigned char*)P.out + OUT_OG); float* LSE = (float*)((unsigned char*)P.out + OUT_LSE);
        for (int u = vcu; u < 3072; u += G) attn_unit(PROJ, OG, LSE, lds, u, tid);
        for (int u = bx; u < 256; u += G) gla_pass1(P, lds, u, tid); } SEAM(2);
    if (IN(3)) { gla_scan(P, vcu, G, tid); attn_merge(P, vcu, G, tid); } SEAM(3);
    if (IN(4)) { for (int u = bx; u < 256; u += G) gla_pass2(P, lds, u, tid); } SEAM(4);
    if (IN(5)) { { pg8::Gemm g{(const bf16*)(P.ws + WS_OA), (const bf16*)(P.ws + WS_WPA), T, D, 512, 0}; pg8::StaticOrder S; S.init(T, D, G, bx); pg8::EpiGate<false> E{MIXED, PROJ + C_MA, NP}; pg8::gemm_phase(lds, g, S, E); }
                 { pg8::Gemm g{(const bf16*)(P.ws + WS_OB), (const bf16*)(P.ws + WS_WPB), T, D, D, 0}; pg8::StaticOrder S; S.init(T, D, G, bx); pg8::EpiGate<true> E{MIXED, PROJ + C_MB, NP}; pg8::gemm_phase(lds, g, S, E); } } SEAM(5);
    if (IN(6)) { pg8::Gemm g{MIXED, (const bf16*)(P.ws + WS_WOUT), T, D, D, 0}; pg8::StaticOrder S; S.init(T, D, G, bx); pg8::EpiResF32 E{P.x, P.out}; pg8::gemm_phase(lds, g, S, E); } SEAM(6);
#elif BRINGUP == 2
    if (IN(6)) { for (size_t idx = (size_t)vcu * 512 + tid; idx < (size_t)T * D / 4; idx += (size_t)G * 512) ((f32x4*)P.out)[idx] = ((const f32x4*)P.x)[idx]; } SEAM(6);
#endif
#if BRINGUP != 1
    if (IN(7)) { router_phase(P, lds, G, tid); } SEAM(7);
    if (IN(8)) { moe_gather(P, lds, vcu, G, tid); } SEAM(8);
    if (IN(9)) { LAS int* ts = (LAS int*)(lds + TBL_OFF); moe_tables(P, ts, tid);
        pg8::Gemm g{(const bf16*)(P.ws + WS_XG), (const bf16*)(P.ws + WS_WUP), 0, 2048, D, (size_t)2048 * 1024}; pg8::MoeOrder S; S.init(ts[32] * 256, 2048, G, bx); S.ts = ts;
        pg8::EpiSwiGLU E{(bf16*)(P.ws + WS_ACT), P.bup}; pg8::gemm_phase(lds, g, S, E); } SEAM(9);
    if (IN(10)) { LAS int* ts = (LAS int*)(lds + TBL_OFF); moe_tables(P, ts, tid);
        pg8::Gemm g{(const bf16*)(P.ws + WS_ACT), (const bf16*)(P.ws + WS_WDN), 0, D, D, (size_t)1024 * 1024}; pg8::MoeOrder S; S.init(ts[32] * 256, D, G, bx); S.ts = ts;
        pg8::EpiStoreBf16 E{(bf16*)(P.ws + WS_YB), D, P.bdn, 1024}; pg8::gemm_phase(lds, g, S, E); } SEAM(10);
#endif
    if (IN(11)) { final_phase(P, vcu, G, tid); }
#undef IN
#undef SEAM
}

extern "C" void kernel_launch(void* const* d_in, const int* in_sizes, int n_in, void* d_out, int out_size, void* d_ws, size_t ws_size, hipStream_t stream) {
    static int grid = 0;
    if (grid == 0) {
        if (n_in != 17 || out_size != T * D || ws_size < WS_END) { fprintf(stderr, "kernel_launch: unexpected shapes (n_in %d out %d ws %zu, need %zu)\n", n_in, out_size, ws_size, (size_t)WS_END); grid = -1; return; }
        int dev = 0, cus = 0;
        if (hipGetDevice(&dev) != hipSuccess || hipDeviceGetAttribute(&cus, hipDeviceAttributeMultiprocessorCount, dev) != hipSuccess) { grid = -1; return; }
        if (hipFuncSetAttribute((const void*)fwd, hipFuncAttributeMaxDynamicSharedMemorySize, LDS_BYTES) != hipSuccess) { grid = -1; return; }
        int per_cu = 0; (void)hipOccupancyMaxActiveBlocksPerMultiprocessor(&per_cu, (const void*)fwd, 512, LDS_BYTES); (void)hipGetLastError();
        grid = cus;
    }
    if (grid < 0) return;
    (void)hipMemsetAsync((char*)d_ws + WS_CTL, 0, CTL_ZERO_BYTES, stream);
    Args a{};
    for (int i = 0; i < 17; ++i) a.in[i] = (const float*)d_in[i];
    a.out = (float*)d_out; a.ws = (unsigned char*)d_ws;
    if (MK_N_LAUNCHES == 1) { a.ph_lo = 0; a.ph_hi = N_PHASES; hipLaunchKernelGGL(fwd, dim3(grid), dim3(512), LDS_BYTES, stream, a); }
    else { for (int p = 0; p < N_PHASES; ++p) { a.ph_lo = p; a.ph_hi = p + 1; hipLaunchKernelGGL(fwd, dim3(grid), dim3(512), LDS_BYTES, stream, a); } }
}
```

```cpp
#include <hip/hip_runtime.h>
#include <cstdio>
#include <cstdint>

#ifndef MK_N_LAUNCHES
#define MK_N_LAUNCHES 1
#endif
#ifndef DUP_MASK
#define DUP_MASK 0
#endif
#ifndef BRINGUP
#define BRINGUP 0
#endif

#define DI __device__ __forceinline__
#define LAS __attribute__((address_space(3)))
#define GAS __attribute__((address_space(1)))
typedef unsigned short bf16;
typedef short bf16x8 __attribute__((ext_vector_type(8)));
typedef short s16x4 __attribute__((ext_vector_type(4)));
typedef short v4i16_t __attribute__((ext_vector_type(4)));
typedef float f32x4 __attribute__((ext_vector_type(4)));
typedef float f32x2 __attribute__((ext_vector_type(2)));
typedef unsigned u32x4 __attribute__((ext_vector_type(4)));
typedef unsigned u32x2 __attribute__((ext_vector_type(2)));
typedef __bf16 bf16v2 __attribute__((ext_vector_type(2)));
typedef GAS unsigned gu32;
#define RLX_AGENT __ATOMIC_RELAXED, __HIP_MEMORY_SCOPE_AGENT
#define LDS_WAIT() asm volatile("s_waitcnt lgkmcnt(0)" ::: "memory")
#define VM_WAIT() asm volatile("s_waitcnt vmcnt(0)" ::: "memory")

DI unsigned pk2(float a, float b) { bf16v2 v; v.x = (__bf16)a; v.y = (__bf16)b; return __builtin_bit_cast(unsigned, v); }
DI float bflo(unsigned w) { return __uint_as_float(w << 16); }
DI float bfhi(unsigned w) { return __uint_as_float(w & 0xffff0000u); }
DI float bf2f(bf16 b) { return __uint_as_float(((unsigned)b) << 16); }
DI bf16 f2bf(float f) { return (bf16)(pk2(f, 0.f) & 0xffffu); }
DI float sigmoidf_fast(float z) { return __builtin_amdgcn_rcpf(1.0f + __builtin_amdgcn_exp2f(-1.4426950408889634f * z)); }
DI bf16x8 cat8(s16x4 lo, s16x4 hi) { bf16x8 r; r[0] = lo[0]; r[1] = lo[1]; r[2] = lo[2]; r[3] = lo[3]; r[4] = hi[0]; r[5] = hi[1]; r[6] = hi[2]; r[7] = hi[3]; return r; }
#define MFMA16(a, b, c) __builtin_amdgcn_mfma_f32_16x16x32_bf16((a), (b), (c), 0, 0, 0)

constexpr int T = 32768, SEQ = 16384, D = 1024, NP = 10240, IN_W = 9744;
constexpr int C_GQ = 4608, C_GK = 5120, C_GV = 5632, C_GOG = 6656, C_GF = 7680, C_MA = 8192, C_MB = 9216;
constexpr int NEXP = 32, NASG = T * 4, MAXTILES = 544;
constexpr float RMS_EPS = 1e-5f;

namespace pg8 {
#define PG8_LAS __attribute__((address_space(3)))
typedef unsigned short bf16_t;
constexpr int BM = 256, BK = 64, HALF = 128, HTB = HALF * BK * 2, STAGE_BYTES = 8 * HTB, NXCD = 8, WGM = 8;
__host__ __device__ __forceinline__ int lds_byte(int r, int c) { const int st = (r >> 4) * 2 + (c >> 5), rr = r & 15, cc = c & 31, ob = rr * 64 + cc * 2; return st * 1024 + (ob ^ (((ob >> 9) & 1) << 5)); }
__host__ __device__ __forceinline__ void stage_rc(int b, int& R, int& C) { const int st = b / 1024, sb = b % 1024, swz = sb ^ (((sb >> 9) & 1) << 5); R = (st >> 1) * 16 + swz / 64; C = (st & 1) * 32 + (swz % 64) / 2; }
__host__ __device__ __forceinline__ int perm32(int rho) { const int n = rho >> 4, i = rho & 15; return 8 * (i >> 2) + 4 * n + (i & 3); }

struct Unit { int pm, pn, e; };
struct Gemm { const bf16_t* A; const bf16_t* Bt; int M, N, K; size_t bstride; const PG8_LAS unsigned short* lt; };

struct StaticOrder {
    int nM, nN, nwg, G, c;
    __host__ __device__ void init(int M, int N, int G_, int c_) { nM = M / BM; nN = N / BM; nwg = nM * nN; G = G_; c = c_; }
    __host__ __device__ bool next(int i, Unit& u) const {
        const long L = (long)i * G + c; if (L >= nwg) return false;
        int wgid = (int)L; { const int q = nwg / NXCD, r = nwg % NXCD, xcd = wgid % NXCD, off = wgid / NXCD; wgid = (xcd < r ? xcd * (q + 1) : r * (q + 1) + (xcd - r) * q) + off; }
        const int nig = WGM * nN, gid = wgid / nig, fm = gid * WGM, gsz = (nM - fm) < WGM ? (nM - fm) : WGM;
        u.pm = fm + ((wgid % nig) % gsz); u.pn = (wgid % nig) / gsz; u.e = 0; return true;
    }
};
struct MoeOrder : StaticOrder {
    const PG8_LAS int* ts;
    __device__ __forceinline__ bool next(int i, Unit& u) const {
        if (!StaticOrder::next(i, u)) return false;
        int e = 0;
#pragma unroll 1
        while (e < 31 && u.pm >= ts[e + 1]) ++e;
        u.e = e; return true;
    }
};

struct EpiStoreBf16 {
    static constexpr bool PERM = true;
    bf16_t* O; int ldc; const float* bias; int bias_estride;
    __device__ __forceinline__ void operator()(const f32x4 (&acc)[2][2][4][2], const Unit& u, int wr, int wc, int fr, int fq) const {
        const int row0 = u.pm * BM + wr * 64 + fr, col0 = u.pn * BM + wc * 32 + 8 * fq;
        f32x4 bv[2][2];
#pragma unroll
        for (int bj = 0; bj < 2; ++bj)
#pragma unroll
            for (int n = 0; n < 2; ++n) bv[bj][n] = bias ? *(const f32x4*)(bias + (size_t)u.e * bias_estride + col0 + bj * HALF + 4 * n) : (f32x4){0.f, 0.f, 0.f, 0.f};
#pragma unroll
        for (int ai = 0; ai < 2; ++ai)
#pragma unroll
            for (int m = 0; m < 4; ++m) { bf16_t* rowp = O + (size_t)(row0 + ai * HALF + m * 16) * ldc + col0;
#pragma unroll
                for (int bj = 0; bj < 2; ++bj) { const f32x4 v0 = acc[ai][bj][m][0] + bv[bj][0], v1 = acc[ai][bj][m][1] + bv[bj][1];
                    u32x4 w; w.x = pk2(v0[0], v0[1]); w.y = pk2(v0[2], v0[3]); w.z = pk2(v1[0], v1[1]); w.w = pk2(v1[2], v1[3]);
                    *(u32x4*)(rowp + bj * HALF) = w; } }
    }
};
template <bool ADD> struct EpiGate {
    static constexpr bool PERM = true;
    bf16_t* O; const bf16_t* G; int ldg;
    __device__ __forceinline__ void operator()(const f32x4 (&acc)[2][2][4][2], const Unit& u, int wr, int wc, int fr, int fq) const {
        const int row0 = u.pm * BM + wr * 64 + fr, col0 = u.pn * BM + wc * 32 + 8 * fq;
#pragma unroll
        for (int ai = 0; ai < 2; ++ai)
#pragma unroll
            for (int m = 0; m < 4; ++m) { const size_t r = (size_t)(row0 + ai * HALF + m * 16);
#pragma unroll
                for (int bj = 0; bj < 2; ++bj) { const u32x4 gw = *(const u32x4*)(G + r * ldg + col0 + bj * HALF);
                    u32x4 ow = {0u, 0u, 0u, 0u}; if (ADD) ow = *(const u32x4*)(O + r * D + col0 + bj * HALF);
                    const f32x4 v0 = acc[ai][bj][m][0], v1 = acc[ai][bj][m][1]; u32x4 w;
                    w.x = pk2((ADD ? bflo(ow.x) : 0.f) + sigmoidf_fast(bflo(gw.x)) * v0[0], (ADD ? bfhi(ow.x) : 0.f) + sigmoidf_fast(bfhi(gw.x)) * v0[1]);
                    w.y = pk2((ADD ? bflo(ow.y) : 0.f) + sigmoidf_fast(bflo(gw.y)) * v0[2], (ADD ? bfhi(ow.y) : 0.f) + sigmoidf_fast(bfhi(gw.y)) * v0[3]);
                    w.z = pk2((ADD ? bflo(ow.z) : 0.f) + sigmoidf_fast(bflo(gw.z)) * v1[0], (ADD ? bfhi(ow.z) : 0.f) + sigmoidf_fast(bfhi(gw.z)) * v1[1]);
                    w.w = pk2((ADD ? bflo(ow.w) : 0.f) + sigmoidf_fast(bflo(gw.w)) * v1[2], (ADD ? bfhi(ow.w) : 0.f) + sigmoidf_fast(bfhi(gw.w)) * v1[3]);
                    *(u32x4*)(O + r * D + col0 + bj * HALF) = w; } }
    }
};
struct EpiResF32 {
    static constexpr bool PERM = false;
    const float* base; float* C;
    __device__ __forceinline__ void operator()(const f32x4 (&acc)[2][2][4][2], const Unit& u, int wr, int wc, int fr, int fq) const {
        const int row0 = u.pm * BM + wr * 64 + fr, col0 = u.pn * BM + wc * 32 + 4 * fq;
#pragma unroll
        for (int ai = 0; ai < 2; ++ai)
#pragma unroll
            for (int m = 0; m < 4; ++m) { const size_t off = (size_t)(row0 + ai * HALF + m * 16) * D + col0;
#pragma unroll
                for (int bj = 0; bj < 2; ++bj)
#pragma unroll
                    for (int n = 0; n < 2; ++n) *(f32x4*)(C + off + bj * HALF + n * 16) = *(const f32x4*)(base + off + bj * HALF + n * 16) + acc[ai][bj][m][n]; }
    }
};
struct EpiSwiGLU8 {
    static constexpr bool PERM = true;
    unsigned char* O; const float* bup; const float* cs;
    __device__ __forceinline__ void operator()(const f32x4 (&acc)[2][2][4][2], const Unit& u, int wr, int wc, int fr, int fq) const {
        const int row0 = u.pm * BM + wr * 64 + fr, x0 = wc * 32 + 8 * fq;
        const float* bg = bup + (size_t)u.e * 2048 + u.pn * 128 + x0; const float* bl = bg + 1024;
        const float* sg = cs + (size_t)u.e * 2048 + u.pn * 256 + x0; const float* sl = sg + 128;
        const f32x4 bgv[2] = {*(const f32x4*)bg, *(const f32x4*)(bg + 4)}, blv[2] = {*(const f32x4*)bl, *(const f32x4*)(bl + 4)};
        const f32x4 sgv[2] = {*(const f32x4*)sg, *(const f32x4*)(sg + 4)}, slv[2] = {*(const f32x4*)sl, *(const f32x4*)(sl + 4)};
#pragma unroll
        for (int ai = 0; ai < 2; ++ai)
#pragma unroll
            for (int m = 0; m < 4; ++m) { float r[8];
#pragma unroll
                for (int n = 0; n < 2; ++n) { const f32x4 gv = acc[ai][0][m][n] * sgv[n] + bgv[n], lv = acc[ai][1][m][n] * slv[n] + blv[n];
#pragma unroll
                    for (int j = 0; j < 4; ++j) { const float xg = fminf(gv[j], 7.0f), xl = fminf(fmaxf(lv[j], -7.0f), 7.0f); r[4 * n + j] = xg * sigmoidf_fast(1.702f * xg) * (xl + 1.0f); } }
                int w0 = 0, w1 = 0;
                w0 = __builtin_amdgcn_cvt_pk_fp8_f32(r[0], r[1], w0, false); w0 = __builtin_amdgcn_cvt_pk_fp8_f32(r[2], r[3], w0, true);
                w1 = __builtin_amdgcn_cvt_pk_fp8_f32(r[4], r[5], w1, false); w1 = __builtin_amdgcn_cvt_pk_fp8_f32(r[6], r[7], w1, true);
                u32x2 w; w.x = (unsigned)w0; w.y = (unsigned)w1;
                *(u32x2*)(O + (size_t)(row0 + ai * HALF + m * 16) * D + u.pn * 128 + x0) = w; }
    }
};
struct EpiDown8 {
    static constexpr bool PERM = true;
    bf16_t* O; const float* bias; const float* cs;
    __device__ __forceinline__ void operator()(const f32x4 (&acc)[2][2][4][2], const Unit& u, int wr, int wc, int fr, int fq) const {
        const int row0 = u.pm * BM + wr * 64 + fr, col0 = u.pn * BM + wc * 32 + 8 * fq;
        f32x4 bv[2][2], sv[2][2];
#pragma unroll
        for (int bj = 0; bj < 2; ++bj)
#pragma unroll
            for (int n = 0; n < 2; ++n) { bv[bj][n] = *(const f32x4*)(bias + (size_t)u.e * D + col0 + bj * HALF + 4 * n); sv[bj][n] = *(const f32x4*)(cs + (size_t)u.e * D + col0 + bj * HALF + 4 * n); }
#pragma unroll
        for (int ai = 0; ai < 2; ++ai)
#pragma unroll
            for (int m = 0; m < 4; ++m) { bf16_t* rowp = O + (size_t)(row0 + ai * HALF + m * 16) * D + col0;
#pragma unroll
                for (int bj = 0; bj < 2; ++bj) { const f32x4 v0 = acc[ai][bj][m][0] * sv[bj][0] + bv[bj][0], v1 = acc[ai][bj][m][1] * sv[bj][1] + bv[bj][1];
                    u32x4 w; w.x = pk2(v0[0], v0[1]); w.y = pk2(v0[2], v0[3]); w.z = pk2(v1[0], v1[1]); w.w = pk2(v1[2], v1[3]);
                    *(u32x4*)(rowp + bj * HALF) = w; } }
    }
};

typedef int v8i_t __attribute__((ext_vector_type(8)));
typedef int v4i_t __attribute__((ext_vector_type(4)));
template <class Epi, class Sched, int DT = 0, bool GATHER = false, bool ALIGN_EPI = true, bool SP2 = true>
__device__ __forceinline__ void gemm_phase(PG8_LAS unsigned char* lds, const Gemm g, const Sched& S, const Epi& E) {
    const int tid = threadIdx.x, wid = __builtin_amdgcn_readfirstlane(tid >> 6), lane = tid & 63, wr = wid >> 2, wc = wid & 3, fr = lane & 15, fq = lane >> 4;
    const int K = g.K, nt = K / BK;
    unsigned voffA[2], voffB[2]; int gR[2], gC[2];
#pragma unroll
    for (int i = 0; i < 2; ++i) { int R, C; stage_rc(tid * 16 + i * 8192, R, C); const int Rb = Epi::PERM ? ((R & ~31) + perm32(R & 31)) : R;
        voffA[i] = (unsigned)(R * K + C) * 2u; voffB[i] = (unsigned)(Rb * K + C) * 2u; gR[i] = R; gC[i] = C * 2; }
    unsigned offC[2][2], offN[2][2];
#define PG8_GOFF(dst, uidx) do { _Pragma("unroll") for (int _h = 0; _h < 2; ++_h) _Pragma("unroll") for (int _i = 0; _i < 2; ++_i) \
        dst[_h][_i] = (unsigned)g.lt[(uidx) * 256 + _h * 128 + gR[_i]] * (unsigned)(K * 2) + (unsigned)gC[_i]; } while (0)
    const size_t kstep = (size_t)(BK * 2), hstep = (size_t)HALF * K * 2, tstep = 2 * hstep, estep = g.bstride * 2;
    const unsigned ldsw = (unsigned)wid * 1024u;
    const int aoff = lds_byte(wr * 64 + fr, fq * 8), boff = lds_byte(wc * 32 + fr, fq * 8);
#define PG8_SA(b, h) (((b) * 2 + (h)) * HTB)
#define PG8_SB(b, h) ((4 + (b) * 2 + (h)) * HTB)
#define PG8_STAGE(bufoff, gbase, voff) do { _Pragma("unroll") for (int _i = 0; _i < 2; ++_i) \
        __builtin_amdgcn_global_load_lds((const unsigned*)((const char*)(gbase) + (voff)[_i]), (PG8_LAS unsigned*)(lds + (bufoff) + ldsw + _i * 8192), 16, 0, 0); } while (0)
#define PG8_LDA(dst, b, h) do { if constexpr (DT == 1) { _Pragma("unroll") for (int m = 0; m < 4; ++m) dst##8[m] = __builtin_shufflevector(*(const PG8_LAS v4i_t*)(lds + PG8_SA(b, h) + aoff + m * 2048), *(const PG8_LAS v4i_t*)(lds + PG8_SA(b, h) + aoff + m * 2048 + 1024), 0, 1, 2, 3, 4, 5, 6, 7); } \
        else { _Pragma("unroll") for (int m = 0; m < 4; ++m) _Pragma("unroll") for (int k = 0; k < 2; ++k) dst[m][k] = *(const PG8_LAS bf16x8*)(lds + PG8_SA(b, h) + aoff + m * 2048 + k * 1024); } } while (0)
#define PG8_LDB(dst, b, h) do { if constexpr (DT == 1) { _Pragma("unroll") for (int n = 0; n < 2; ++n) dst##8[n] = __builtin_shufflevector(*(const PG8_LAS v4i_t*)(lds + PG8_SB(b, h) + boff + n * 2048), *(const PG8_LAS v4i_t*)(lds + PG8_SB(b, h) + boff + n * 2048 + 1024), 0, 1, 2, 3, 4, 5, 6, 7); } \
        else { _Pragma("unroll") for (int n = 0; n < 2; ++n) _Pragma("unroll") for (int k = 0; k < 2; ++k) dst[n][k] = *(const PG8_LAS bf16x8*)(lds + PG8_SB(b, h) + boff + n * 2048 + k * 1024); } } while (0)
#define PG8_MMA(ai, bj, At, Bt) do { __builtin_amdgcn_s_setprio(1); if constexpr (DT == 1) { _Pragma("unroll") for (int m = 0; m < 4; ++m) _Pragma("unroll") for (int n = 0; n < 2; ++n) \
        asm volatile("v_mfma_scale_f32_16x16x128_f8f6f4 %0, %1, %2, %0, %3, %3 op_sel_hi:[0,0,0]" : "+v"(acc[ai][bj][m][n]) : "v"(Bt##8[n]), "v"(At##8[m]), "v"(sc1)); } \
        else { _Pragma("unroll") for (int m = 0; m < 4; ++m) _Pragma("unroll") for (int n = 0; n < 2; ++n) _Pragma("unroll") for (int k = 0; k < 2; ++k) \
        acc[ai][bj][m][n] = __builtin_amdgcn_mfma_f32_16x16x32_bf16(Bt[n][k], At[m][k], acc[ai][bj][m][n], 0, 0, 0); } __builtin_amdgcn_s_setprio(0); } while (0)
#define PG8_STAGE_A(bufoff, h, which) do { if constexpr (GATHER) { _Pragma("unroll") for (int _i = 0; _i < 2; ++_i) { \
            const unsigned _o = ((which) == 1) ? offC[h][_i] : (last ? offN[h][_i] : offC[h][_i]); const size_t _kb = ((which) == 1) ? (size_t)(t + 1) * kstep : ((last ? (size_t)0 : (size_t)(t + 2) * kstep) + ((which) == 3 ? kstep : 0)); \
            __builtin_amdgcn_global_load_lds((const unsigned*)((const char*)g.A + _kb + _o), (PG8_LAS unsigned*)(lds + (bufoff) + ldsw + _i * 8192), 16, 0, 0); } } \
        else { const char* _p = ((which) == 1 ? a1 : ((which) == 2 ? a2 : a3)) + (h) * hstep; PG8_STAGE(bufoff, _p, voffA); } } while (0)
#define PG8_WAIT_V(n) asm volatile("s_waitcnt vmcnt(" #n ")" ::: "memory")
#define PG8_WAIT_L(n) asm volatile("s_waitcnt lgkmcnt(" #n ")" ::: "memory")
#define PG8_BAR __builtin_amdgcn_s_barrier()
#define PG8_SCHED __builtin_amdgcn_sched_barrier(0)
    static_assert(!GATHER || SP2, "GATHER is written for the SP2 loop");
    Unit cur, nxt; int ui = 0;
    if (!S.next(0, cur)) return;
    f32x4 acc[2][2][4][2];
#pragma unroll
    for (int a = 0; a < 2; ++a)
#pragma unroll
        for (int b = 0; b < 2; ++b)
#pragma unroll
            for (int m = 0; m < 4; ++m)
#pragma unroll
                for (int n = 0; n < 2; ++n) acc[a][b][m][n] = (f32x4){0.f, 0.f, 0.f, 0.f};
    bf16x8 At[4][2], B0[2][2], B1[2][2]; v8i_t At8[4], B08[2], B18[2];
    int sc1 = 0x7F7F7F7F; asm volatile("" : "+v"(sc1));
    const char* cA = GATHER ? (const char*)g.A : (const char*)g.A + (size_t)cur.pm * tstep; const char* cB = (const char*)g.Bt + (size_t)cur.e * estep + (size_t)cur.pn * tstep;
    if constexpr (GATHER) { PG8_GOFF(offC, 0); }
#define PG8_STAGE_A0(bufoff, h, kb) do { if constexpr (GATHER) { _Pragma("unroll") for (int _i = 0; _i < 2; ++_i) \
            __builtin_amdgcn_global_load_lds((const unsigned*)((const char*)g.A + (size_t)(kb) + offC[h][_i]), (PG8_LAS unsigned*)(lds + (bufoff) + ldsw + _i * 8192), 16, 0, 0); } \
        else PG8_STAGE(bufoff, cA + (h) * hstep + (kb), voffA); } while (0)
    if constexpr (SP2) {
        PG8_STAGE(PG8_SB(0, 0), cB, voffB); PG8_STAGE(PG8_SB(0, 1), cB + hstep, voffB); PG8_STAGE_A0(PG8_SA(0, 0), 0, 0); PG8_STAGE_A0(PG8_SA(0, 1), 1, 0);
        if (wr == 1) PG8_BAR;
        PG8_WAIT_V(2); PG8_BAR;
        PG8_STAGE(PG8_SB(1, 0), cB + kstep, voffB); PG8_STAGE_A0(PG8_SA(1, 0), 0, kstep); PG8_STAGE(PG8_SB(1, 1), cB + hstep + kstep, voffB);
        PG8_WAIT_V(6); PG8_BAR;
    } else {
        PG8_STAGE(PG8_SB(0, 0), cB, voffB); PG8_STAGE(PG8_SA(0, 0), cA, voffA); PG8_STAGE(PG8_SB(0, 1), cB + hstep, voffB); PG8_STAGE(PG8_SA(0, 1), cA + hstep, voffA);
        if (wr == 1) PG8_BAR;
        PG8_WAIT_V(4); PG8_BAR;
        PG8_STAGE(PG8_SB(1, 0), cB + kstep, voffB); PG8_STAGE(PG8_SA(1, 0), cA + kstep, voffA); PG8_STAGE(PG8_SB(1, 1), cB + hstep + kstep, voffB);
        PG8_WAIT_V(6); PG8_BAR;
    }
    for (;;) {
        const bool has_next = S.next(ui + 1, nxt);
        const char* nA = (has_next && !GATHER) ? (const char*)g.A + (size_t)nxt.pm * tstep : cA; const char* nB = has_next ? (const char*)g.Bt + (size_t)nxt.e * estep + (size_t)nxt.pn * tstep : cB;
        if constexpr (GATHER) { if (has_next) { PG8_GOFF(offN, ui + 1); } else {
#pragma unroll
            for (int _h = 0; _h < 2; ++_h) { offN[_h][0] = offC[_h][0]; offN[_h][1] = offC[_h][1]; } } }
#pragma unroll 1
        for (int t = 0; t < nt; t += 2) {
            const bool last = (t == nt - 2);
            const char* a1 = cA + (size_t)(t + 1) * kstep;
            const char* a2 = last ? nA : cA + (size_t)(t + 2) * kstep; const char* b2 = last ? nB : cB + (size_t)(t + 2) * kstep;
            const char* a3 = a2 + kstep; const char* b3 = b2 + kstep;
            if constexpr (SP2) {
            PG8_LDB(B0, 0, 0); PG8_LDB(B1, 0, 1); PG8_SCHED; PG8_LDA(At, 0, 0); PG8_STAGE_A(PG8_SA(1, 1), 1, 1);
            PG8_WAIT_V(8); PG8_WAIT_L(0); PG8_BAR; PG8_MMA(0, 0, At, B0); PG8_MMA(0, 1, At, B1); PG8_BAR; PG8_SCHED;
            PG8_LDA(At, 0, 1); PG8_STAGE(PG8_SB(0, 0), b2, voffB); PG8_STAGE(PG8_SB(0, 1), b2 + hstep, voffB); PG8_STAGE_A(PG8_SA(0, 0), 0, 2);
            PG8_WAIT_V(8); PG8_WAIT_L(0); PG8_BAR; PG8_MMA(1, 0, At, B0); PG8_MMA(1, 1, At, B1); PG8_BAR; PG8_SCHED;
            PG8_LDB(B0, 1, 0); PG8_LDB(B1, 1, 1); PG8_SCHED; PG8_LDA(At, 1, 0); PG8_STAGE_A(PG8_SA(0, 1), 1, 2);
            PG8_WAIT_V(8); PG8_WAIT_L(0); PG8_BAR; PG8_MMA(0, 0, At, B0); PG8_MMA(0, 1, At, B1); PG8_BAR; PG8_SCHED;
            PG8_LDA(At, 1, 1); PG8_STAGE(PG8_SB(1, 0), b3, voffB); PG8_STAGE(PG8_SB(1, 1), b3 + hstep, voffB); PG8_STAGE_A(PG8_SA(1, 0), 0, 3);
            PG8_WAIT_V(8); PG8_WAIT_L(0); PG8_BAR; PG8_MMA(1, 0, At, B0); PG8_MMA(1, 1, At, B1); PG8_BAR; PG8_SCHED;
            } else {
            PG8_LDB(B0, 0, 0); PG8_SCHED; PG8_LDA(At, 0, 0); PG8_STAGE(PG8_SA(1, 1), a1 + hstep, voffA);
            PG8_WAIT_L(8); PG8_BAR; PG8_WAIT_L(0); PG8_MMA(0, 0, At, B0); PG8_BAR; PG8_SCHED;
            PG8_LDB(B1, 0, 1); PG8_STAGE(PG8_SB(0, 0), b2, voffB);
            PG8_BAR; PG8_WAIT_L(0); PG8_MMA(0, 1, At, B1); PG8_BAR;
            PG8_LDA(At, 0, 1); PG8_STAGE(PG8_SA(0, 0), a2, voffA);
            PG8_BAR; PG8_WAIT_L(0); PG8_MMA(1, 0, At, B0); PG8_BAR; PG8_SCHED;
            PG8_STAGE(PG8_SB(0, 1), b2 + hstep, voffB);
            PG8_WAIT_V(6); PG8_BAR; PG8_MMA(1, 1, At, B1); PG8_BAR;
            PG8_LDB(B0, 1, 0); PG8_SCHED; PG8_LDA(At, 1, 0); PG8_STAGE(PG8_SA(0, 1), a2 + hstep, voffA);
            PG8_WAIT_L(8); PG8_BAR; PG8_WAIT_L(0); PG8_MMA(0, 0, At, B0); PG8_BAR; PG8_SCHED;
            PG8_LDB(B1, 1, 1); PG8_STAGE(PG8_SB(1, 0), b3, voffB);
            PG8_BAR; PG8_WAIT_L(0); PG8_MMA(0, 1, At, B1); PG8_BAR;
            PG8_LDA(At, 1, 1); PG8_STAGE(PG8_SA(1, 0), a3, voffA);
            PG8_BAR; PG8_WAIT_L(0); PG8_MMA(1, 0, At, B0); PG8_BAR; PG8_SCHED;
            PG8_STAGE(PG8_SB(1, 1), b3 + hstep, voffB);
            PG8_WAIT_V(6); PG8_BAR; PG8_MMA(1, 1, At, B1); PG8_BAR;
            }
        }
        if constexpr (DT == 1) asm volatile("s_nop 15\n\ts_nop 15\n\ts_nop 7" ::: "memory");
        if constexpr (ALIGN_EPI) { if (wr == 0) PG8_BAR; }
        E(acc, cur, wr, wc, fr, fq);
        if (!has_next) break;
#pragma unroll
        for (int a = 0; a < 2; ++a)
#pragma unroll
            for (int b = 0; b < 2; ++b)
#pragma unroll
                for (int m = 0; m < 4; ++m)
#pragma unroll
                    for (int n = 0; n < 2; ++n) acc[a][b][m][n] = (f32x4){0.f, 0.f, 0.f, 0.f};
        cur = nxt; cA = nA; cB = nB; ++ui;
        if constexpr (GATHER) {
#pragma unroll
            for (int _h = 0; _h < 2; ++_h) { offC[_h][0] = offN[_h][0]; offC[_h][1] = offN[_h][1]; } }
        if constexpr (ALIGN_EPI) { if (wr == 1) PG8_BAR; }
    }
    PG8_WAIT_V(0);
    if constexpr (!ALIGN_EPI) { if (wr == 0) PG8_BAR; }
    PG8_BAR;
#undef PG8_SA
#undef PG8_SB
#undef PG8_STAGE
#undef PG8_STAGE_A
#undef PG8_STAGE_A0
#undef PG8_GOFF
#undef PG8_LDA
#undef PG8_LDB
#undef PG8_MMA
#undef PG8_WAIT_V
#undef PG8_WAIT_L
#undef PG8_BAR
#undef PG8_SCHED
}
}

constexpr size_t MiB = 1u << 20;
constexpr size_t WS_CTL = 0, CTL_ZERO_BYTES = 1 * MiB;
constexpr size_t WS_ASG_E = 1 * MiB, WS_ASG_SLOT = WS_ASG_E + (size_t)NASG * 4, WS_ASG_G = WS_ASG_SLOT + (size_t)NASG * 4, WS_ASG_ROW = WS_ASG_G + (size_t)NASG * 4;
constexpr size_t WS_WRT = 3 * MiB;
constexpr size_t WS_SUP = WS_WRT + 64 * 1024, WS_SDN = WS_SUP + 32 * 2048 * 4;
constexpr size_t WS_ROWTOK = WS_SDN + 32 * 1024 * 4;
constexpr size_t WS_WPA = 4 * MiB, WS_WPB = 5 * MiB, WS_WOUT = 7 * MiB, WS_WIN = 9 * MiB;
constexpr size_t WS_WUP = 29 * MiB, WS_WDN = 93 * MiB;
constexpr size_t WS_XN = 125 * MiB;
constexpr size_t WS_GSTATE = WS_XN, WS_GDEC = WS_XN + 32 * MiB;
constexpr size_t WS_OA = 189 * MiB, WS_OB = 221 * MiB;
constexpr size_t WS_HN = WS_OB;
constexpr size_t WS_PROJ = 285 * MiB;
constexpr size_t WS_ACT = WS_PROJ, WS_YB = WS_PROJ + 136 * MiB;
constexpr size_t WS_END = 925 * MiB;
static_assert(WS_ROWTOK + (size_t)MAXTILES * 256 * 4 <= WS_WPA && WS_PROJ + (size_t)T * NP * 2 == WS_END && WS_YB + (size_t)MAXTILES * 256 * D * 2 <= WS_END && (size_t)MAXTILES * 256 * D <= 136 * MiB, "d_ws map");
constexpr size_t OUT_OG = 0, OUT_LSE = 96 * MiB;
constexpr int CW_BAR = 4096, CW_CNT = 512;
constexpr int RING_BYTES = 131072, MISC_OFF = RING_BYTES, TBL_OFF = RING_BYTES + 512, LDS_BYTES = 147456;

#define XB_TMO      128
#define XB_XCNT(j)  (256  + 64 * (j))
#define XB_XSUB(j)  (1280 + 64 * (j))
#define XB_XGEN(j)  (2304 + 64 * (j))
#define XB_TOP      3328
#define XB_TOPGEN   3392
#define XCD_BAR_WORDS 3456
#define XB_SPIN_CAP (1u << 18)
__device__ __forceinline__ unsigned xb_ld(unsigned* p)              { return __hip_atomic_load(p, __ATOMIC_RELAXED, __HIP_MEMORY_SCOPE_AGENT); }
__device__ __forceinline__ unsigned xb_add(unsigned* p, unsigned v) { return __hip_atomic_fetch_add(p, v, __ATOMIC_RELAXED, __HIP_MEMORY_SCOPE_AGENT); }
__device__ __forceinline__ unsigned xb_xcc_id() { return (unsigned)__builtin_amdgcn_s_getreg((3 << 11) | 20) & 0xFu; }
#define XB_SPIN(cond, bar) do { unsigned _sp = 0; while (cond) { __builtin_amdgcn_s_sleep(1); \
    if ((++_sp & 255u) == 0u) { if (xb_ld(&(bar)[XB_TMO])) break; if (_sp > XB_SPIN_CAP) { atomicAdd(&(bar)[XB_TMO], 1u); break; } } } } while (0)
struct XcdBarrier { unsigned* bar; unsigned x; volatile LAS unsigned* st; };
__device__ __forceinline__ XcdBarrier xcd_barrier_post(unsigned* bar, volatile LAS unsigned* st) {
    XcdBarrier b; b.bar = bar; b.x = xb_xcc_id(); b.st = st;
    if (threadIdx.x == 0) (void)xb_add(&bar[XB_XCNT(b.x)], 1u);
    return b;
}
__device__ __forceinline__ void xcd_barrier_complete(unsigned* bar, unsigned x, unsigned& nloc, unsigned& nx) {
    const unsigned G = gridDim.x * gridDim.y * gridDim.z;
    unsigned sum, cnt, mine, sp = 0u;
    for (;;) {
        sum = 0u; cnt = 0u; mine = 0u;
#pragma unroll
        for (unsigned j = 0; j < 16; ++j) { const unsigned c = xb_ld(&bar[XB_XCNT(j)]); sum += c; cnt += (c > 0u) ? 1u : 0u; mine = (j == x) ? c : mine; }
        if (sum == G) break;
        __builtin_amdgcn_s_sleep(1);
        if ((++sp & 255u) == 0u) { if (xb_ld(&bar[XB_TMO])) break; if (sp > XB_SPIN_CAP) { atomicAdd(&bar[XB_TMO], 1u); break; } }
    }
    nloc = mine > 0u ? mine : 1u; nx = cnt > 0u ? cnt : 1u;
}
__device__ __forceinline__ void xcd_barrier(const XcdBarrier& b) {
    asm volatile("s_waitcnt vmcnt(0)" ::: "memory");
    __syncthreads();
    if (threadIdx.x == 0) {
        unsigned* bar = b.bar;
        __builtin_amdgcn_s_waitcnt(0);
        unsigned nloc = b.st[0], nx = b.st[1];
        if (nloc == 0u) { xcd_barrier_complete(bar, b.x, nloc, nx); b.st[0] = nloc; b.st[1] = nx; }
        const unsigned old = xb_add(&bar[XB_XSUB(b.x)], 1u);
        const unsigned gen = old / nloc;
        if (old + 1u == (gen + 1u) * nloc) {
            __builtin_amdgcn_fence(__ATOMIC_RELEASE, "agent");
            asm volatile("s_waitcnt vmcnt(0)" ::: "memory");
            const unsigned og = xb_add(&bar[XB_TOP], 1u);
            const unsigned tg = og / nx;
            if (og + 1u == (tg + 1u) * nx) xb_add(&bar[XB_TOPGEN], 1u);
            else XB_SPIN(xb_ld(&bar[XB_TOPGEN]) == tg, bar);
            __builtin_amdgcn_fence(__ATOMIC_ACQUIRE, "agent");
            xb_add(&bar[XB_XGEN(b.x)], 1u);
            asm volatile("s_waitcnt vmcnt(0)" ::: "memory");
        } else {
            XB_SPIN(xb_ld(&bar[XB_XGEN(b.x)]) == gen, bar);
            __builtin_amdgcn_fence(__ATOMIC_ACQUIRE, "agent");
            asm volatile("s_waitcnt vmcnt(0)" ::: "memory");
        }
    }
    __syncthreads();
}

DI float wave_sum(float v) {
#pragma unroll
    for (int o = 1; o < 64; o <<= 1) v += __shfl_xor(v, o);
    return v;
}
DI unsigned offb(unsigned row, unsigned ch) { return 256u * row + 16u * (ch ^ (((row & 3u) << 2) | ((row >> 2) & 3u))); }
DI s16x4 vtr(const LAS unsigned char* p) { return __builtin_bit_cast(s16x4, __builtin_amdgcn_ds_read_tr16_b64_v4i16((LAS v4i16_t*)p)); }
DI s16x4 tr4(const LAS unsigned char* img, int rowbase, int c, int lane) { const int q = (lane & 15) >> 2, p = lane & 3; return vtr(img + offb((unsigned)(rowbase + q), (unsigned)(2 * c + (p >> 1))) + 8 * (p & 1)); }

struct Ptrs {
    const float *x, *ln1, *w_in, *w_gk2, *b_gk2, *gnorm, *wpa, *wpb, *wout, *ln2, *wr, *br, *wup, *bup, *wdn, *bdn, *lnf;
    float* out; unsigned char* ws; gu32* ctl;
};

DI void p0_tile(const float* W, int ldw, int k0, int sc0, bf16* WT, int K, int dr0, LAS float* scr, int lane) {
#pragma unroll 8
    for (int i = 0; i < 32; ++i) { const int kk = 2 * i + (lane >> 5); scr[kk * 33 + (lane & 31)] = W[(size_t)(k0 + kk) * ldw + sc0 + (lane & 31)]; }
    LDS_WAIT(); asm volatile("" ::: "memory");
    const int c = lane & 7;
#pragma unroll
    for (int j = 0; j < 4; ++j) { const int n = (lane >> 3) + 8 * j; const LAS float* s = scr + (8 * c) * 33 + n;
        u32x4 o; o.x = pk2(s[0 * 33], s[1 * 33]); o.y = pk2(s[2 * 33], s[3 * 33]); o.z = pk2(s[4 * 33], s[5 * 33]); o.w = pk2(s[6 * 33], s[7 * 33]);
        *(u32x4*)(WT + (size_t)(dr0 + n) * K + k0 + 8 * c) = o; }
    LDS_WAIT(); asm volatile("" ::: "memory");
}
DI void rms_row_to_bf16(const float* xrow, const float* w, bf16* orow, int lane) {
    const f32x4* xr = (const f32x4*)xrow + lane; const f32x4* wr = (const f32x4*)w + lane;
    f32x4 v[4]; float s = 0.f;
#pragma unroll
    for (int j = 0; j < 4; ++j) { v[j] = xr[64 * j]; s += (v[j].x * v[j].x + v[j].y * v[j].y) + (v[j].z * v[j].z + v[j].w * v[j].w); }
    const float rstd = 1.f / sqrtf(wave_sum(s) * (1.f / D) + RMS_EPS);
    u32x2* o8 = (u32x2*)orow + lane;
#pragma unroll
    for (int j = 0; j < 4; ++j) { const f32x4 ww = wr[64 * j]; u32x2 o; o.x = pk2(v[j].x * rstd * ww.x, v[j].y * rstd * ww.y); o.y = pk2(v[j].z * rstd * ww.z, v[j].w * rstd * ww.w); o8[64 * j] = o; }
}
constexpr int PMAX_OFF = 131072 + 1024;
DI void p0_quant_item(const float* W, int ldw, int sc0, unsigned char* W8, int dr0, float* sc_out, LAS unsigned char* lds, int tid) {
    const int lane = tid & 63, w = tid >> 6; LAS float* scr = (LAS float*)(lds + w * 16384); LAS float* PM = (LAS float*)(lds + PMAX_OFF);
    const int n = lane & 31; float mx = 0.f;
#pragma unroll 16
    for (int i = 0; i < 64; ++i) { const int kk = 2 * i + (lane >> 5); const float v = W[(size_t)(128 * w + kk) * ldw + sc0 + n]; scr[kk * 32 + ((n + 4 * (kk >> 4)) & 31)] = v; mx = fmaxf(mx, fabsf(v)); }
    mx = fmaxf(mx, __shfl_xor(mx, 32));
    if (lane < 32) PM[w * 32 + lane] = mx;
    __syncthreads();
    const int c = lane & 7, nn = lane >> 3;
#pragma unroll
    for (int j = 0; j < 4; ++j) { const int n2 = nn + 8 * j; float am = 0.f;
#pragma unroll
        for (int w2 = 0; w2 < 8; ++w2) am = fmaxf(am, PM[w2 * 32 + n2]);
        const int ex = (int)((__float_as_uint(am) >> 23) & 0xffu) - 127;
        const float sc = (am > 0.f) ? __uint_as_float((unsigned)(127 + 7 - ex) << 23) : 1.0f, inv = (am > 0.f) ? __uint_as_float((unsigned)(127 - 7 + ex) << 23) : 1.0f;
        if (w == 0 && c == 0) sc_out[dr0 + n2] = inv;
        float v[16];
#pragma unroll
        for (int i = 0; i < 16; ++i) v[i] = scr[(16 * c + i) * 32 + ((n2 + 4 * c) & 31)] * sc;
        int o[4];
#pragma unroll
        for (int q = 0; q < 4; ++q) { int t = 0; t = __builtin_amdgcn_cvt_pk_fp8_f32(v[4 * q], v[4 * q + 1], t, false); t = __builtin_amdgcn_cvt_pk_fp8_f32(v[4 * q + 2], v[4 * q + 3], t, true); o[q] = t; }
        u32x4 ov; ov.x = (unsigned)o[0]; ov.y = (unsigned)o[1]; ov.z = (unsigned)o[2]; ov.w = (unsigned)o[3];
        *(u32x4*)(W8 + (size_t)(dr0 + n2) * 1024 + 128 * w + 16 * c) = ov; }
    __syncthreads();
}
DI void p0_prologue(const Ptrs& P, LAS unsigned char* lds, int vcu, int G, int tid) {
    const int lane = tid & 63, wave = tid >> 6;
    LAS float* scr = (LAS float*)(lds + wave * 16384);
    const int gw = vcu * 8 + wave, NGW = G * 8;
    bf16* WIN_T = (bf16*)(P.ws + WS_WIN); bf16* WPA_T = (bf16*)(P.ws + WS_WPA); bf16* WPB_T = (bf16*)(P.ws + WS_WPB); bf16* WOUT_T = (bf16*)(P.ws + WS_WOUT);
    bf16* WRT = (bf16*)(P.ws + WS_WRT); unsigned char* WUP8 = P.ws + WS_WUP; unsigned char* WDN8 = P.ws + WS_WDN; bf16* XN = (bf16*)(P.ws + WS_XN);
#if BRINGUP != 1
    for (int it = vcu; it < 32 * 64 + 32 * 32; it += G) {
        if (it < 32 * 64) { const int e = it >> 6, nb = it & 63, c0 = 32 * nb; const int dr0 = (c0 < 1024) ? 256 * (c0 >> 7) + (c0 & 127) : 256 * ((c0 - 1024) >> 7) + 128 + (c0 & 127);
            p0_quant_item(P.wup + (size_t)e * 1024 * 2048, 2048, c0, WUP8 + (size_t)e * 2048 * 1024, dr0, (float*)(P.ws + WS_SUP) + e * 2048, lds, tid); }
        else { const int r = it - 32 * 64, e = r >> 5, nb = r & 31;
            p0_quant_item(P.wdn + (size_t)e * 1024 * 1024, 1024, 32 * nb, WDN8 + (size_t)e * 1024 * 1024, 32 * nb, (float*)(P.ws + WS_SDN) + e * 1024, lds, tid); } }
    constexpr int I_IN1 = 16 * 240, I_IN2 = 16 * 64, I_PA = 8 * 32, I_PB = 16 * 32, I_OUT = 16 * 32, I_R = 16;
    constexpr int NITEMS = I_IN1 + I_IN2 + I_PA + I_PB + I_OUT + I_R;
    for (int it = gw; it < NITEMS; it += NGW) {
        int r = it;
        if (r < I_IN1) { const int kb = r / 240, nb = r % 240; p0_tile(P.w_in, IN_W, 64 * kb, 32 * nb, WIN_T, 1024, 32 * nb, scr, lane); continue; } r -= I_IN1;
        if (r < I_IN2) { const int kb = r >> 6, nb = r & 63; p0_tile(P.w_in, IN_W, 64 * kb, 7696 + 32 * nb, WIN_T, 1024, C_MA + 32 * nb, scr, lane); continue; } r -= I_IN2;
        if (r < I_PA) { const int kb = r >> 5, nb = r & 31; p0_tile(P.wpa, 1024, 64 * kb, 32 * nb, WPA_T, 512, 32 * nb, scr, lane); continue; } r -= I_PA;
        if (r < I_PB) { const int kb = r >> 5, nb = r & 31; p0_tile(P.wpb, 1024, 64 * kb, 32 * nb, WPB_T, 1024, 32 * nb, scr, lane); continue; } r -= I_PB;
        if (r < I_OUT) { const int kb = r >> 5, nb = r & 31; p0_tile(P.wout, 1024, 64 * kb, 32 * nb, WOUT_T, 1024, 32 * nb, scr, lane); continue; } r -= I_OUT;
        p0_tile(P.wr, 32, 64 * r, 0, WRT, 1024, 0, scr, lane);
    }
    for (int idx = (vcu * 512 + tid); idx < 512 * 128; idx += G * 512) { const int j = idx >> 7, k0 = (idx & 127) * 8; float a[8];
#pragma unroll
        for (int i = 0; i < 8; ++i) a[i] = 0.f;
#pragma unroll 4
        for (int r = 0; r < 16; ++r) { const float w2 = P.w_gk2[r * 512 + j];
#pragma unroll
            for (int i = 0; i < 8; ++i) a[i] += P.w_in[(size_t)(k0 + i) * IN_W + 7680 + r] * w2; }
        u32x4 o; o.x = pk2(a[0], a[1]); o.y = pk2(a[2], a[3]); o.z = pk2(a[4], a[5]); o.w = pk2(a[6], a[7]);
        *(u32x4*)(WIN_T + (size_t)(C_GF + j) * 1024 + k0) = o; }
    for (int m = gw; m < T; m += NGW) rms_row_to_bf16(P.x + (size_t)m * D, P.ln1, XN + (size_t)m * D, lane);
#endif
}

DI void attn_unit(const bf16* PROJ, bf16* OG, float* LSE, LAS unsigned char* lds, int unit, int tid) {
    const int lane = tid & 63, w = tid >> 6, i = lane & 15, g4 = lane >> 4;
    const int grp = unit >> 10, idx = unit & 1023, b = idx >> 9, h = (idx >> 7) & 3, q7 = idx & 127;
    const int dsh = 2 * grp, d = 1 << dsh, nblk_sh = 7 - dsh, r = q7 >> nblk_sh, n = q7 & ((1 << nblk_sh) - 1);
    LAS unsigned char* KL = lds; LAS unsigned char* VL = lds + 65536;
    const bf16* base = PROJ + (size_t)b * SEQ * NP + grp * 1536 + h * 128;
    u32x4 kreg[8], vreg[8];
#pragma unroll
    for (int ii = 0; ii < 8; ++ii) { const int id = tid + 512 * ii, row = id >> 4, ch = id & 15; const int sig = n * 128 - 128 + row;
        if (sig >= 0) { const bf16* src = base + (size_t)(sig * d + r) * NP + 8 * ch; kreg[ii] = *(const u32x4*)(src + 512); vreg[ii] = *(const u32x4*)(src + 1024); }
        else { kreg[ii] = (u32x4){0u, 0u, 0u, 0u}; vreg[ii] = (u32x4){0u, 0u, 0u, 0u}; } }
    bf16x8 qf[4];
    { const bf16* qsrc = base + (size_t)((n * 128 + 16 * w + i) * d + r) * NP + 8 * g4;
#pragma unroll
      for (int ks = 0; ks < 4; ++ks) qf[ks] = *(const bf16x8*)(qsrc + 32 * ks); }
#pragma unroll
    for (int ii = 0; ii < 8; ++ii) { const int id = tid + 512 * ii, row = id >> 4, ch = id & 15; *(LAS u32x4*)(KL + offb(row, ch)) = kreg[ii]; *(LAS u32x4*)(VL + offb(row, ch)) = vreg[ii]; }
    __syncthreads();
    const int kt0 = (w == 0) ? 0 : w - 1;
    f32x4 st[10];
#pragma unroll
    for (int tt = 0; tt < 10; ++tt) { f32x4 a = {0.f, 0.f, 0.f, 0.f};
#pragma unroll
        for (int ks = 0; ks < 4; ++ks) { const bf16x8 kf = *(const LAS bf16x8*)(KL + offb(16 * (kt0 + tt) + i, 4 * ks + g4)); a = MFMA16(kf, qf[ks], a); }
        st[tt] = a; }
    const int iq = 16 * w + i; float mx = -3.0e38f;
#pragma unroll
    for (int tt = 0; tt < 10; ++tt)
#pragma unroll
        for (int rg = 0; rg < 4; ++rg) { const int j = 16 * (kt0 + tt) + 4 * g4 + rg, dist = iq + 128 - j; const bool ok = ((unsigned)dist <= 128u) && (n > 0 || j >= 128);
            st[tt][rg] = ok ? st[tt][rg] : -__builtin_inff(); mx = fmaxf(mx, st[tt][rg]); }
    mx = fmaxf(mx, __shfl_xor(mx, 16)); mx = fmaxf(mx, __shfl_xor(mx, 32));
    constexpr float SC = 0.08838834764831845f, C2 = SC * 1.4426950408889634f; float sum = 0.f;
#pragma unroll
    for (int tt = 0; tt < 10; ++tt)
#pragma unroll
        for (int rg = 0; rg < 4; ++rg) { const float p = __builtin_amdgcn_exp2f((st[tt][rg] - mx) * C2); st[tt][rg] = p; sum += p; }
    sum += __shfl_xor(sum, 16); sum += __shfl_xor(sum, 32);
    f32x4 o[8];
#pragma unroll
    for (int c = 0; c < 8; ++c) o[c] = (f32x4){0.f, 0.f, 0.f, 0.f};
#pragma unroll
    for (int kk = 0; kk < 5; ++kk) { u32x4 pw; pw.x = pk2(st[2 * kk][0], st[2 * kk][1]); pw.y = pk2(st[2 * kk][2], st[2 * kk][3]); pw.z = pk2(st[2 * kk + 1][0], st[2 * kk + 1][1]); pw.w = pk2(st[2 * kk + 1][2], st[2 * kk + 1][3]);
        const bf16x8 pa = __builtin_bit_cast(bf16x8, pw);
#pragma unroll
        for (int c = 0; c < 8; ++c) { const s16x4 lo = tr4(VL, 16 * (kt0 + 2 * kk) + 4 * g4, c, lane), hi = tr4(VL, 16 * (kt0 + 2 * kk + 1) + 4 * g4, c, lane); o[c] = MFMA16(pa, cat8(lo, hi), o[c]); } }
    const float linv = 1.0f / sum;
    const size_t mrow0 = (size_t)b * SEQ;
#pragma unroll
    for (int rg = 0; rg < 4; ++rg) { const float li = __shfl(linv, 4 * g4 + rg); const size_t m = mrow0 + (size_t)((n * 128 + 16 * w + 4 * g4 + rg) * d + r);
        bf16* dst = OG + ((size_t)grp * T + m) * 512 + h * 128 + i;
#pragma unroll
        for (int c = 0; c < 8; ++c) dst[16 * c] = f2bf(o[c][rg] * li); }
    if (lane < 16) { const size_t m = mrow0 + (size_t)((n * 128 + iq) * d + r); LSE[((size_t)grp * T + m) * 4 + h] = mx * SC + __logf(sum); }
    __syncthreads();
}

constexpr int GL_QE = 0, GL_KM = 16384, GL_KE = 32768, GL_V = 49152, GL_ATT = 81920, GL_TOT = 91136, GL_DEC = 93184, GL_RS = 93696;
template <bool FULL> DI float gla_prep(const bf16* PROJ, const float* b_gk2, LAS unsigned char* lds, size_t mbase, int h, int tid) {
    const int j = tid & 127, tq = tid >> 7;
    const bf16* src = PROJ + (mbase + 16 * tq) * NP + h * 128 + j;
    const float bias = b_gk2[h * 128 + j];
    float c[16], kv[16], qv[16]; float run = 0.f;
#pragma unroll
    for (int ii = 0; ii < 16; ++ii) { const bf16* p = src + (size_t)ii * NP; const float xg = bf2f(p[C_GF]) + bias; kv[ii] = bf2f(p[C_GK]); if (FULL) qv[ii] = bf2f(p[C_GQ]);
        const float ls = fminf(xg, 0.f) - __logf(1.0f + __expf(-fabsf(xg))); run += ls * (1.0f / 16.0f); c[ii] = run; }
    LAS float* TOT = (LAS float*)(lds + GL_TOT);
    TOT[tq * 128 + j] = run;
    u32x4 vr[4];
#pragma unroll
    for (int ii = 0; ii < 4; ++ii) { const int id = tid + 512 * ii, row = id >> 5, c32 = id & 31; vr[ii] = *(const u32x4*)(PROJ + (mbase + row) * NP + C_GV + h * 256 + 8 * c32); }
    __syncthreads();
    float off = 0.f, blast = 0.f;
#pragma unroll
    for (int t2 = 0; t2 < 4; ++t2) { const float v = TOT[t2 * 128 + j]; blast += v; off += (t2 < tq) ? v : 0.f; }
#pragma unroll
    for (int ii = 0; ii < 16; ++ii) { const int s = 16 * tq + ii; const float bb = off + c[ii]; const unsigned o = offb(s, j >> 3) + (j & 7) * 2;
        *(LAS bf16*)(lds + GL_KE + o) = f2bf(kv[ii] * __expf(blast - bb));
        if (FULL) { *(LAS bf16*)(lds + GL_QE + o) = f2bf(qv[ii] * 0.08838834764831845f * __expf(bb)); *(LAS bf16*)(lds + GL_KM + o) = f2bf(kv[ii] * __expf(-bb)); } }
    if (tq == 0) ((LAS float*)(lds + GL_DEC))[j] = __expf(blast);
#pragma unroll
    for (int ii = 0; ii < 4; ++ii) { const int id = tid + 512 * ii, row = id >> 5, c32 = id & 31; *(LAS u32x4*)(lds + GL_V + (c32 >> 4) * 16384 + offb(row, c32 & 15)) = vr[ii]; }
    __syncthreads();
    return blast;
}
DI void gla_state_update(f32x4 (&S)[8][2], const LAS unsigned char* lds, int w, int lane) {
    const int g4 = lane >> 4; const LAS unsigned char* Vimg = lds + GL_V + (w >> 2) * 16384; const int cv = 2 * (w & 3);
#pragma unroll
    for (int mt = 0; mt < 8; ++mt) { const f32x4 dc = *(const LAS f32x4*)(lds + GL_DEC + (16 * mt + 4 * g4) * 4); S[mt][0] = S[mt][0] * dc; S[mt][1] = S[mt][1] * dc; }
#pragma unroll
    for (int ks = 0; ks < 2; ++ks) { bf16x8 bfr[2];
#pragma unroll
        for (int nt = 0; nt < 2; ++nt) bfr[nt] = cat8(tr4(Vimg, 32 * ks + 8 * g4, cv + nt, lane), tr4(Vimg, 32 * ks + 8 * g4 + 4, cv + nt, lane));
#pragma unroll
        for (int mt = 0; mt < 8; ++mt) { const bf16x8 a = cat8(tr4(lds + GL_KE, 32 * ks + 8 * g4, mt, lane), tr4(lds + GL_KE, 32 * ks + 8 * g4 + 4, mt, lane));
            S[mt][0] = MFMA16(a, bfr[0], S[mt][0]); S[mt][1] = MFMA16(a, bfr[1], S[mt][1]); } }
}
DI void gla_pass1(const Ptrs& P, LAS unsigned char* lds, int unit, int tid) {
    const int lane = tid & 63, w = tid >> 6; const int bh = unit >> 5, sc = unit & 31, b = bh >> 2, h = bh & 3;
    const bf16* PROJ = (const bf16*)(P.ws + WS_PROJ);
    f32x4 S[8][2];
#pragma unroll
    for (int mt = 0; mt < 8; ++mt) { S[mt][0] = (f32x4){0.f, 0.f, 0.f, 0.f}; S[mt][1] = (f32x4){0.f, 0.f, 0.f, 0.f}; }
    float logd = 0.f;
    for (int ci = 0; ci < 8; ++ci) { const size_t mbase = (size_t)b * SEQ + (size_t)(8 * sc + ci) * 64;
        logd += gla_prep<false>(PROJ, P.b_gk2, lds, mbase, h, tid);
        gla_state_update(S, lds, w, lane);
        __syncthreads(); }
    float* GS = (float*)(P.ws + WS_GSTATE) + (size_t)unit * 32768;
#pragma unroll
    for (int mt = 0; mt < 8; ++mt)
#pragma unroll
        for (int nt = 0; nt < 2; ++nt)
#pragma unroll
            for (int rg = 0; rg < 4; ++rg) GS[((w * 16 + mt * 2 + nt) * 4 + rg) * 64 + lane] = S[mt][nt][rg];
    if (tid < 128) ((float*)(P.ws + WS_GDEC))[unit * 128 + tid] = __expf(logd);
}
DI void gla_scan(const Ptrs& P, int vcu, int G, int tid) {
    float* GS = (float*)(P.ws + WS_GSTATE); const float* GD = (const float*)(P.ws + WS_GDEC);
    for (int cid = vcu * 512 + tid; cid < 8 * 32768; cid += G * 512) { const int bh = cid >> 15, e = cid & 32767, ln = e & 63, rg = (e >> 6) & 3, mt = ((e >> 8) & 15) >> 1, dk = 16 * mt + 4 * (ln >> 4) + rg;
        float ev[32], dv[32];
#pragma unroll
        for (int sc = 0; sc < 32; ++sc) { ev[sc] = GS[((size_t)(bh * 32 + sc) << 15) + e]; dv[sc] = GD[(bh * 32 + sc) * 128 + dk]; }
        float carry = 0.f;
#pragma unroll
        for (int sc = 0; sc < 32; ++sc) { GS[((size_t)(bh * 32 + sc) << 15) + e] = carry; carry = dv[sc] * carry + ev[sc]; } }
}
DI void gla_pass2(const Ptrs& P, LAS unsigned char* lds, int unit, int tid) {
    const int lane0 = tid & 63, w = tid >> 6; const int bh = unit >> 5, sc = unit & 31, b = bh >> 2, h = bh & 3;
    const bf16* PROJ = (const bf16*)(P.ws + WS_PROJ); bf16* OB = (bf16*)(P.ws + WS_OB);
    f32x4 S[8][2];
    { const float* GS = (const float*)(P.ws + WS_GSTATE) + (size_t)unit * 32768;
#pragma unroll
      for (int mt = 0; mt < 8; ++mt)
#pragma unroll
          for (int nt = 0; nt < 2; ++nt)
#pragma unroll
              for (int rg = 0; rg < 4; ++rg) S[mt][nt][rg] = GS[((w * 16 + mt * 2 + nt) * 4 + rg) * 64 + lane0]; }
    const float nw0 = P.gnorm[32 * w + (lane0 & 15)], nw1 = P.gnorm[32 * w + 16 + (lane0 & 15)];
    const LAS unsigned char* Vimg = lds + GL_V + (w >> 2) * 16384; const int cv = 2 * (w & 3);
    for (int ci = 0; ci < 8; ++ci) { const size_t mbase = (size_t)b * SEQ + (size_t)(8 * sc + ci) * 64;
        (void)gla_prep<true>(PROJ, P.b_gk2, lds, mbase, h, tid);
        int lane = lane0; asm volatile("" : "+v"(lane));
        const int i = lane & 15, g4 = lane >> 4;
        { const int mi = w >> 1;
#pragma unroll
          for (int nn = 0; nn < 2; ++nn) { const int nj = 2 * (w & 1) + nn; f32x4 a = {0.f, 0.f, 0.f, 0.f};
#pragma unroll
              for (int ks = 0; ks < 4; ++ks) { const bf16x8 af = *(const LAS bf16x8*)(lds + GL_QE + offb(16 * mi + i, 4 * ks + g4)), bfr = *(const LAS bf16x8*)(lds + GL_KM + offb(16 * nj + i, 4 * ks + g4)); a = MFMA16(af, bfr, a); }
#pragma unroll
              for (int rg = 0; rg < 4; ++rg) { const int sq = 16 * mi + 4 * g4 + rg, sk = 16 * nj + i; *(LAS bf16*)(lds + GL_ATT + sq * 144 + sk * 2) = f2bf(sk <= sq ? a[rg] : 0.f); } } }
        __syncthreads();
        f32x4 o[4][2];
#pragma unroll
        for (int mt = 0; mt < 4; ++mt) { o[mt][0] = (f32x4){0.f, 0.f, 0.f, 0.f}; o[mt][1] = (f32x4){0.f, 0.f, 0.f, 0.f}; }
#pragma unroll
        for (int ks = 0; ks < 2; ++ks) { bf16x8 bfr[2];
#pragma unroll
            for (int nt = 0; nt < 2; ++nt) bfr[nt] = cat8(tr4(Vimg, 32 * ks + 8 * g4, cv + nt, lane), tr4(Vimg, 32 * ks + 8 * g4 + 4, cv + nt, lane));
#pragma unroll
            for (int mt = 0; mt < 4; ++mt) { const bf16x8 a = *(const LAS bf16x8*)(lds + GL_ATT + (16 * mt + i) * 144 + 64 * ks + 16 * g4); o[mt][0] = MFMA16(a, bfr[0], o[mt][0]); o[mt][1] = MFMA16(a, bfr[1], o[mt][1]); } }
#pragma unroll
        for (int ks = 0; ks < 4; ++ks) { bf16x8 sb[2];
#pragma unroll
            for (int nt = 0; nt < 2; ++nt) { u32x4 pw; pw.x = pk2(S[2 * ks][nt][0], S[2 * ks][nt][1]); pw.y = pk2(S[2 * ks][nt][2], S[2 * ks][nt][3]); pw.z = pk2(S[2 * ks + 1][nt][0], S[2 * ks + 1][nt][1]); pw.w = pk2(S[2 * ks + 1][nt][2], S[2 * ks + 1][nt][3]); sb[nt] = __builtin_bit_cast(bf16x8, pw); }
#pragma unroll
            for (int mt = 0; mt < 4; ++mt) { const u32x2 lo = *(const LAS u32x2*)(lds + GL_QE + offb(16 * mt + i, 4 * ks + (g4 >> 1)) + (g4 & 1) * 8), hi = *(const LAS u32x2*)(lds + GL_QE + offb(16 * mt + i, 4 * ks + 2 + (g4 >> 1)) + (g4 & 1) * 8);
                u32x4 aw; aw.x = lo.x; aw.y = lo.y; aw.z = hi.x; aw.w = hi.y; const bf16x8 a = __builtin_bit_cast(bf16x8, aw);
                o[mt][0] = MFMA16(a, sb[0], o[mt][0]); o[mt][1] = MFMA16(a, sb[1], o[mt][1]); } }
        LAS float* RS = (LAS float*)(lds + GL_RS);
#pragma unroll
        for (int mt = 0; mt < 4; ++mt)
#pragma unroll
            for (int rg = 0; rg < 4; ++rg) { float ss = o[mt][0][rg] * o[mt][0][rg] + o[mt][1][rg] * o[mt][1][rg];
                ss += __shfl_xor(ss, 1); ss += __shfl_xor(ss, 2); ss += __shfl_xor(ss, 4); ss += __shfl_xor(ss, 8);
                if (i == 0) RS[w * 64 + 16 * mt + 4 * g4 + rg] = ss; }
        __syncthreads();
#pragma unroll
        for (int mt = 0; mt < 4; ++mt)
#pragma unroll
            for (int rg = 0; rg < 4; ++rg) { const int sq = 16 * mt + 4 * g4 + rg; float tot = 0.f;
#pragma unroll
                for (int w2 = 0; w2 < 8; ++w2) tot += RS[w2 * 64 + sq];
                const float rstd = 1.0f / sqrtf(tot * (1.0f / 256.0f) + RMS_EPS);
                const bf16* gp = PROJ + (mbase + sq) * NP + C_GOG + h * 256 + 32 * w + i; bf16* op = OB + (mbase + sq) * D + h * 256 + 32 * w + i;
                const float g0 = bf2f(gp[0]), g1 = bf2f(gp[16]);
                op[0] = f2bf(o[mt][0][rg] * rstd * nw0 * g0 * sigmoidf_fast(g0)); op[16] = f2bf(o[mt][1][rg] * rstd * nw1 * g1 * sigmoidf_fast(g1)); }
        gla_state_update(S, lds, w, lane);
        __syncthreads(); }
}

DI void attn_merge(const Ptrs& P, int vcu, int G, int tid) {
    const int lane = tid & 63, wave = tid >> 6, gw = vcu * 8 + wave, NGW = G * 8;
    const bf16* OG = (const bf16*)((const unsigned char*)P.out + OUT_OG); const float* LSE = (const float*)((const unsigned char*)P.out + OUT_LSE); bf16* OA = (bf16*)(P.ws + WS_OA);
    for (int m = gw; m < T; m += NGW) { const int h = lane >> 4;
        const float l0 = LSE[((size_t)0 * T + m) * 4 + h], l1 = LSE[((size_t)1 * T + m) * 4 + h], l2 = LSE[((size_t)2 * T + m) * 4 + h];
        const float mx = fmaxf(l0, fmaxf(l1, l2)); float w0 = __expf(l0 - mx), w1 = __expf(l1 - mx), w2 = __expf(l2 - mx); const float inv = 1.0f / (w0 + w1 + w2); w0 *= inv; w1 *= inv; w2 *= inv;
        const u32x4 a = *(const u32x4*)(OG + ((size_t)0 * T + m) * 512 + 8 * lane), bq = *(const u32x4*)(OG + ((size_t)1 * T + m) * 512 + 8 * lane), c = *(const u32x4*)(OG + ((size_t)2 * T + m) * 512 + 8 * lane);
        u32x4 o;
        o.x = pk2(w0 * bflo(a.x) + w1 * bflo(bq.x) + w2 * bflo(c.x), w0 * bfhi(a.x) + w1 * bfhi(bq.x) + w2 * bfhi(c.x));
        o.y = pk2(w0 * bflo(a.y) + w1 * bflo(bq.y) + w2 * bflo(c.y), w0 * bfhi(a.y) + w1 * bfhi(bq.y) + w2 * bfhi(c.y));
        o.z = pk2(w0 * bflo(a.z) + w1 * bflo(bq.z) + w2 * bflo(c.z), w0 * bfhi(a.z) + w1 * bfhi(bq.z) + w2 * bfhi(c.z));
        o.w = pk2(w0 * bflo(a.w) + w1 * bflo(bq.w) + w2 * bflo(c.w), w0 * bfhi(a.w) + w1 * bfhi(bq.w) + w2 * bfhi(c.w));
        *(u32x4*)(OA + (size_t)m * 512 + 8 * lane) = o; }
}

DI void router_phase(const Ptrs& P, LAS unsigned char* lds, int G, int tid) {
    const int lane = tid & 63, w = tid >> 6, i = lane & 15, g4 = lane >> 4;
    const float* H1 = P.out; unsigned char* HN8 = P.ws + WS_HN; const bf16* WRT = (const bf16*)(P.ws + WS_WRT);
    { int* RT = (int*)(P.ws + WS_ROWTOK); for (int idx = blockIdx.x * 512 + tid; idx < MAXTILES * 256; idx += G * 512) RT[idx] = 0; }
    int* ASG_E = (int*)(P.ws + WS_ASG_E); int* ASG_SLOT = (int*)(P.ws + WS_ASG_SLOT); float* ASG_G = (float*)(P.ws + WS_ASG_G);
    LAS float* LG = (LAS float*)lds; LAS int* lcnt = (LAS int*)(lds + 17408); LAS int* lbase = (LAS int*)(lds + 17536);
    unsigned* gcnt = (unsigned*)(P.ctl + CW_CNT);
    for (int tb = blockIdx.x; tb < T / 128; tb += G) {
        if (tid < 32) lcnt[tid] = 0;
        __syncthreads();
        const int t = tb * 128 + 16 * w + i; const float* hrow = H1 + (size_t)t * D + 8 * g4;
        float ss = 0.f;
#pragma unroll 8
        for (int c = 0; c < 32; ++c) { const f32x4 v0 = *(const f32x4*)(hrow + 32 * c), v1 = *(const f32x4*)(hrow + 32 * c + 4); ss += (v0.x * v0.x + v0.y * v0.y) + (v0.z * v0.z + v0.w * v0.w) + (v1.x * v1.x + v1.y * v1.y) + (v1.z * v1.z + v1.w * v1.w); }
        ss += __shfl_xor(ss, 16); ss += __shfl_xor(ss, 32);
        const float rstd = 1.0f / sqrtf(ss * (1.0f / D) + RMS_EPS);
        f32x4 a0 = {0.f, 0.f, 0.f, 0.f}, a1 = {0.f, 0.f, 0.f, 0.f};
#pragma unroll 4
        for (int c = 0; c < 32; ++c) { const f32x4 v0 = *(const f32x4*)(hrow + 32 * c), v1 = *(const f32x4*)(hrow + 32 * c + 4); const f32x4 w0 = *(const f32x4*)(P.ln2 + 32 * c + 8 * g4), w1 = *(const f32x4*)(P.ln2 + 32 * c + 8 * g4 + 4);
            u32x4 y; y.x = pk2(v0.x * rstd * w0.x, v0.y * rstd * w0.y); y.y = pk2(v0.z * rstd * w0.z, v0.w * rstd * w0.w); y.z = pk2(v1.x * rstd * w1.x, v1.y * rstd * w1.y); y.w = pk2(v1.z * rstd * w1.z, v1.w * rstd * w1.w);
            { const float f0 = v0.x * rstd * w0.x, f1 = v0.y * rstd * w0.y, f2 = v0.z * rstd * w0.z, f3 = v0.w * rstd * w0.w, f4 = v1.x * rstd * w1.x, f5 = v1.y * rstd * w1.y, f6 = v1.z * rstd * w1.z, f7 = v1.w * rstd * w1.w;
              int q0 = 0, q1 = 0; q0 = __builtin_amdgcn_cvt_pk_fp8_f32(f0, f1, q0, false); q0 = __builtin_amdgcn_cvt_pk_fp8_f32(f2, f3, q0, true); q1 = __builtin_amdgcn_cvt_pk_fp8_f32(f4, f5, q1, false); q1 = __builtin_amdgcn_cvt_pk_fp8_f32(f6, f7, q1, true);
              u32x2 q; q.x = (unsigned)q0; q.y = (unsigned)q1; *(u32x2*)(HN8 + (size_t)t * D + 32 * c + 8 * g4) = q; }
            const bf16x8 af = __builtin_bit_cast(bf16x8, y); const bf16x8 b0 = *(const bf16x8*)(WRT + (size_t)i * D + 32 * c + 8 * g4), b1 = *(const bf16x8*)(WRT + (size_t)(16 + i) * D + 32 * c + 8 * g4);
            a0 = MFMA16(af, b0, a0); a1 = MFMA16(af, b1, a1); }
        const float br0 = P.br[i], br1 = P.br[16 + i];
#pragma unroll
        for (int rg = 0; rg < 4; ++rg) { LG[(w * 16 + 4 * g4 + rg) * 33 + i] = a0[rg] + br0; LG[(w * 16 + 4 * g4 + rg) * 33 + 16 + i] = a1[rg] + br1; }
        LDS_WAIT(); asm volatile("" ::: "memory");
        int es[4] = {0, 0, 0, 0}, ls[4] = {0, 0, 0, 0}; float gs[4] = {0.f, 0.f, 0.f, 0.f};
        if (lane < 16) { float lg[32];
#pragma unroll
            for (int e = 0; e < 32; ++e) lg[e] = LG[(w * 16 + lane) * 33 + e];
            unsigned taken = 0u; float tv[4];
#pragma unroll
            for (int k = 0; k < 4; ++k) { float best = -3.0e38f; int bi = 0;
#pragma unroll
                for (int e = 0; e < 32; ++e) { const bool ok = !((taken >> e) & 1u) && lg[e] > best; best = ok ? lg[e] : best; bi = ok ? e : bi; }
                taken |= 1u << bi; es[k] = bi; tv[k] = best; }
            const float e1 = __expf(tv[1] - tv[0]), e2 = __expf(tv[2] - tv[0]), e3 = __expf(tv[3] - tv[0]), inv = 1.0f / (1.0f + e1 + e2 + e3);
            gs[0] = inv; gs[1] = e1 * inv; gs[2] = e2 * inv; gs[3] = e3 * inv;
#pragma unroll
            for (int k = 0; k < 4; ++k) ls[k] = atomicAdd((int*)&lcnt[es[k]], 1); }
        __syncthreads();
        if (tid < 32) lbase[tid] = (int)__hip_atomic_fetch_add(gcnt + tid, (unsigned)lcnt[tid], RLX_AGENT);
        __syncthreads();
        if (lane < 16) { const int tt = tb * 128 + 16 * w + lane;
#pragma unroll
            for (int k = 0; k < 4; ++k) { ASG_E[4 * tt + k] = es[k]; ASG_SLOT[4 * tt + k] = lbase[es[k]] + ls[k]; ASG_G[4 * tt + k] = gs[k]; } }
        __syncthreads();
    }
}
DI void moe_tables(const Ptrs& P, LAS int* ts, int tid) {
    if (tid == 0) { const unsigned* gcnt = (const unsigned*)(P.ctl + CW_CNT); int run = 0;
        for (int e = 0; e < 32; ++e) { ts[e] = run; run += (int)((__hip_atomic_load(gcnt + e, RLX_AGENT) + 255u) >> 8); } ts[32] = run; }
    __syncthreads();
}
DI void moe_scatter(const Ptrs& P, LAS unsigned char* lds, int vcu, int G, int tid) {
    LAS int* ts = (LAS int*)(lds + TBL_OFF); moe_tables(P, ts, tid);
    const int* ASG_E = (const int*)(P.ws + WS_ASG_E); const int* ASG_SLOT = (const int*)(P.ws + WS_ASG_SLOT); int* ASG_ROW = (int*)(P.ws + WS_ASG_ROW); int* RT = (int*)(P.ws + WS_ROWTOK);
    for (int a = vcu * 512 + tid; a < NASG; a += G * 512) { const int row = ts[ASG_E[a]] * 256 + ASG_SLOT[a]; ASG_ROW[a] = row; RT[row] = a >> 2; }
}
constexpr int LT_OFF = 131072 + 2048;
template <class Sched> DI void moe_unit_tokens(const Ptrs& P, const Sched& S, LAS unsigned short* lt, int tid) {
    const int* RT = (const int*)(P.ws + WS_ROWTOK); pg8::Unit u;
    for (int i = 0; i < 24 && S.next(i, u); ++i) { if (tid < 256) lt[i * 256 + tid] = (unsigned short)RT[u.pm * 256 + tid]; }
    __syncthreads();
}
DI void final_phase(const Ptrs& P, int vcu, int G, int tid) {
    const int lane = tid & 63, wave = tid >> 6, gw = vcu * 8 + wave, NGW = G * 8;
    const int* ASG_ROW = (const int*)(P.ws + WS_ASG_ROW); const float* ASG_G = (const float*)(P.ws + WS_ASG_G); const bf16* YB = (const bf16*)(P.ws + WS_YB);
    for (int t = gw; t < T; t += NGW) {
#if BRINGUP == 1
        const f32x4* hr = (const f32x4*)(P.x + (size_t)t * D) + lane;
#else
        const f32x4* hr = (const f32x4*)(P.out + (size_t)t * D) + lane;
#endif
        f32x4 v[4];
#pragma unroll
        for (int j = 0; j < 4; ++j) v[j] = hr[64 * j];
#if BRINGUP != 1
#pragma unroll
        for (int k = 0; k < 4; ++k) { const int row = ASG_ROW[4 * t + k]; const float gk = ASG_G[4 * t + k]; const u32x2* yr = (const u32x2*)(YB + (size_t)row * D) + lane;
#pragma unroll
            for (int j = 0; j < 4; ++j) { const u32x2 y = yr[64 * j]; v[j].x += gk * bflo(y.x); v[j].y += gk * bfhi(y.x); v[j].z += gk * bflo(y.y); v[j].w += gk * bfhi(y.y); } }
#endif
        float s = 0.f;
#pragma unroll
        for (int j = 0; j < 4; ++j) s += (v[j].x * v[j].x + v[j].y * v[j].y) + (v[j].z * v[j].z + v[j].w * v[j].w);
        const float rstd = 1.f / sqrtf(wave_sum(s) * (1.f / D) + RMS_EPS);
        f32x4* orow = (f32x4*)(P.out + (size_t)t * D) + lane; const f32x4* wr = (const f32x4*)P.lnf + lane;
#pragma unroll
        for (int j = 0; j < 4; ++j) orow[64 * j] = v[j] * rstd * wr[64 * j]; }
}

constexpr int N_PHASES = 12;
struct Args { const float* in[17]; float* out; unsigned char* ws; int ph_lo, ph_hi; };
__global__ void __launch_bounds__(512, 2) fwd(Args args) {
    extern __shared__ __attribute__((aligned(16))) unsigned char lds_raw[];
    LAS unsigned char* lds = (LAS unsigned char*)lds_raw;
    const int tid = threadIdx.x, G = gridDim.x; const int bx = blockIdx.x; const int vcu = (G % 8 == 0) ? (bx % 8) * (G / 8) + bx / 8 : bx;
    Ptrs P;
    P.x = args.in[0]; P.ln1 = args.in[1]; P.w_in = args.in[2]; P.w_gk2 = args.in[3]; P.b_gk2 = args.in[4]; P.gnorm = args.in[5]; P.wpa = args.in[6]; P.wpb = args.in[7]; P.wout = args.in[8];
    P.ln2 = args.in[9]; P.wr = args.in[10]; P.br = args.in[11]; P.wup = args.in[12]; P.bup = args.in[13]; P.wdn = args.in[14]; P.bdn = args.in[15]; P.lnf = args.in[16];
    P.out = args.out; P.ws = args.ws; P.ctl = (gu32*)(args.ws + WS_CTL);
    volatile LAS unsigned* MISC = (volatile LAS unsigned*)(lds + MISC_OFF);
    for (int u = tid; u < (LDS_BYTES - MISC_OFF) / 4; u += 512) ((LAS unsigned*)(lds + MISC_OFF))[u] = 0u;
    __syncthreads();
    XcdBarrier bar; bar.bar = (unsigned*)(P.ctl + CW_BAR); bar.x = 0; bar.st = nullptr;
    if (MK_N_LAUNCHES == 1) bar = xcd_barrier_post((unsigned*)(P.ctl + CW_BAR), MISC + 8);
    const int lo = args.ph_lo, hi = args.ph_hi;
#ifndef PH_MASK
#define PH_MASK 0xFFF
#endif
#define IN(k) (((PH_MASK >> (k)) & 1) && lo <= (k) && (k) < hi)
#define SEAM(k) do { if (IN(k) && IN((k) + 1)) xcd_barrier(bar); } while (0)
#define DUP(k, ...) do { __VA_ARGS__; if ((DUP_MASK >> (k)) & 1) { __syncthreads(); __VA_ARGS__; } } while (0)
    bf16* PROJ = (bf16*)(P.ws + WS_PROJ); bf16* XN = (bf16*)(P.ws + WS_XN); bf16* MIXED = XN;

    if (IN(0)) { DUP(0, p0_prologue(P, lds, vcu, G, tid)); } SEAM(0);
#if BRINGUP == 0
    if (IN(1)) { pg8::Gemm g{XN, (const bf16*)(P.ws + WS_WIN), T, NP, D, 0}; pg8::StaticOrder S; S.init(T, NP, G, bx);
        pg8::EpiStoreBf16 E{PROJ, NP, nullptr, 0}; DUP(1, pg8::gemm_phase(lds, g, S, E)); } SEAM(1);
    if (IN(2)) { bf16* OG = (bf16*)((unsigned char*)P.out + OUT_OG); float* LSE = (float*)((unsigned char*)P.out + OUT_LSE);
        DUP(12, for (int u = vcu; u < 3072; u += G) attn_unit(PROJ, OG, LSE, lds, u, tid));
        DUP(13, for (int u = bx; u < 256; u += G) gla_pass1(P, lds, u, tid)); } SEAM(2);
    if (IN(3)) { gla_scan(P, vcu, G, tid); attn_merge(P, vcu, G, tid); } SEAM(3);
    if (IN(4)) { DUP(4, for (int u = bx; u < 256; u += G) gla_pass2(P, lds, u, tid)); } SEAM(4);
    if (IN(5)) { { pg8::Gemm g{(const bf16*)(P.ws + WS_OA), (const bf16*)(P.ws + WS_WPA), T, D, 512, 0}; pg8::StaticOrder S; S.init(T, D, G, bx); pg8::EpiGate<false> E{MIXED, PROJ + C_MA, NP}; pg8::gemm_phase(lds, g, S, E); }
                 { pg8::Gemm g{(const bf16*)(P.ws + WS_OB), (const bf16*)(P.ws + WS_WPB), T, D, D, 0}; pg8::StaticOrder S; S.init(T, D, G, bx); pg8::EpiGate<true> E{MIXED, PROJ + C_MB, NP}; pg8::gemm_phase(lds, g, S, E); } } SEAM(5);
    if (IN(6)) { pg8::Gemm g{MIXED, (const bf16*)(P.ws + WS_WOUT), T, D, D, 0}; pg8::StaticOrder S; S.init(T, D, G, bx); pg8::EpiResF32 E{P.x, P.out}; pg8::gemm_phase(lds, g, S, E); } SEAM(6);
#elif BRINGUP == 2
    if (IN(6)) { for (size_t idx = (size_t)vcu * 512 + tid; idx < (size_t)T * D / 4; idx += (size_t)G * 512) ((f32x4*)P.out)[idx] = ((const f32x4*)P.x)[idx]; } SEAM(6);
#endif
#if BRINGUP != 1
    if (IN(7)) { router_phase(P, lds, G, tid); } SEAM(7);
    if (IN(8)) { moe_scatter(P, lds, vcu, G, tid); } SEAM(8);
    if (IN(9)) { LAS int* ts = (LAS int*)(lds + TBL_OFF); moe_tables(P, ts, tid); LAS unsigned short* lt = (LAS unsigned short*)(lds + LT_OFF);
        pg8::MoeOrder S; S.init(ts[32] * 256, 2048, G, bx); S.ts = ts; moe_unit_tokens(P, S, lt, tid);
        pg8::Gemm g{(const bf16*)(P.ws + WS_HN), (const bf16*)(P.ws + WS_WUP), 0, 2048, D / 2, (size_t)2048 * 512, lt};
        pg8::EpiSwiGLU8 E{P.ws + WS_ACT, P.bup, (const float*)(P.ws + WS_SUP)}; DUP(9, pg8::gemm_phase<pg8::EpiSwiGLU8, pg8::MoeOrder, 1, true>(lds, g, S, E)); } SEAM(9);
    if (IN(10)) { LAS int* ts = (LAS int*)(lds + TBL_OFF); moe_tables(P, ts, tid);
        pg8::Gemm g{(const bf16*)(P.ws + WS_ACT), (const bf16*)(P.ws + WS_WDN), 0, D, D / 2, (size_t)1024 * 512, nullptr}; pg8::MoeOrder S; S.init(ts[32] * 256, D, G, bx); S.ts = ts;
        pg8::EpiDown8 E{(bf16*)(P.ws + WS_YB), P.bdn, (const float*)(P.ws + WS_SDN)}; DUP(10, pg8::gemm_phase<pg8::EpiDown8, pg8::MoeOrder, 1, false>(lds, g, S, E)); } SEAM(10);
#endif
    if (IN(11)) { final_phase(P, vcu, G, tid); }
#undef IN
#undef SEAM
}

extern "C" void kernel_launch(void* const* d_in, const int* in_sizes, int n_in, void* d_out, int out_size, void* d_ws, size_t ws_size, hipStream_t stream) {
    static int grid = 0;
    if (grid == 0) {
        if (n_in != 17 || out_size != T * D || ws_size < WS_END) { fprintf(stderr, "kernel_launch: unexpected shapes (n_in %d out %d ws %zu, need %zu)\n", n_in, out_size, ws_size, (size_t)WS_END); grid = -1; return; }
        int dev = 0, cus = 0;
        if (hipGetDevice(&dev) != hipSuccess || hipDeviceGetAttribute(&cus, hipDeviceAttributeMultiprocessorCount, dev) != hipSuccess) { grid = -1; return; }
        if (hipFuncSetAttribute((const void*)fwd, hipFuncAttributeMaxDynamicSharedMemorySize, LDS_BYTES) != hipSuccess) { grid = -1; return; }
        int per_cu = 0; (void)hipOccupancyMaxActiveBlocksPerMultiprocessor(&per_cu, (const void*)fwd, 512, LDS_BYTES); (void)hipGetLastError();
        grid = cus;
    }
    if (grid < 0) return;
    (void)hipMemsetAsync((char*)d_ws + WS_CTL, 0, CTL_ZERO_BYTES, stream);
    Args a{};
    for (int i = 0; i < 17; ++i) a.in[i] = (const float*)d_in[i];
    a.out = (float*)d_out; a.ws = (unsigned char*)d_ws;
    if (MK_N_LAUNCHES == 1) { a.ph_lo = 0; a.ph_hi = N_PHASES; hipLaunchKernelGGL(fwd, dim3(grid), dim3(512), LDS_BYTES, stream, a); }
    else { for (int p = 0; p < N_PHASES; ++p) { a.ph_lo = p; a.ph_hi = p + 1; hipLaunchKernelGGL(fwd, dim3(grid), dim3(512), LDS_BYTES, stream, a); } }
}
```

```cpp
#include <hip/hip_runtime.h>
#include <cstdio>
#include <cstdint>

#ifndef MK_N_LAUNCHES
#define MK_N_LAUNCHES 1
#endif
#ifndef DUP_MASK
#define DUP_MASK 0
#endif
#ifndef STAMP_PHASE
#define STAMP_PHASE -1
#endif
#ifndef BRINGUP
#define BRINGUP 0
#endif

#define DI __device__ __forceinline__
#define LAS __attribute__((address_space(3)))
#define GAS __attribute__((address_space(1)))
typedef unsigned short bf16;
typedef short bf16x8 __attribute__((ext_vector_type(8)));
typedef short s16x4 __attribute__((ext_vector_type(4)));
typedef short v4i16_t __attribute__((ext_vector_type(4)));
typedef float f32x4 __attribute__((ext_vector_type(4)));
typedef float f32x2 __attribute__((ext_vector_type(2)));
typedef unsigned u32x4 __attribute__((ext_vector_type(4)));
typedef unsigned u32x2 __attribute__((ext_vector_type(2)));
typedef __bf16 bf16v2 __attribute__((ext_vector_type(2)));
typedef GAS unsigned gu32;
#define RLX_AGENT __ATOMIC_RELAXED, __HIP_MEMORY_SCOPE_AGENT
#define LDS_WAIT() asm volatile("s_waitcnt lgkmcnt(0)" ::: "memory")
#define VM_WAIT() asm volatile("s_waitcnt vmcnt(0)" ::: "memory")

DI unsigned pk2(float a, float b) { bf16v2 v; v.x = (__bf16)a; v.y = (__bf16)b; return __builtin_bit_cast(unsigned, v); }
DI float bflo(unsigned w) { return __uint_as_float(w << 16); }
DI float bfhi(unsigned w) { return __uint_as_float(w & 0xffff0000u); }
DI float bf2f(bf16 b) { return __uint_as_float(((unsigned)b) << 16); }
DI bf16 f2bf(float f) { return (bf16)(pk2(f, 0.f) & 0xffffu); }
DI float sigmoidf_fast(float z) { return __builtin_amdgcn_rcpf(1.0f + __builtin_amdgcn_exp2f(-1.4426950408889634f * z)); }
DI bf16x8 cat8(s16x4 lo, s16x4 hi) { bf16x8 r; r[0] = lo[0]; r[1] = lo[1]; r[2] = lo[2]; r[3] = lo[3]; r[4] = hi[0]; r[5] = hi[1]; r[6] = hi[2]; r[7] = hi[3]; return r; }
#define MFMA16(a, b, c) __builtin_amdgcn_mfma_f32_16x16x32_bf16((a), (b), (c), 0, 0, 0)

constexpr int T = 32768, SEQ = 16384, D = 1024, NP = 10240, IN_W = 9744;
constexpr int C_GQ = 4608, C_GK = 5120, C_GV = 5632, C_GOG = 6656, C_GF = 7680, C_MA = 8192, C_MB = 9216;
constexpr int NEXP = 32, NASG = T * 4, MAXTILES = 544;
constexpr float RMS_EPS = 1e-5f;

namespace pg8 {
#define PG8_LAS __attribute__((address_space(3)))
typedef unsigned short bf16_t;
constexpr int BM = 256, BK = 64, HALF = 128, HTB = HALF * BK * 2, STAGE_BYTES = 8 * HTB, NXCD = 8, WGM = 8;
__host__ __device__ __forceinline__ int lds_byte(int r, int c) { const int st = (r >> 4) * 2 + (c >> 5), rr = r & 15, cc = c & 31, ob = rr * 64 + cc * 2; return st * 1024 + (ob ^ (((ob >> 9) & 1) << 5)); }
__host__ __device__ __forceinline__ void stage_rc(int b, int& R, int& C) { const int st = b / 1024, sb = b % 1024, swz = sb ^ (((sb >> 9) & 1) << 5); R = (st >> 1) * 16 + swz / 64; C = (st & 1) * 32 + (swz % 64) / 2; }
__host__ __device__ __forceinline__ int perm32(int rho) { const int n = rho >> 4, i = rho & 15; return 8 * (i >> 2) + 4 * n + (i & 3); }

struct Unit { int pm, pn, e; };
struct Gemm { const bf16_t* A; const bf16_t* Bt; int M, N, K; size_t bstride; const PG8_LAS unsigned short* lt; };

struct StaticOrder {
    int nM, nN, nwg, G, c, ibeg = 0, iend = 0x7fffffff;
    __host__ __device__ void init(int M, int N, int G_, int c_) { nM = M / BM; nN = N / BM; nwg = nM * nN; G = G_; c = c_; ibeg = 0; iend = 0x7fffffff; }
    __host__ __device__ bool next(int i, Unit& u) const {
        i += ibeg; if (i >= iend) return false;
        const long L = (long)i * G + c; if (L >= nwg) return false;
        int wgid = (int)L; { const int q = nwg / NXCD, r = nwg % NXCD, xcd = wgid % NXCD, off = wgid / NXCD; wgid = (xcd < r ? xcd * (q + 1) : r * (q + 1) + (xcd - r) * q) + off; }
        const int nig = WGM * nN, gid = wgid / nig, fm = gid * WGM, gsz = (nM - fm) < WGM ? (nM - fm) : WGM;
        u.pm = fm + ((wgid % nig) % gsz); u.pn = (wgid % nig) / gsz; u.e = 0; return true;
    }
};
struct MoeOrder : StaticOrder {
    const PG8_LAS int* ts;
    __device__ __forceinline__ bool next(int i, Unit& u) const {
        if (!StaticOrder::next(i, u)) return false;
        int e = 0;
#pragma unroll 1
        while (e < 31 && u.pm >= ts[e + 1]) ++e;
        u.e = e; return true;
    }
};

struct EpiStoreBf16 {
    static constexpr bool PERM = true, HAS_VEC = false;
    bf16_t* O; int ldc; const float* bias; int bias_estride;
    __device__ __forceinline__ void operator()(const f32x4 (&acc)[2][2][4][2], const Unit& u, int wr, int wc, int fr, int fq, const PG8_LAS float* vec) const {
        const int row0 = u.pm * BM + wr * 64 + fr, col0 = u.pn * BM + wc * 32 + 8 * fq;
        f32x4 bv[2][2];
#pragma unroll
        for (int bj = 0; bj < 2; ++bj)
#pragma unroll
            for (int n = 0; n < 2; ++n) bv[bj][n] = bias ? *(const f32x4*)(bias + (size_t)u.e * bias_estride + col0 + bj * HALF + 4 * n) : (f32x4){0.f, 0.f, 0.f, 0.f};
#pragma unroll
        for (int ai = 0; ai < 2; ++ai)
#pragma unroll
            for (int m = 0; m < 4; ++m) { bf16_t* rowp = O + (size_t)(row0 + ai * HALF + m * 16) * ldc + col0;
#pragma unroll
                for (int bj = 0; bj < 2; ++bj) { const f32x4 v0 = acc[ai][bj][m][0] + bv[bj][0], v1 = acc[ai][bj][m][1] + bv[bj][1];
                    u32x4 w; w.x = pk2(v0[0], v0[1]); w.y = pk2(v0[2], v0[3]); w.z = pk2(v1[0], v1[1]); w.w = pk2(v1[2], v1[3]);
                    *(u32x4*)(rowp + bj * HALF) = w; } }
    }
};
template <bool I8> struct EpiProj {
    static constexpr bool PERM = true, HAS_VEC = I8;
    bf16_t* P; const float* bgk2; const float* sx; const float* sw;
    __device__ __forceinline__ const float* vec_src(const Unit& u, int L) const { const int o = (L & 63) * 4; return L < 64 ? sw + u.pn * BM + o : sx + u.pm * BM + o; }
    template <bool ISG, bool F8> __device__ __forceinline__ void block(const f32x4 (&acc)[2][2][4][2], int bj, int cb, size_t base, int pitch, int dsh, float sc, int row0, int x0, int wr, int fr, const PG8_LAS float* vec) const {
        f32x4 b0 = {0.f, 0.f, 0.f, 0.f}, b1 = {0.f, 0.f, 0.f, 0.f};
        if (ISG) { b0 = *(const f32x4*)(bgk2 + (cb - 60) * 128 + x0); b1 = *(const f32x4*)(bgk2 + (cb - 60) * 128 + x0 + 4); }
        f32x4 c0 = {sc, sc, sc, sc}, c1 = {sc, sc, sc, sc};
        if (I8) { c0 = *(const PG8_LAS f32x4*)(vec + bj * HALF + x0) * sc; c1 = *(const PG8_LAS f32x4*)(vec + bj * HALF + x0 + 4) * sc; }
#pragma unroll
        for (int ai = 0; ai < 2; ++ai)
#pragma unroll
            for (int m = 0; m < 4; ++m) { const int r = row0 + ai * HALF + m * 16, s = r & (SEQ - 1); const size_t rp = (size_t)(r & ~(SEQ - 1)) + (size_t)((s & ((1 << dsh) - 1)) << (14 - dsh)) + (size_t)(s >> dsh);
                f32x4 v0 = acc[ai][bj][m][0], v1 = acc[ai][bj][m][1];
                if (I8) { const float rs = vec[256 + wr * 64 + fr + ai * HALF + m * 16]; const f32x4 d0 = c0 * rs, d1 = c1 * rs;
#pragma unroll
                    for (int j = 0; j < 4; ++j) { v0[j] = (float)__float_as_int(v0[j]) * d0[j]; v1[j] = (float)__float_as_int(v1[j]) * d1[j]; } }
                else { v0 = v0 * c0; v1 = v1 * c1; }
                if (ISG) {
#pragma unroll
                    for (int j = 0; j < 4; ++j) { const float xa = v0[j] + b0[j], xb = v1[j] + b1[j];
                        v0[j] = (fminf(xa, 0.f) - __logf(1.0f + __expf(-fabsf(xa)))) * (1.0f / 16.0f); v1[j] = (fminf(xb, 0.f) - __logf(1.0f + __expf(-fabsf(xb)))) * (1.0f / 16.0f); } }
                if (F8) { int w0 = 0, w1 = 0; w0 = __builtin_amdgcn_cvt_pk_fp8_f32(v0[0], v0[1], w0, false); w0 = __builtin_amdgcn_cvt_pk_fp8_f32(v0[2], v0[3], w0, true);
                    w1 = __builtin_amdgcn_cvt_pk_fp8_f32(v1[0], v1[1], w1, false); w1 = __builtin_amdgcn_cvt_pk_fp8_f32(v1[2], v1[3], w1, true);
                    u32x2 w; w.x = (unsigned)w0; w.y = (unsigned)w1; *(u32x2*)((unsigned char*)P + 2 * base + rp * pitch + x0) = w; }
                else { u32x4 w; w.x = pk2(v0[0], v0[1]); w.y = pk2(v0[2], v0[3]); w.z = pk2(v1[0], v1[1]); w.w = pk2(v1[2], v1[3]);
                    *(u32x4*)(P + base + rp * pitch + x0) = w; } }
    }
    __device__ __forceinline__ void operator()(const f32x4 (&acc)[2][2][4][2], const Unit& u, int wr, int wc, int fr, int fq, const PG8_LAS float* vec) const {
        const int row0 = u.pm * BM + wr * 64 + fr, x0 = wc * 32 + 8 * fq;
#pragma unroll
        for (int bj = 0; bj < 2; ++bj) { const int cb = __builtin_amdgcn_readfirstlane(2 * u.pn + bj);
            size_t base; int pitch = 128, dsh = 0; float sc = 1.0f;
            if (cb < 36) { base = (size_t)cb * T * 128; dsh = 2 * (cb / 12); if ((cb % 12) < 4) sc = 0.08838834764831845f * 1.4426950408889634f; }
            else if (cb < 44) { base = (size_t)cb * T * 128; if (cb < 40) sc = 0.08838834764831845f; }
            else if (cb < 60) { const int gb = (cb < 52) ? 44 : 52; base = (size_t)gb * T * 128 + (size_t)((cb - gb) >> 1) * T * 256 + ((cb - gb) & 1) * 128; pitch = 256; }
            else if (cb < 64) { base = (size_t)cb * T * 128; }
            else { base = (size_t)64 * T * 128 + (size_t)(cb - 64) * 64; pitch = 2048; }
            if (cb >= 60 && cb < 64) block<true, false>(acc, bj, cb, base, pitch, dsh, sc, row0, x0, wr, fr, vec);
            else if (cb >= 64 || cb < 36) block<false, true>(acc, bj, cb, base, pitch, dsh, sc, row0, x0, wr, fr, vec);
            else block<false, false>(acc, bj, cb, base, pitch, dsh, sc, row0, x0, wr, fr, vec); }
    }
};
template <bool ADD> struct EpiGate {
    static constexpr bool PERM = true, HAS_VEC = false; static constexpr int NSTORE = 16;
    bf16_t* O; const unsigned char* G8; unsigned char* PART8;
    __device__ __forceinline__ void operator()(const f32x4 (&acc)[2][2][4][2], const Unit& u, int wr, int wc, int fr, int fq, const PG8_LAS float* vec) const {
        const int row0 = u.pm * BM + wr * 64 + fr, col0 = u.pn * BM + wc * 32 + 8 * fq;
#pragma unroll
        for (int ai = 0; ai < 2; ++ai)
#pragma unroll
            for (int m = 0; m < 4; ++m) { const size_t r = (size_t)(row0 + ai * HALF + m * 16);
#pragma unroll
                for (int bj = 0; bj < 2; ++bj) { const u32x2 gw = *(const u32x2*)(G8 + r * 2048 + col0 + bj * HALF);
                    u32x2 pw = {0u, 0u}; if (ADD) pw = *(const u32x2*)(PART8 + r * D + col0 + bj * HALF);
                    const f32x2 g0 = __builtin_amdgcn_cvt_pk_f32_fp8((int)gw.x, false), g1 = __builtin_amdgcn_cvt_pk_f32_fp8((int)gw.x, true), g2 = __builtin_amdgcn_cvt_pk_f32_fp8((int)gw.y, false), g3 = __builtin_amdgcn_cvt_pk_f32_fp8((int)gw.y, true);
                    f32x2 p0 = {0.f, 0.f}, p1 = {0.f, 0.f}, p2 = {0.f, 0.f}, p3 = {0.f, 0.f};
                    if (ADD) { p0 = __builtin_amdgcn_cvt_pk_f32_fp8((int)pw.x, false); p1 = __builtin_amdgcn_cvt_pk_f32_fp8((int)pw.x, true); p2 = __builtin_amdgcn_cvt_pk_f32_fp8((int)pw.y, false); p3 = __builtin_amdgcn_cvt_pk_f32_fp8((int)pw.y, true); }
                    const f32x4 v0 = acc[ai][bj][m][0], v1 = acc[ai][bj][m][1];
                    const float r0 = p0.x + sigmoidf_fast(g0.x) * v0[0], r1 = p0.y + sigmoidf_fast(g0.y) * v0[1], r2 = p1.x + sigmoidf_fast(g1.x) * v0[2], r3 = p1.y + sigmoidf_fast(g1.y) * v0[3];
                    const float r4 = p2.x + sigmoidf_fast(g2.x) * v1[0], r5 = p2.y + sigmoidf_fast(g2.y) * v1[1], r6 = p3.x + sigmoidf_fast(g3.x) * v1[2], r7 = p3.y + sigmoidf_fast(g3.y) * v1[3];
                    if (ADD) { u32x4 w; w.x = pk2(r0, r1); w.y = pk2(r2, r3); w.z = pk2(r4, r5); w.w = pk2(r6, r7); *(u32x4*)(O + r * D + col0 + bj * HALF) = w; }
                    else { int w0 = 0, w1 = 0; w0 = __builtin_amdgcn_cvt_pk_fp8_f32(r0, r1, w0, false); w0 = __builtin_amdgcn_cvt_pk_fp8_f32(r2, r3, w0, true); w1 = __builtin_amdgcn_cvt_pk_fp8_f32(r4, r5, w1, false); w1 = __builtin_amdgcn_cvt_pk_fp8_f32(r6, r7, w1, true);
                        u32x2 w; w.x = (unsigned)w0; w.y = (unsigned)w1; *(u32x2*)(PART8 + r * D + col0 + bj * HALF) = w; } } }
    }
};
struct EpiResBf16 {
    static constexpr bool PERM = true, HAS_VEC = false; static constexpr int NSTORE = 16;
    const float* base; bf16_t* O; float* PS;
    __device__ __forceinline__ void operator()(const f32x4 (&acc)[2][2][4][2], const Unit& u, int wr, int wc, int fr, int fq, const PG8_LAS float* vec) const {
        const int row0 = u.pm * BM + wr * 64 + fr, col0 = u.pn * BM + wc * 32 + 8 * fq;
#pragma unroll
        for (int ai = 0; ai < 2; ++ai)
#pragma unroll
            for (int m = 0; m < 4; ++m) { const size_t off = (size_t)(row0 + ai * HALF + m * 16) * D + col0; float ss = 0.f;
#pragma unroll
                for (int bj = 0; bj < 2; ++bj) { const f32x4 v0 = *(const f32x4*)(base + off + bj * HALF) + acc[ai][bj][m][0], v1 = *(const f32x4*)(base + off + bj * HALF + 4) + acc[ai][bj][m][1];
                    ss += (v0[0] * v0[0] + v0[1] * v0[1]) + (v0[2] * v0[2] + v0[3] * v0[3]) + (v1[0] * v1[0] + v1[1] * v1[1]) + (v1[2] * v1[2] + v1[3] * v1[3]);
                    u32x4 w; w.x = pk2(v0[0], v0[1]); w.y = pk2(v0[2], v0[3]); w.z = pk2(v1[0], v1[1]); w.w = pk2(v1[2], v1[3]);
                    *(u32x4*)(O + off + bj * HALF) = w; }
                ss += __shfl_xor(ss, 16); ss += __shfl_xor(ss, 32);
                if (fq == 0) PS[(size_t)(u.pn * 4 + wc) * T + row0 + ai * HALF + m * 16] = ss; }
    }
};
struct EpiSwiGLU8 {
    static constexpr bool PERM = true, HAS_VEC = true;
    unsigned char* O; const float* bup; const float* cs;
    __device__ __forceinline__ const float* vec_src(const Unit& u, int L) const { const int seg = L >> 5, o = (L & 31) * 4;
        return seg == 0 ? bup + (size_t)u.e * 2048 + u.pn * 128 + o : seg == 1 ? bup + (size_t)u.e * 2048 + 1024 + u.pn * 128 + o : seg == 2 ? cs + (size_t)u.e * 2048 + u.pn * 256 + o : cs + (size_t)u.e * 2048 + u.pn * 256 + 128 + o; }
    __device__ __forceinline__ void operator()(const f32x4 (&acc)[2][2][4][2], const Unit& u, int wr, int wc, int fr, int fq, const PG8_LAS float* vec) const {
        const int row0 = u.pm * BM + wr * 64 + fr, x0 = wc * 32 + 8 * fq;
        const f32x4 bgv[2] = {*(const PG8_LAS f32x4*)(vec + x0), *(const PG8_LAS f32x4*)(vec + x0 + 4)}, blv[2] = {*(const PG8_LAS f32x4*)(vec + 128 + x0), *(const PG8_LAS f32x4*)(vec + 128 + x0 + 4)};
        const f32x4 sgv[2] = {*(const PG8_LAS f32x4*)(vec + 256 + x0), *(const PG8_LAS f32x4*)(vec + 256 + x0 + 4)}, slv[2] = {*(const PG8_LAS f32x4*)(vec + 384 + x0), *(const PG8_LAS f32x4*)(vec + 384 + x0 + 4)};
#pragma unroll
        for (int ai = 0; ai < 2; ++ai)
#pragma unroll
            for (int m = 0; m < 4; ++m) { float r[8];
#pragma unroll
                for (int n = 0; n < 2; ++n) { const f32x4 gv = acc[ai][0][m][n] * sgv[n] + bgv[n], lv = acc[ai][1][m][n] * slv[n] + blv[n];
#pragma unroll
                    for (int j = 0; j < 4; ++j) { const float xg = fminf(gv[j], 7.0f), xl = fminf(fmaxf(lv[j], -7.0f), 7.0f); r[4 * n + j] = xg * sigmoidf_fast(1.702f * xg) * (xl + 1.0f); } }
                int w0 = 0, w1 = 0;
                w0 = __builtin_amdgcn_cvt_pk_fp8_f32(r[0], r[1], w0, false); w0 = __builtin_amdgcn_cvt_pk_fp8_f32(r[2], r[3], w0, true);
                w1 = __builtin_amdgcn_cvt_pk_fp8_f32(r[4], r[5], w1, false); w1 = __builtin_amdgcn_cvt_pk_fp8_f32(r[6], r[7], w1, true);
                u32x2 w; w.x = (unsigned)w0; w.y = (unsigned)w1;
                *(u32x2*)(O + (size_t)(row0 + ai * HALF + m * 16) * D + u.pn * 128 + x0) = w; }
    }
};
struct EpiDown8 {
    static constexpr bool PERM = true, HAS_VEC = true;
    unsigned char* O; const float* bias; const float* cs;
    __device__ __forceinline__ const float* vec_src(const Unit& u, int L) const { const int o = (L & 63) * 4; return (L < 64 ? bias : cs) + (size_t)u.e * D + u.pn * BM + o; }
    __device__ __forceinline__ void operator()(const f32x4 (&acc)[2][2][4][2], const Unit& u, int wr, int wc, int fr, int fq, const PG8_LAS float* vec) const {
        const int row0 = u.pm * BM + wr * 64 + fr, col0 = u.pn * BM + wc * 32 + 8 * fq;
        f32x4 bv[2][2], sv[2][2];
#pragma unroll
        for (int bj = 0; bj < 2; ++bj)
#pragma unroll
            for (int n = 0; n < 2; ++n) { bv[bj][n] = *(const PG8_LAS f32x4*)(vec + wc * 32 + 8 * fq + bj * HALF + 4 * n); sv[bj][n] = *(const PG8_LAS f32x4*)(vec + 256 + wc * 32 + 8 * fq + bj * HALF + 4 * n); }
#pragma unroll
        for (int ai = 0; ai < 2; ++ai)
#pragma unroll
            for (int m = 0; m < 4; ++m) { unsigned char* rowp = O + (size_t)(row0 + ai * HALF + m * 16) * D + col0;
#pragma unroll
                for (int bj = 0; bj < 2; ++bj) { const f32x4 v0 = acc[ai][bj][m][0] * sv[bj][0] + bv[bj][0], v1 = acc[ai][bj][m][1] * sv[bj][1] + bv[bj][1];
                    int w0 = 0, w1 = 0; w0 = __builtin_amdgcn_cvt_pk_fp8_f32(v0[0], v0[1], w0, false); w0 = __builtin_amdgcn_cvt_pk_fp8_f32(v0[2], v0[3], w0, true);
                    w1 = __builtin_amdgcn_cvt_pk_fp8_f32(v1[0], v1[1], w1, false); w1 = __builtin_amdgcn_cvt_pk_fp8_f32(v1[2], v1[3], w1, true);
                    u32x2 w; w.x = (unsigned)w0; w.y = (unsigned)w1; *(u32x2*)(rowp + bj * HALF) = w; } }
    }
};
constexpr int EPV_OFF = 131072 + 12288;
typedef int v8i_t __attribute__((ext_vector_type(8)));
typedef int v4i_t __attribute__((ext_vector_type(4)));
template <class Epi, class Sched, int DT = 0, bool GATHER = false, bool ALIGN_EPI = true, bool SP2 = true>
__device__ __forceinline__ void gemm_phase(PG8_LAS unsigned char* lds, const Gemm g, const Sched& S, const Epi& E, const int tid = threadIdx.x) {
    const int wid = __builtin_amdgcn_readfirstlane(tid >> 6), lane = tid & 63, wr = wid >> 2, wc = wid & 3, fr = lane & 15, fq = lane >> 4;
    const int K = g.K, nt = K / BK;
    unsigned voffA[2], voffB[2]; int gR[2], gC[2];
#pragma unroll
    for (int i = 0; i < 2; ++i) { int R, C; stage_rc(tid * 16 + i * 8192, R, C); const int Rb = Epi::PERM ? ((R & ~31) + perm32(R & 31)) : R;
        voffA[i] = (unsigned)(R * K + C) * 2u; voffB[i] = (unsigned)(Rb * K + C) * 2u; gR[i] = R; gC[i] = C * 2; }
    unsigned offC[2][2], offN[2][2];
#define PG8_GOFF(dst, uidx) do { _Pragma("unroll") for (int _h = 0; _h < 2; ++_h) _Pragma("unroll") for (int _i = 0; _i < 2; ++_i) \
        dst[_h][_i] = (unsigned)g.lt[(uidx) * 256 + _h * 128 + gR[_i]] * (unsigned)(K * 2) + (unsigned)gC[_i]; } while (0)
    const size_t kstep = (size_t)(BK * 2), hstep = (size_t)HALF * K * 2, tstep = 2 * hstep, estep = g.bstride * 2;
    const unsigned ldsw = (unsigned)wid * 1024u;
    const int aoff = lds_byte(wr * 64 + fr, fq * 8), boff = lds_byte(wc * 32 + fr, fq * 8);
#define PG8_SA(b, h) (((b) * 2 + (h)) * HTB)
#define PG8_SB(b, h) ((4 + (b) * 2 + (h)) * HTB)
#define PG8_STAGE(bufoff, gbase, voff) do { _Pragma("unroll") for (int _i = 0; _i < 2; ++_i) \
        __builtin_amdgcn_global_load_lds((const unsigned*)((const char*)(gbase) + (voff)[_i]), (PG8_LAS unsigned*)(lds + (bufoff) + ldsw + _i * 8192), 16, 0, 0); } while (0)
#define PG8_LDA(dst, b, h) do { if constexpr (DT == 1) { _Pragma("unroll") for (int m = 0; m < 4; ++m) dst##8[m] = __builtin_shufflevector(*(const PG8_LAS v4i_t*)(lds + PG8_SA(b, h) + aoff + m * 2048), *(const PG8_LAS v4i_t*)(lds + PG8_SA(b, h) + aoff + m * 2048 + 1024), 0, 1, 2, 3, 4, 5, 6, 7); } \
        else { _Pragma("unroll") for (int m = 0; m < 4; ++m) _Pragma("unroll") for (int k = 0; k < 2; ++k) dst[m][k] = *(const PG8_LAS bf16x8*)(lds + PG8_SA(b, h) + aoff + m * 2048 + k * 1024); } } while (0)
#define PG8_LDB(dst, b, h) do { if constexpr (DT == 1) { _Pragma("unroll") for (int n = 0; n < 2; ++n) dst##8[n] = __builtin_shufflevector(*(const PG8_LAS v4i_t*)(lds + PG8_SB(b, h) + boff + n * 2048), *(const PG8_LAS v4i_t*)(lds + PG8_SB(b, h) + boff + n * 2048 + 1024), 0, 1, 2, 3, 4, 5, 6, 7); } \
        else { _Pragma("unroll") for (int n = 0; n < 2; ++n) _Pragma("unroll") for (int k = 0; k < 2; ++k) dst[n][k] = *(const PG8_LAS bf16x8*)(lds + PG8_SB(b, h) + boff + n * 2048 + k * 1024); } } while (0)
#define PG8_MMA(ai, bj, At, Bt) do { __builtin_amdgcn_s_setprio(1); if constexpr (DT == 1) { _Pragma("unroll") for (int m = 0; m < 4; ++m) _Pragma("unroll") for (int n = 0; n < 2; ++n) \
        asm volatile("v_mfma_scale_f32_16x16x128_f8f6f4 %0, %1, %2, %0, %3, %3 op_sel_hi:[0,0,0]" : "+v"(acc[ai][bj][m][n]) : "v"(Bt##8[n]), "v"(At##8[m]), "v"(sc1)); } \
        else if constexpr (DT == 2) { _Pragma("unroll") for (int m = 0; m < 4; ++m) _Pragma("unroll") for (int n = 0; n < 2; ++n) _Pragma("unroll") for (int k = 0; k < 2; ++k) \
        asm volatile("v_mfma_i32_16x16x64_i8 %0, %1, %2, %0" : "+v"(acc[ai][bj][m][n]) : "v"(Bt[n][k]), "v"(At[m][k])); } \
        else { _Pragma("unroll") for (int m = 0; m < 4; ++m) _Pragma("unroll") for (int n = 0; n < 2; ++n) _Pragma("unroll") for (int k = 0; k < 2; ++k) \
        acc[ai][bj][m][n] = __builtin_amdgcn_mfma_f32_16x16x32_bf16(Bt[n][k], At[m][k], acc[ai][bj][m][n], 0, 0, 0); } __builtin_amdgcn_s_setprio(0); } while (0)
#define PG8_STAGE_A(bufoff, h, which) do { if constexpr (GATHER) { _Pragma("unroll") for (int _i = 0; _i < 2; ++_i) { \
            const unsigned _o = ((which) == 1) ? offC[h][_i] : (last ? offN[h][_i] : offC[h][_i]); const size_t _kb = ((which) == 1) ? (size_t)(t + 1) * kstep : ((last ? (size_t)0 : (size_t)(t + 2) * kstep) + ((which) == 3 ? kstep : 0)); \
            __builtin_amdgcn_global_load_lds((const unsigned*)((const char*)g.A + _kb + _o), (PG8_LAS unsigned*)(lds + (bufoff) + ldsw + _i * 8192), 16, 0, 0); } } \
        else { const char* _p = ((which) == 1 ? a1 : ((which) == 2 ? a2 : a3)) + (h) * hstep; PG8_STAGE(bufoff, _p, voffA); } } while (0)
#define PG8_WAIT_V(n) asm volatile("s_waitcnt vmcnt(" #n ")" ::: "memory")
#define PG8_WAIT_L(n) asm volatile("s_waitcnt lgkmcnt(" #n ")" ::: "memory")
#define PG8_BAR __builtin_amdgcn_s_barrier()
#define PG8_SCHED __builtin_amdgcn_sched_barrier(0)
    static_assert(!GATHER || SP2, "GATHER is written for the SP2 loop");
    Unit cur, nxt; int ui = 0;
    if (!S.next(0, cur)) return;
#define PG8_EPV(u, uidx) do { if constexpr (Epi::HAS_VEC) { int _te = tid; asm volatile("" : "+v"(_te)); if (wid < 2) __builtin_amdgcn_global_load_lds((const unsigned*)E.vec_src(u, _te), (PG8_LAS unsigned*)(lds + EPV_OFF + ((uidx) & 1) * 2048 + wid * 1024), 16, 0, 0); } } while (0)
    PG8_EPV(cur, 0);
    f32x4 acc[2][2][4][2];
#pragma unroll
    for (int a = 0; a < 2; ++a)
#pragma unroll
        for (int b = 0; b < 2; ++b)
#pragma unroll
            for (int m = 0; m < 4; ++m)
#pragma unroll
                for (int n = 0; n < 2; ++n) acc[a][b][m][n] = (f32x4){0.f, 0.f, 0.f, 0.f};
    bf16x8 At[4][2], B0[2][2], B1[2][2]; v8i_t At8[4], B08[2], B18[2];
    int sc1 = 0x7F7F7F7F; asm volatile("" : "+v"(sc1));
    const char* cA = GATHER ? (const char*)g.A : (const char*)g.A + (size_t)cur.pm * tstep; const char* cB = (const char*)g.Bt + (size_t)cur.e * estep + (size_t)cur.pn * tstep;
    if constexpr (GATHER) { PG8_GOFF(offC, 0); }
#define PG8_STAGE_A0(bufoff, h, kb) do { if constexpr (GATHER) { _Pragma("unroll") for (int _i = 0; _i < 2; ++_i) \
            __builtin_amdgcn_global_load_lds((const unsigned*)((const char*)g.A + (size_t)(kb) + offC[h][_i]), (PG8_LAS unsigned*)(lds + (bufoff) + ldsw + _i * 8192), 16, 0, 0); } \
        else PG8_STAGE(bufoff, cA + (h) * hstep + (kb), voffA); } while (0)
    if constexpr (SP2) {
        PG8_STAGE(PG8_SB(0, 0), cB, voffB); PG8_STAGE(PG8_SB(0, 1), cB + hstep, voffB); PG8_STAGE_A0(PG8_SA(0, 0), 0, 0); PG8_STAGE_A0(PG8_SA(0, 1), 1, 0);
        if (wr == 1) PG8_BAR;
        PG8_WAIT_V(2); PG8_BAR;
        PG8_STAGE(PG8_SB(1, 0), cB + kstep, voffB); PG8_STAGE_A0(PG8_SA(1, 0), 0, kstep); PG8_STAGE(PG8_SB(1, 1), cB + hstep + kstep, voffB);
        PG8_WAIT_V(6); PG8_BAR;
    } else {
        PG8_STAGE(PG8_SB(0, 0), cB, voffB); PG8_STAGE(PG8_SA(0, 0), cA, voffA); PG8_STAGE(PG8_SB(0, 1), cB + hstep, voffB); PG8_STAGE(PG8_SA(0, 1), cA + hstep, voffA);
        if (wr == 1) PG8_BAR;
        PG8_WAIT_V(4); PG8_BAR;
        PG8_STAGE(PG8_SB(1, 0), cB + kstep, voffB); PG8_STAGE(PG8_SA(1, 0), cA + kstep, voffA); PG8_STAGE(PG8_SB(1, 1), cB + hstep + kstep, voffB);
        PG8_WAIT_V(6); PG8_BAR;
    }
    for (;;) {
        const bool has_next = S.next(ui + 1, nxt);
        const char* nA = (has_next && !GATHER) ? (const char*)g.A + (size_t)nxt.pm * tstep : cA; const char* nB = has_next ? (const char*)g.Bt + (size_t)nxt.e * estep + (size_t)nxt.pn * tstep : cB;
        if constexpr (GATHER) { if (has_next) { PG8_GOFF(offN, ui + 1); } else {
#pragma unroll
            for (int _h = 0; _h < 2; ++_h) { offN[_h][0] = offC[_h][0]; offN[_h][1] = offC[_h][1]; } } }
#pragma unroll 1
        for (int t = 0; t < nt; t += 2) {
            const bool last = (t == nt - 2);
            const char* a1 = cA + (size_t)(t + 1) * kstep;
            const char* a2 = last ? nA : cA + (size_t)(t + 2) * kstep; const char* b2 = last ? nB : cB + (size_t)(t + 2) * kstep;
            const char* a3 = a2 + kstep; const char* b3 = b2 + kstep;
            if constexpr (SP2) {
            PG8_LDB(B0, 0, 0); PG8_LDB(B1, 0, 1); PG8_SCHED; PG8_LDA(At, 0, 0); PG8_STAGE_A(PG8_SA(1, 1), 1, 1);
            PG8_WAIT_V(8); PG8_WAIT_L(0); PG8_BAR; PG8_MMA(0, 0, At, B0); PG8_MMA(0, 1, At, B1); PG8_BAR; PG8_SCHED;
            PG8_LDA(At, 0, 1); PG8_STAGE(PG8_SB(0, 0), b2, voffB); PG8_STAGE(PG8_SB(0, 1), b2 + hstep, voffB); PG8_STAGE_A(PG8_SA(0, 0), 0, 2);
            PG8_WAIT_V(8); PG8_WAIT_L(0); PG8_BAR; PG8_MMA(1, 0, At, B0); PG8_MMA(1, 1, At, B1); PG8_BAR; PG8_SCHED;
            PG8_LDB(B0, 1, 0); PG8_LDB(B1, 1, 1); PG8_SCHED; PG8_LDA(At, 1, 0); PG8_STAGE_A(PG8_SA(0, 1), 1, 2);
            PG8_WAIT_V(8); PG8_WAIT_L(0); PG8_BAR; PG8_MMA(0, 0, At, B0); PG8_MMA(0, 1, At, B1); PG8_BAR; PG8_SCHED;
            PG8_LDA(At, 1, 1); PG8_STAGE(PG8_SB(1, 0), b3, voffB); PG8_STAGE(PG8_SB(1, 1), b3 + hstep, voffB); PG8_STAGE_A(PG8_SA(1, 0), 0, 3);
            PG8_WAIT_V(8); PG8_WAIT_L(0); PG8_BAR; PG8_MMA(1, 0, At, B0); PG8_MMA(1, 1, At, B1); PG8_BAR; PG8_SCHED;
            } else {
            PG8_LDB(B0, 0, 0); PG8_SCHED; PG8_LDA(At, 0, 0); PG8_STAGE(PG8_SA(1, 1), a1 + hstep, voffA);
            PG8_WAIT_L(8); PG8_BAR; PG8_WAIT_L(0); PG8_MMA(0, 0, At, B0); PG8_BAR; PG8_SCHED;
            PG8_LDB(B1, 0, 1); PG8_STAGE(PG8_SB(0, 0), b2, voffB);
            PG8_BAR; PG8_WAIT_L(0); PG8_MMA(0, 1, At, B1); PG8_BAR;
            PG8_LDA(At, 0, 1); PG8_STAGE(PG8_SA(0, 0), a2, voffA);
            PG8_BAR; PG8_WAIT_L(0); PG8_MMA(1, 0, At, B0); PG8_BAR; PG8_SCHED;
            PG8_STAGE(PG8_SB(0, 1), b2 + hstep, voffB);
            PG8_WAIT_V(6); PG8_BAR; PG8_MMA(1, 1, At, B1); PG8_BAR;
            PG8_LDB(B0, 1, 0); PG8_SCHED; PG8_LDA(At, 1, 0); PG8_STAGE(PG8_SA(0, 1), a2 + hstep, voffA);
            PG8_WAIT_L(8); PG8_BAR; PG8_WAIT_L(0); PG8_MMA(0, 0, At, B0); PG8_BAR; PG8_SCHED;
            PG8_LDB(B1, 1, 1); PG8_STAGE(PG8_SB(1, 0), b3, voffB);
            PG8_BAR; PG8_WAIT_L(0); PG8_MMA(0, 1, At, B1); PG8_BAR;
            PG8_LDA(At, 1, 1); PG8_STAGE(PG8_SA(1, 0), a3, voffA);
            PG8_BAR; PG8_WAIT_L(0); PG8_MMA(1, 0, At, B0); PG8_BAR; PG8_SCHED;
            PG8_STAGE(PG8_SB(1, 1), b3 + hstep, voffB);
            PG8_WAIT_V(6); PG8_BAR; PG8_MMA(1, 1, At, B1); PG8_BAR;
            }
        }
        if constexpr (DT != 0) asm volatile("s_nop 15\n\ts_nop 15\n\ts_nop 7" ::: "memory");
        if constexpr (ALIGN_EPI) { if (wr == 0) PG8_BAR; }
        E(acc, cur, wr, wc, fr, fq, (const PG8_LAS float*)(lds + EPV_OFF + (ui & 1) * 2048));
        if (!has_next) break;
#pragma unroll
        for (int a = 0; a < 2; ++a)
#pragma unroll
            for (int b = 0; b < 2; ++b)
#pragma unroll
                for (int m = 0; m < 4; ++m)
#pragma unroll
                    for (int n = 0; n < 2; ++n) acc[a][b][m][n] = (f32x4){0.f, 0.f, 0.f, 0.f};
        cur = nxt; cA = nA; cB = nB; ++ui;
        PG8_EPV(cur, ui);
        if constexpr (GATHER) {
#pragma unroll
            for (int _h = 0; _h < 2; ++_h) { offC[_h][0] = offN[_h][0]; offC[_h][1] = offN[_h][1]; } }
        if constexpr (ALIGN_EPI) { if (wr == 1) PG8_BAR; }
    }
    PG8_WAIT_V(0);
    if constexpr (!ALIGN_EPI) { if (wr == 0) PG8_BAR; }
    PG8_BAR;
#undef PG8_SA
#undef PG8_SB
#undef PG8_STAGE
#undef PG8_EPV
#undef PG8_STAGE_A
#undef PG8_STAGE_A0
#undef PG8_GOFF
#undef PG8_LDA
#undef PG8_LDB
#undef PG8_MMA
#undef PG8_WAIT_V
#undef PG8_WAIT_L
#undef PG8_BAR
#undef PG8_SCHED
}
}

constexpr size_t MiB = 1u << 20;
constexpr size_t WS_CTL = 0, CTL_ZERO_BYTES = 1 * MiB;
constexpr size_t WS_ASG_E = 1 * MiB, WS_ASG_SLOT = WS_ASG_E + (size_t)NASG * 4, WS_ASG_G = WS_ASG_SLOT + (size_t)NASG * 4, WS_ASG_ROW = WS_ASG_G + (size_t)NASG * 4;
constexpr size_t WS_WRT = 3 * MiB;
constexpr size_t WS_SUP = WS_WRT + 64 * 1024, WS_SDN = WS_SUP + 32 * 2048 * 4;
constexpr size_t WS_ROWTOK = WS_SDN + 32 * 1024 * 4;
constexpr size_t WS_WPA = 4 * MiB, WS_WPB = 5 * MiB, WS_WOUT = 7 * MiB, WS_WIN = 9 * MiB;
constexpr size_t WS_WUP = 29 * MiB, WS_WDN = 93 * MiB;
constexpr size_t WS_XN = 125 * MiB;
constexpr size_t WS_GSTATE = WS_XN, WS_GDEC = WS_XN + 32 * MiB;
constexpr size_t WS_SX = WS_XN + 40 * MiB, WS_SWIN = WS_XN + 41 * MiB;
constexpr size_t WS_OA = 189 * MiB, WS_OB = 221 * MiB;
constexpr size_t WS_H1 = WS_OA;
constexpr size_t WS_HN = WS_OB + 32 * MiB;
constexpr size_t WS_PROJ = 285 * MiB;
constexpr size_t WS_ACT = WS_PROJ, WS_YB = WS_PROJ + 136 * MiB;
constexpr size_t WS_PS = WS_PROJ + 300 * MiB;
constexpr size_t WS_END = 925 * MiB;
static_assert(WS_ROWTOK + (size_t)MAXTILES * 256 * 4 <= WS_WPA && WS_PROJ + (size_t)T * NP * 2 == WS_END && WS_YB + (size_t)MAXTILES * 256 * D * 2 <= WS_END && (size_t)MAXTILES * 256 * D <= 136 * MiB, "d_ws map");
constexpr size_t OUT_OG = 0, OUT_LSE = 96 * MiB;
constexpr int CW_BAR = 4096, CW_CNT = 32768;
constexpr int RING_BYTES = 131072, MISC_OFF = RING_BYTES, TBL_OFF = RING_BYTES + 512, LDS_BYTES = 147456;

#define XB_TMO      128
#define XB_XCNT(j)  (256  + 64 * (j))
#define XB_XSUB(j)  (1280 + 64 * (j))
#define XB_XGEN(j)  (2304 + 64 * (j))
#define XB_TOP      3328
#define XB_TOPGEN   3392
#define XCD_BAR_WORDS 3456
#define XB_SPIN_CAP (1u << 18)
__device__ __forceinline__ unsigned xb_ld(unsigned* p)              { return __hip_atomic_load(p, __ATOMIC_RELAXED, __HIP_MEMORY_SCOPE_AGENT); }
__device__ __forceinline__ unsigned xb_add(unsigned* p, unsigned v) { return __hip_atomic_fetch_add(p, v, __ATOMIC_RELAXED, __HIP_MEMORY_SCOPE_AGENT); }
__device__ __forceinline__ unsigned xb_xcc_id() { return (unsigned)__builtin_amdgcn_s_getreg((3 << 11) | 20) & 0xFu; }
#define XB_SPIN(cond, bar) do { unsigned _sp = 0; while (cond) { __builtin_amdgcn_s_sleep(1); \
    if ((++_sp & 255u) == 0u) { if (xb_ld(&(bar)[XB_TMO])) break; if (_sp > XB_SPIN_CAP) { atomicAdd(&(bar)[XB_TMO], 1u); break; } } } } while (0)
struct XcdBarrier { unsigned* bar; unsigned x; volatile LAS unsigned* st; };
__device__ __forceinline__ XcdBarrier xcd_barrier_post(unsigned* bar, volatile LAS unsigned* st) {
    XcdBarrier b; b.bar = bar; b.x = xb_xcc_id(); b.st = st;
    if (threadIdx.x == 0) (void)xb_add(&bar[XB_XCNT(b.x)], 1u);
    return b;
}
__device__ __forceinline__ void xcd_barrier_complete(unsigned* bar, unsigned x, unsigned& nloc, unsigned& nx) {
    const unsigned G = gridDim.x * gridDim.y * gridDim.z;
    unsigned sum, cnt, mine, sp = 0u;
    for (;;) {
        sum = 0u; cnt = 0u; mine = 0u;
#pragma unroll
        for (unsigned j = 0; j < 16; ++j) { const unsigned c = xb_ld(&bar[XB_XCNT(j)]); sum += c; cnt += (c > 0u) ? 1u : 0u; mine = (j == x) ? c : mine; }
        if (sum == G) break;
        __builtin_amdgcn_s_sleep(1);
        if ((++sp & 255u) == 0u) { if (xb_ld(&bar[XB_TMO])) break; if (sp > XB_SPIN_CAP) { atomicAdd(&bar[XB_TMO], 1u); break; } }
    }
    nloc = mine > 0u ? mine : 1u; nx = cnt > 0u ? cnt : 1u;
}
__device__ __forceinline__ void xcd_barrier(const XcdBarrier& b) {
    asm volatile("s_waitcnt vmcnt(0)" ::: "memory");
    __syncthreads();
    if (threadIdx.x == 0) {
        unsigned* bar = b.bar;
        __builtin_amdgcn_s_waitcnt(0);
        unsigned nloc = b.st[0], nx = b.st[1];
        if (nloc == 0u) { xcd_barrier_complete(bar, b.x, nloc, nx); b.st[0] = nloc; b.st[1] = nx; }
        const unsigned old = xb_add(&bar[XB_XSUB(b.x)], 1u);
        const unsigned gen = old / nloc;
        if (old + 1u == (gen + 1u) * nloc) {
            __builtin_amdgcn_fence(__ATOMIC_RELEASE, "agent");
            asm volatile("s_waitcnt vmcnt(0)" ::: "memory");
            const unsigned og = xb_add(&bar[XB_TOP], 1u);
            const unsigned tg = og / nx;
            if (og + 1u == (tg + 1u) * nx) xb_add(&bar[XB_TOPGEN], 1u);
            else XB_SPIN(xb_ld(&bar[XB_TOPGEN]) == tg, bar);
            __builtin_amdgcn_fence(__ATOMIC_ACQUIRE, "agent");
            xb_add(&bar[XB_XGEN(b.x)], 1u);
            asm volatile("s_waitcnt vmcnt(0)" ::: "memory");
        } else {
            XB_SPIN(xb_ld(&bar[XB_XGEN(b.x)]) == gen, bar);
            __builtin_amdgcn_fence(__ATOMIC_ACQUIRE, "agent");
            asm volatile("s_waitcnt vmcnt(0)" ::: "memory");
        }
    }
    __syncthreads();
}

DI float wave_sum(float v) {
#pragma unroll
    for (int o = 1; o < 64; o <<= 1) v += __shfl_xor(v, o);
    return v;
}
DI unsigned offb(unsigned row, unsigned ch) { return 256u * row + 16u * (ch ^ (((row & 3u) << 2) | ((row >> 2) & 3u))); }
DI s16x4 vtr(const LAS unsigned char* p) { return __builtin_bit_cast(s16x4, __builtin_amdgcn_ds_read_tr16_b64_v4i16((LAS v4i16_t*)p)); }
DI s16x4 tr4(const LAS unsigned char* img, int rowbase, int c, int lane) { const int q = (lane & 15) >> 2, p = lane & 3; return vtr(img + offb((unsigned)(rowbase + q), (unsigned)(2 * c + (p >> 1))) + 8 * (p & 1)); }

struct Ptrs {
    const float *x, *ln1, *w_in, *w_gk2, *b_gk2, *gnorm, *wpa, *wpb, *wout, *ln2, *wr, *br, *wup, *bup, *wdn, *bdn, *lnf;
    float* out; unsigned char* ws; gu32* ctl;
};

DI void p0_tile(const float* W, int ldw, int k0, int sc0, bf16* WT, int K, int dr0, LAS float* scr, int lane) {
#pragma unroll 8
    for (int i = 0; i < 32; ++i) { const int kk = 2 * i + (lane >> 5); scr[kk * 33 + (lane & 31)] = W[(size_t)(k0 + kk) * ldw + sc0 + (lane & 31)]; }
    LDS_WAIT(); asm volatile("" ::: "memory");
    const int c = lane & 7;
#pragma unroll
    for (int j = 0; j < 4; ++j) { const int n = (lane >> 3) + 8 * j; const LAS float* s = scr + (8 * c) * 33 + n;
        u32x4 o; o.x = pk2(s[0 * 33], s[1 * 33]); o.y = pk2(s[2 * 33], s[3 * 33]); o.z = pk2(s[4 * 33], s[5 * 33]); o.w = pk2(s[6 * 33], s[7 * 33]);
        *(u32x4*)(WT + (size_t)(dr0 + n) * K + k0 + 8 * c) = o; }
    LDS_WAIT(); asm volatile("" ::: "memory");
}
DI void rms_row_to_bf16(const float* xrow, const float* w, bf16* orow, int lane) {
    const f32x4* xr = (const f32x4*)xrow + lane; const f32x4* wr = (const f32x4*)w + lane;
    f32x4 v[4]; float s = 0.f;
#pragma unroll
    for (int j = 0; j < 4; ++j) { v[j] = xr[64 * j]; s += (v[j].x * v[j].x + v[j].y * v[j].y) + (v[j].z * v[j].z + v[j].w * v[j].w); }
    const float rstd = 1.f / sqrtf(wave_sum(s) * (1.f / D) + RMS_EPS);
    u32x2* o8 = (u32x2*)orow + lane;
#pragma unroll
    for (int j = 0; j < 4; ++j) { const f32x4 ww = wr[64 * j]; u32x2 o; o.x = pk2(v[j].x * rstd * ww.x, v[j].y * rstd * ww.y); o.y = pk2(v[j].z * rstd * ww.z, v[j].w * rstd * ww.w); o8[64 * j] = o; }
}
constexpr int PMAX_OFF = 131072 + 1024;
struct QItem { const float* W; int ldw, sc0, dr0; unsigned char* W8; float* sc; };
DI QItem p0_qitem(const Ptrs& P, int it) { QItem q;
    if (it < 32 * 64) { const int e = it >> 6, nb = it & 63, c0 = 32 * nb; q.W = P.wup + (size_t)e * 1024 * 2048; q.ldw = 2048; q.sc0 = c0;
        q.dr0 = (c0 < 1024) ? 256 * (c0 >> 7) + (c0 & 127) : 256 * ((c0 - 1024) >> 7) + 128 + (c0 & 127); q.W8 = P.ws + WS_WUP + (size_t)e * 2048 * 1024; q.sc = (float*)(P.ws + WS_SUP) + e * 2048; }
    else { const int r = it - 32 * 64, e = r >> 5, nb = r & 31; q.W = P.wdn + (size_t)e * 1024 * 1024; q.ldw = 1024; q.sc0 = 32 * nb; q.dr0 = 32 * nb; q.W8 = P.ws + WS_WDN + (size_t)e * 1024 * 1024; q.sc = (float*)(P.ws + WS_SDN) + e * 1024; }
    return q; }
DI void p0_qload(f32x4 (&v)[16], const QItem& q, int w, int lane) {
#pragma unroll
    for (int i = 0; i < 16; ++i) v[i] = *(const f32x4*)(q.W + (size_t)(128 * w + 8 * i + (lane >> 3)) * q.ldw + q.sc0 + 4 * (lane & 7));
}
DI void p0_quant_all(const Ptrs& P, LAS unsigned char* lds, int vcu, int G, int tid, int j0, int j1) {
    const int lane = tid & 63, w = tid >> 6; LAS float* scr = (LAS float*)(lds + w * 16384); LAS float* PM = (LAS float*)(lds + PMAX_OFF);
    constexpr int NQ = 32 * 64 + 32 * 32; const int NQE = (vcu + (long)j1 * G < NQ) ? vcu + j1 * G : NQ;
    f32x4 v[16]; int it = vcu + j0 * G;
    if (it < NQE) p0_qload(v, p0_qitem(P, it), w, lane);
#pragma unroll 1
    for (; it < NQE; it += G) { const QItem q = p0_qitem(P, it);
        { const int ng8 = lane & 7, rsub = lane >> 3; f32x4 mx = {0.f, 0.f, 0.f, 0.f};
#pragma unroll
          for (int i = 0; i < 16; ++i) { const int kk = 8 * i + rsub; *(LAS f32x4*)(scr + kk * 32 + 4 * ((ng8 + (kk >> 4)) & 7)) = v[i];
              mx.x = fmaxf(mx.x, fabsf(v[i].x)); mx.y = fmaxf(mx.y, fabsf(v[i].y)); mx.z = fmaxf(mx.z, fabsf(v[i].z)); mx.w = fmaxf(mx.w, fabsf(v[i].w)); }
#pragma unroll
          for (int o = 8; o < 64; o <<= 1) { mx.x = fmaxf(mx.x, __shfl_xor(mx.x, o)); mx.y = fmaxf(mx.y, __shfl_xor(mx.y, o)); mx.z = fmaxf(mx.z, __shfl_xor(mx.z, o)); mx.w = fmaxf(mx.w, __shfl_xor(mx.w, o)); }
          if (lane < 8) *(LAS f32x4*)(PM + w * 32 + 4 * lane) = mx; }
        __syncthreads();
        if (it + G < NQE) p0_qload(v, p0_qitem(P, it + G), w, lane);
        { const int c = lane & 7, ng = lane >> 3; f32x4 am = {0.f, 0.f, 0.f, 0.f};
#pragma unroll
          for (int w2 = 0; w2 < 8; ++w2) { const f32x4 t = *(const LAS f32x4*)(PM + w2 * 32 + 4 * ng); am.x = fmaxf(am.x, t.x); am.y = fmaxf(am.y, t.y); am.z = fmaxf(am.z, t.z); am.w = fmaxf(am.w, t.w); }
          float sc[4], inv[4];
#pragma unroll
          for (int j = 0; j < 4; ++j) { const float a = am[j]; const int ex = (int)((__float_as_uint(a) >> 23) & 0xffu) - 127;
              sc[j] = (a > 0.f) ? __uint_as_float((unsigned)(127 + 7 - ex) << 23) : 1.0f; inv[j] = (a > 0.f) ? __uint_as_float((unsigned)(127 - 7 + ex) << 23) : 1.0f; }
          if (w == 0 && c == 0) *(f32x4*)(q.sc + q.dr0 + 4 * ng) = (f32x4){inv[0], inv[1], inv[2], inv[3]};
          f32x4 x[16];
#pragma unroll
          for (int i = 0; i < 16; ++i) x[i] = *(const LAS f32x4*)(scr + (16 * c + i) * 32 + 4 * ((ng + c) & 7));
#pragma unroll
          for (int j = 0; j < 4; ++j) { int o[4];
#pragma unroll
              for (int qq = 0; qq < 4; ++qq) { int t = 0; t = __builtin_amdgcn_cvt_pk_fp8_f32(x[4 * qq][j] * sc[j], x[4 * qq + 1][j] * sc[j], t, false); t = __builtin_amdgcn_cvt_pk_fp8_f32(x[4 * qq + 2][j] * sc[j], x[4 * qq + 3][j] * sc[j], t, true); o[qq] = t; }
              u32x4 ov; ov.x = (unsigned)o[0]; ov.y = (unsigned)o[1]; ov.z = (unsigned)o[2]; ov.w = (unsigned)o[3];
              *(u32x4*)(q.W8 + (size_t)(q.dr0 + 4 * ng + j) * 1024 + 128 * w + 16 * c) = ov; } }
        __syncthreads(); }
}
DI void p0_win_load(float (&v)[64], const Ptrs& P, int it, int w, int lane) {
    const int n = lane & 31; const int sc0 = (it < 240) ? 32 * it : 7696 + 32 * (it - 240);
#pragma unroll
    for (int i = 0; i < 64; ++i) v[i] = P.w_in[(size_t)(128 * w + 2 * i + (lane >> 5)) * IN_W + sc0 + n];
}
DI void p0_quant_win(const Ptrs& P, LAS unsigned char* lds, int vcu, int G, int tid) {
    const int lane = tid & 63, w = tid >> 6; LAS float* scr = (LAS float*)(lds + w * 16384); LAS float* PM = (LAS float*)(lds + PMAX_OFF);
    signed char* W8 = (signed char*)(P.ws + WS_WIN); float* SW = (float*)(P.ws + WS_SWIN);
    constexpr int NQ = 320; float v[64];
#pragma unroll 1
    for (int it = vcu; it < NQ; it += G) { const int dr0 = (it < 240) ? 32 * it : ((it < 304) ? C_MA + 32 * (it - 240) : C_GF + 32 * (it - 304));
        const int n = lane & 31; float mx = 0.f;
        if (it < 304) { p0_win_load(v, P, it, w, lane);
#pragma unroll
            for (int i = 0; i < 64; ++i) { const int kk = 2 * i + (lane >> 5); scr[kk * 32 + ((n + 4 * (kk >> 4)) & 31)] = v[i]; mx = fmaxf(mx, fabsf(v[i])); } }
        else { const int j = 32 * (it - 304) + n; float w2[16];
#pragma unroll
            for (int r = 0; r < 16; ++r) w2[r] = P.w_gk2[r * 512 + j];
#pragma unroll 2
            for (int i = 0; i < 64; ++i) { const int kk = 2 * i + (lane >> 5); const f32x4* src = (const f32x4*)(P.w_in + (size_t)(128 * w + kk) * IN_W + 7680); float a = 0.f;
#pragma unroll
                for (int q = 0; q < 4; ++q) { const f32x4 t = src[q]; a += t.x * w2[4 * q] + t.y * w2[4 * q + 1] + t.z * w2[4 * q + 2] + t.w * w2[4 * q + 3]; }
                scr[kk * 32 + ((n + 4 * (kk >> 4)) & 31)] = a; mx = fmaxf(mx, fabsf(a)); } }
        mx = fmaxf(mx, __shfl_xor(mx, 32));
        if (lane < 32) PM[w * 32 + lane] = mx;
        __syncthreads();
        const int c = lane & 7, nn = lane >> 3;
#pragma unroll
        for (int j = 0; j < 4; ++j) { const int n2 = nn + 8 * j; float am = 0.f;
#pragma unroll
            for (int w2 = 0; w2 < 8; ++w2) am = fmaxf(am, PM[w2 * 32 + n2]);
            const float sc = (am > 0.f) ? 127.0f / am : 1.0f;
            if (w == 0 && c == 0) SW[dr0 + n2] = (am > 0.f) ? am * (1.0f / 127.0f) : 1.0f;
            unsigned o[4];
#pragma unroll
            for (int qq = 0; qq < 4; ++qq) { unsigned t = 0u;
#pragma unroll
                for (int e = 0; e < 4; ++e) { const int qi = (int)rintf(scr[(16 * c + 4 * qq + e) * 32 + ((n2 + 4 * c) & 31)] * sc); t |= ((unsigned)qi & 0xffu) << (8 * e); }
                o[qq] = t; }
            u32x4 ov; ov.x = o[0]; ov.y = o[1]; ov.z = o[2]; ov.w = o[3];
            *(u32x4*)(W8 + (size_t)(dr0 + n2) * 1024 + 128 * w + 16 * c) = ov; }
        __syncthreads(); }
}
template <int NR> DI void rms_rows_to_i8(const float* x0, const float* w, signed char* o0, float* sx0, int lane) {
    const f32x4* xr = (const f32x4*)x0 + lane; const f32x4* wr = (const f32x4*)w + lane;
    f32x4 v[NR][4], wv[4]; float ss[NR], mx[NR];
#pragma unroll
    for (int j = 0; j < 4; ++j) wv[j] = wr[64 * j];
#pragma unroll
    for (int q = 0; q < NR; ++q)
#pragma unroll
        for (int j = 0; j < 4; ++j) v[q][j] = xr[256 * q + 64 * j];
#pragma unroll
    for (int q = 0; q < NR; ++q) { float s = 0.f;
#pragma unroll
        for (int j = 0; j < 4; ++j) s += (v[q][j].x * v[q][j].x + v[q][j].y * v[q][j].y) + (v[q][j].z * v[q][j].z + v[q][j].w * v[q][j].w);
        ss[q] = s; }
#pragma unroll
    for (int o = 1; o < 64; o <<= 1)
#pragma unroll
        for (int q = 0; q < NR; ++q) ss[q] += __shfl_xor(ss[q], o);
#pragma unroll
    for (int q = 0; q < NR; ++q) { const float r = 1.f / sqrtf(ss[q] * (1.f / D) + RMS_EPS); float m = 0.f;
#pragma unroll
        for (int j = 0; j < 4; ++j) { v[q][j] = v[q][j] * r * wv[j]; m = fmaxf(m, fmaxf(fmaxf(fabsf(v[q][j].x), fabsf(v[q][j].y)), fmaxf(fabsf(v[q][j].z), fabsf(v[q][j].w)))); }
        mx[q] = m; }
#pragma unroll
    for (int o = 1; o < 64; o <<= 1)
#pragma unroll
        for (int q = 0; q < NR; ++q) mx[q] = fmaxf(mx[q], __shfl_xor(mx[q], o));
#pragma unroll
    for (int q = 0; q < NR; ++q) { const float qa = (mx[q] > 0.f) ? 127.0f / mx[q] : 1.0f; if (lane == 0) sx0[q] = (mx[q] > 0.f) ? mx[q] * (1.0f / 127.0f) : 1.0f;
        unsigned* o4 = (unsigned*)o0 + 256 * q + lane;
#pragma unroll
        for (int j = 0; j < 4; ++j) o4[64 * j] = ((unsigned)(int)rintf(v[q][j].x * qa) & 0xffu) | (((unsigned)(int)rintf(v[q][j].y * qa) & 0xffu) << 8) | (((unsigned)(int)rintf(v[q][j].z * qa) & 0xffu) << 16) | (((unsigned)(int)rintf(v[q][j].w * qa) & 0xffu) << 24); }
}
DI void rms_rows2_to_bf16(const float* x0, const float* w, bf16* o0, int lane) {
    const f32x4* xr = (const f32x4*)x0 + lane; const f32x4* wr = (const f32x4*)w + lane;
    f32x4 va[4], vb[4], wv[4]; float sa = 0.f, sb = 0.f;
#pragma unroll
    for (int j = 0; j < 4; ++j) { va[j] = xr[64 * j]; vb[j] = xr[256 + 64 * j]; wv[j] = wr[64 * j]; }
#pragma unroll
    for (int j = 0; j < 4; ++j) { sa += (va[j].x * va[j].x + va[j].y * va[j].y) + (va[j].z * va[j].z + va[j].w * va[j].w); sb += (vb[j].x * vb[j].x + vb[j].y * vb[j].y) + (vb[j].z * vb[j].z + vb[j].w * vb[j].w); }
    const float ra = 1.f / sqrtf(wave_sum(sa) * (1.f / D) + RMS_EPS), rb = 1.f / sqrtf(wave_sum(sb) * (1.f / D) + RMS_EPS);
    u32x2* o8 = (u32x2*)o0 + lane;
#pragma unroll
    for (int j = 0; j < 4; ++j) { const f32x4 ww = wv[j]; u32x2 oa, ob; oa.x = pk2(va[j].x * ra * ww.x, va[j].y * ra * ww.y); oa.y = pk2(va[j].z * ra * ww.z, va[j].w * ra * ww.w);
        ob.x = pk2(vb[j].x * rb * ww.x, vb[j].y * rb * ww.y); ob.y = pk2(vb[j].z * rb * ww.z, vb[j].w * rb * ww.w); o8[64 * j] = oa; o8[256 + 64 * j] = ob; }
}
DI void p0_prologue(const Ptrs& P, LAS unsigned char* lds, int vcu, int G, int tid) {
    const int lane = tid & 63, wave = tid >> 6;
    LAS float* scr = (LAS float*)(lds + wave * 16384);
    const int gw = vcu * 8 + wave, NGW = G * 8;
    bf16* WIN_T = (bf16*)(P.ws + WS_WIN); bf16* WPA_T = (bf16*)(P.ws + WS_WPA); bf16* WPB_T = (bf16*)(P.ws + WS_WPB); bf16* WOUT_T = (bf16*)(P.ws + WS_WOUT);
    bf16* WRT = (bf16*)(P.ws + WS_WRT); unsigned char* WUP8 = P.ws + WS_WUP; unsigned char* WDN8 = P.ws + WS_WDN; bf16* XN = (bf16*)(P.ws + WS_XN);
#if BRINGUP != 1
    p0_quant_win(P, lds, vcu, G, tid);
    constexpr int I_PA = 8 * 32, I_PB = 16 * 32, I_OUT = 16 * 32, I_R = 16;
    constexpr int NITEMS = I_PA + I_PB + I_OUT + I_R;
    for (int it = gw; it < NITEMS; it += NGW) {
        int r = it;
        if (r < I_PA) { const int kb = r >> 5, nb = r & 31; p0_tile(P.wpa, 1024, 64 * kb, 32 * nb, WPA_T, 512, 32 * nb, scr, lane); continue; } r -= I_PA;
        if (r < I_PB) { const int kb = r >> 5, nb = r & 31; p0_tile(P.wpb, 1024, 64 * kb, 32 * nb, WPB_T, 1024, 32 * nb, scr, lane); continue; } r -= I_PB;
        if (r < I_OUT) { const int kb = r >> 5, nb = r & 31; p0_tile(P.wout, 1024, 64 * kb, 32 * nb, WOUT_T, 1024, 32 * nb, scr, lane); continue; } r -= I_OUT;
        p0_tile(P.wr, 32, 64 * r, 0, WRT, 1024, 0, scr, lane);
    }
    for (int m = gw * 4; m < T; m += NGW * 4) rms_rows_to_i8<4>(P.x + (size_t)m * D, P.ln1, (signed char*)(P.ws + WS_XN) + (size_t)m * D, (float*)(P.ws + WS_SX) + m, lane);
#endif
}

constexpr size_t PLANE = (size_t)T * 128;
DI bf16* proj_plane(unsigned char* ws, int cb) { return (bf16*)(ws + WS_PROJ) + (size_t)cb * PLANE; }

DI void attn_task(unsigned char* ws, bf16* OG, float* LSE, LAS unsigned char* lds, int task, int tid0) {
    int tid = tid0; const int w = __builtin_amdgcn_readfirstlane(tid0 >> 6); int lane = tid & 63, i = lane & 15, g4 = lane >> 4;
    const int grp = task >> 8, idx = task & 255, b = idx >> 7, h = (idx >> 5) & 3, q5 = idx & 31;
    const int dsh = 2 * grp, d = 1 << dsh, rsh = 5 - dsh, r = q5 >> rsh, n0 = 4 * (q5 & ((1 << rsh) - 1)), Lsub = SEQ >> dsh;
    const unsigned char* Qp = (const unsigned char*)ws + WS_PROJ + (size_t)(12 * grp + h) * PLANE * 2 + ((size_t)b * SEQ + (size_t)r * Lsub) * 128;
#define ATT_Q8(dst, ptr) do { const u32x2 _q = *(const u32x2*)(ptr); const f32x2 _a = __builtin_amdgcn_cvt_pk_f32_fp8((int)_q.x, false), _b = __builtin_amdgcn_cvt_pk_f32_fp8((int)_q.x, true), _c = __builtin_amdgcn_cvt_pk_f32_fp8((int)_q.y, false), _d = __builtin_amdgcn_cvt_pk_f32_fp8((int)_q.y, true); \
        u32x4 _w; _w.x = pk2(_a.x, _a.y); _w.y = pk2(_b.x, _b.y); _w.z = pk2(_c.x, _c.y); _w.w = pk2(_d.x, _d.y); dst = __builtin_bit_cast(bf16x8, _w); } while (0)
    const unsigned char* Kp = (const unsigned char*)ws + WS_PROJ + (size_t)(12 * grp + 4 + h) * PLANE * 2 + ((size_t)b * SEQ + (size_t)r * Lsub) * 128;
    const unsigned char* Vp = (const unsigned char*)ws + WS_PROJ + (size_t)(12 * grp + 8 + h) * PLANE * 2 + ((size_t)b * SEQ + (size_t)r * Lsub) * 128;
    LAS unsigned char* KL = lds; LAS unsigned char* VL = lds + 65536;
    u32x4 pk[2], pv[2]; bf16x8 qf[4], nq[4];
#define ATT_PUT8(img, v8, id_) do { const int _row = (id_) >> 3, _c = (id_) & 7; const unsigned _w[4] = {(v8).x, (v8).y, (v8).z, (v8).w}; unsigned _o[8]; \
        _Pragma("unroll") for (int _q = 0; _q < 4; ++_q) { const f32x2 _lo = __builtin_amdgcn_cvt_pk_f32_fp8((int)_w[_q], false), _hi = __builtin_amdgcn_cvt_pk_f32_fp8((int)_w[_q], true); _o[2 * _q] = pk2(_lo.x, _lo.y); _o[2 * _q + 1] = pk2(_hi.x, _hi.y); } \
        *(LAS u32x4*)((img) + offb(_row, 2 * _c)) = (u32x4){_o[0], _o[1], _o[2], _o[3]}; *(LAS u32x4*)((img) + offb(_row, 2 * _c + 1)) = (u32x4){_o[4], _o[5], _o[6], _o[7]}; } while (0)
#pragma unroll
    for (int ii = 0; ii < 2; ++ii) { const int id = tid + 512 * ii; const int s0 = (n0 - 1) & 1, s1 = n0 & 1;
        u32x4 k0 = {0u, 0u, 0u, 0u}, v0 = {0u, 0u, 0u, 0u};
        if (n0 > 0) { k0 = *(const u32x4*)(Kp + (size_t)(n0 - 1) * 16384 + id * 16); v0 = *(const u32x4*)(Vp + (size_t)(n0 - 1) * 16384 + id * 16); }
        const u32x4 k1 = *(const u32x4*)(Kp + (size_t)n0 * 16384 + id * 16), v1 = *(const u32x4*)(Vp + (size_t)n0 * 16384 + id * 16);
        ATT_PUT8(KL + s0 * 32768, k0, id); ATT_PUT8(VL + s0 * 32768, v0, id); ATT_PUT8(KL + s1 * 32768, k1, id); ATT_PUT8(VL + s1 * 32768, v1, id); }
#pragma unroll
    for (int ks = 0; ks < 4; ++ks) ATT_Q8(qf[ks], Qp + (size_t)(n0 * 128 + 16 * w + i) * 128 + 32 * ks + 8 * g4);
    __syncthreads();
    const int kt0 = (w == 0) ? 0 : w - 1;
#pragma unroll 1
    for (int u = 0; u < 4; ++u) { const int n = n0 + u;
        asm volatile("" : "+v"(tid)); lane = tid & 63; i = lane & 15; g4 = lane >> 4;
        if (u < 3) {
#pragma unroll
            for (int ii = 0; ii < 2; ++ii) { const int id = tid + 512 * ii; pk[ii] = *(const u32x4*)(Kp + (size_t)(n + 1) * 16384 + id * 16); pv[ii] = *(const u32x4*)(Vp + (size_t)(n + 1) * 16384 + id * 16); }
        }
        f32x4 st[10];
#pragma unroll
        for (int tt = 0; tt < 10; ++tt) st[tt] = (f32x4){0.f, 0.f, 0.f, 0.f};
#pragma unroll
        for (int ks = 0; ks < 4; ++ks)
#pragma unroll
            for (int hb = 0; hb < 2; ++hb) { bf16x8 kf[5];
#pragma unroll
                for (int t5 = 0; t5 < 5; ++t5) { const int kt = kt0 + 5 * hb + t5; kf[t5] = *(const LAS bf16x8*)(KL + ((n - 1 + (kt >> 3)) & 1) * 32768 + offb(16 * (kt & 7) + i, 4 * ks + g4)); }
                __builtin_amdgcn_sched_barrier(0);
#pragma unroll
                for (int t5 = 0; t5 < 5; ++t5) st[5 * hb + t5] = MFMA16(kf[t5], qf[ks], st[5 * hb + t5]);
                __builtin_amdgcn_sched_barrier(0); }
        const int iq = 16 * w + i; float mx = -3.0e38f;
#pragma unroll
        for (int tt = 0; tt < 10; ++tt)
#pragma unroll
            for (int rg = 0; rg < 4; ++rg) { const int j = 16 * (kt0 + tt) + 4 * g4 + rg, dist = iq + 128 - j; const bool ok = ((unsigned)dist <= 128u) && (n > 0 || j >= 128);
                st[tt][rg] = ok ? st[tt][rg] : -__builtin_inff(); mx = fmaxf(mx, st[tt][rg]); }
        mx = fmaxf(mx, __shfl_xor(mx, 16)); mx = fmaxf(mx, __shfl_xor(mx, 32));
        float sum = 0.f;
#pragma unroll
        for (int tt = 0; tt < 10; ++tt)
#pragma unroll
            for (int rg = 0; rg < 4; ++rg) { const float p = __builtin_amdgcn_exp2f(st[tt][rg] - mx); st[tt][rg] = p; sum += p; }
        sum += __shfl_xor(sum, 16); sum += __shfl_xor(sum, 32);
        f32x4 o[8];
#pragma unroll
        for (int c = 0; c < 8; ++c) o[c] = (f32x4){0.f, 0.f, 0.f, 0.f};
#pragma unroll
        for (int kk = 0; kk < 5; ++kk) { u32x4 pw; pw.x = pk2(st[2 * kk][0], st[2 * kk][1]); pw.y = pk2(st[2 * kk][2], st[2 * kk][3]); pw.z = pk2(st[2 * kk + 1][0], st[2 * kk + 1][1]); pw.w = pk2(st[2 * kk + 1][2], st[2 * kk + 1][3]);
            const bf16x8 pa = __builtin_bit_cast(bf16x8, pw); const int ka = kt0 + 2 * kk, kb2 = ka + 1;
            const LAS unsigned char* va = VL + ((n - 1 + (ka >> 3)) & 1) * 32768; const LAS unsigned char* vb = VL + ((n - 1 + (kb2 >> 3)) & 1) * 32768;
            bf16x8 vf[8];
#pragma unroll
            for (int c = 0; c < 8; ++c) vf[c] = cat8(tr4(va, 16 * (ka & 7) + 4 * g4, c, lane), tr4(vb, 16 * (kb2 & 7) + 4 * g4, c, lane));
            __builtin_amdgcn_sched_barrier(0);
#pragma unroll
            for (int c = 0; c < 8; ++c) o[c] = MFMA16(pa, vf[c], o[c]);
            __builtin_amdgcn_sched_barrier(0); }
        if (u < 3) {
#pragma unroll
            for (int ks = 0; ks < 4; ++ks) ATT_Q8(nq[ks], Qp + (size_t)((n + 1) * 128 + 16 * w + i) * 128 + 32 * ks + 8 * g4); }
        const float linv = 1.0f / sum;
        const size_t mrow0 = (size_t)b * SEQ;
        if (lane < 16) { const size_t m = mrow0 + (size_t)((n * 128 + iq) * d + r); LSE[((size_t)grp * T + m) * 4 + h] = (mx + __log2f(sum)) * 0.6931471805599453f; }
        __syncthreads();
        { LAS unsigned char* ost = KL + ((n - 1) & 1) * 32768 + w * 4096;
#pragma unroll
          for (int rg = 0; rg < 4; ++rg) { const float li = __shfl(linv, 4 * g4 + rg);
#pragma unroll
              for (int c = 0; c < 8; ++c) *(LAS bf16*)(ost + (4 * g4 + rg) * 256 + (16 * c + i) * 2) = f2bf(o[c][rg] * li); }
          LDS_WAIT(); asm volatile("" ::: "memory");
#pragma unroll
          for (int k = 0; k < 2; ++k) { const int pid = lane + 64 * k, qr = pid >> 3, ch = pid & 7;
              const u32x4 va = *(const LAS u32x4*)(ost + qr * 256 + ch * 32), vb = *(const LAS u32x4*)(ost + qr * 256 + ch * 32 + 16);
              int w0 = 0, w1 = 0, w2 = 0, w3 = 0;
              w0 = __builtin_amdgcn_cvt_pk_fp8_f32(bflo(va.x), bfhi(va.x), w0, false); w0 = __builtin_amdgcn_cvt_pk_fp8_f32(bflo(va.y), bfhi(va.y), w0, true);
              w1 = __builtin_amdgcn_cvt_pk_fp8_f32(bflo(va.z), bfhi(va.z), w1, false); w1 = __builtin_amdgcn_cvt_pk_fp8_f32(bflo(va.w), bfhi(va.w), w1, true);
              w2 = __builtin_amdgcn_cvt_pk_fp8_f32(bflo(vb.x), bfhi(vb.x), w2, false); w2 = __builtin_amdgcn_cvt_pk_fp8_f32(bflo(vb.y), bfhi(vb.y), w2, true);
              w3 = __builtin_amdgcn_cvt_pk_fp8_f32(bflo(vb.z), bfhi(vb.z), w3, false); w3 = __builtin_amdgcn_cvt_pk_fp8_f32(bflo(vb.w), bfhi(vb.w), w3, true);
              u32x4 v; v.x = (unsigned)w0; v.y = (unsigned)w1; v.z = (unsigned)w2; v.w = (unsigned)w3;
              const size_t m = mrow0 + (size_t)((n * 128 + 16 * w + qr) * d + r); *(u32x4*)((unsigned char*)OG + ((size_t)grp * T + m) * 512 + h * 128 + 16 * ch) = v; } }
        if (u < 3) { __syncthreads(); const int s1 = (n + 1) & 1;
#pragma unroll
            for (int ii = 0; ii < 2; ++ii) { const int id = tid + 512 * ii; ATT_PUT8(KL + s1 * 32768, pk[ii], id); ATT_PUT8(VL + s1 * 32768, pv[ii], id); }
#pragma unroll
            for (int ks = 0; ks < 4; ++ks) qf[ks] = nq[ks];
            __syncthreads(); }
    }
    __syncthreads();
#undef ATT_PUT8
}

constexpr int GL_RK = 0, GL_RG = 16384, GL_RQ = 32768, GL_OST = 0, GL_QE = 49152, GL_KM = 65536, GL_KE = 81920, GL_V = 98304;
constexpr int GL_TOT = 131072 + 2048, GL_DEC = 131072 + 6144, GL_ATT = 131072 + 6656;
template <bool FULL> struct GlaPre { u32x4 k[2], g[2], q[FULL ? 2 : 1], v[4]; };
template <bool FULL> DI void gla_fetch_kgq(GlaPre<FULL>& R, const bf16* Kp, const bf16* Gp, const bf16* Qp, size_t mbase, int tid) {
#pragma unroll
    for (int ii = 0; ii < 2; ++ii) { const size_t o = mbase * 128 + (size_t)(tid + 512 * ii) * 8; R.k[ii] = *(const u32x4*)(Kp + o); R.g[ii] = *(const u32x4*)(Gp + o); if (FULL) R.q[ii] = *(const u32x4*)(Qp + o); }
}
template <bool FULL> DI void gla_fetch_v(GlaPre<FULL>& R, const bf16* Vp, size_t mbase, int tid) {
#pragma unroll
    for (int ii = 0; ii < 4; ++ii) R.v[ii] = *(const u32x4*)(Vp + mbase * 256 + (size_t)(tid + 512 * ii) * 8);
}
template <bool FULL> DI void gla_fetch(GlaPre<FULL>& R, const bf16* Kp, const bf16* Gp, const bf16* Qp, const bf16* Vp, size_t mbase, int tid) { gla_fetch_kgq<FULL>(R, Kp, Gp, Qp, mbase, tid); gla_fetch_v<FULL>(R, Vp, mbase, tid); }
template <bool FULL> DI void gla_put(const GlaPre<FULL>& R, LAS unsigned char* lds, int tid) {
#pragma unroll
    for (int ii = 0; ii < 2; ++ii) { const int o = (tid + 512 * ii) * 16; *(LAS u32x4*)(lds + GL_RK + o) = R.k[ii]; *(LAS u32x4*)(lds + GL_RG + o) = R.g[ii]; if (FULL) *(LAS u32x4*)(lds + GL_RQ + o) = R.q[ii]; }
#pragma unroll
    for (int ii = 0; ii < 4; ++ii) { const int id = tid + 512 * ii, row = id >> 5, c32 = id & 31; *(LAS u32x4*)(lds + GL_V + (c32 >> 4) * 16384 + offb(row, c32 & 15)) = R.v[ii]; }
}
template <bool FULL> DI f32x2 gla_prep(LAS unsigned char* lds, int tid) {
    const int jp = tid & 63, tg = tid >> 6;
    f32x2 c[8], kv[8], qv[8]; f32x2 run = {0.f, 0.f};
#pragma unroll
    for (int ii = 0; ii < 8; ++ii) { const int o = (8 * tg + ii) * 256 + jp * 4; const unsigned gw = *(const LAS unsigned*)(lds + GL_RG + o), kw = *(const LAS unsigned*)(lds + GL_RK + o);
        run.x += bflo(gw); run.y += bfhi(gw); c[ii] = run; kv[ii] = (f32x2){bflo(kw), bfhi(kw)};
        if (FULL) { const unsigned qw = *(const LAS unsigned*)(lds + GL_RQ + o); qv[ii] = (f32x2){bflo(qw), bfhi(qw)}; } }
    LAS f32x2* TOT = (LAS f32x2*)(lds + GL_TOT);
    TOT[tg * 64 + jp] = run;
    __syncthreads();
    f32x2 off = {0.f, 0.f}, blast = {0.f, 0.f};
#pragma unroll
    for (int t2 = 0; t2 < 8; ++t2) { const f32x2 v = TOT[t2 * 64 + jp]; blast = blast + v; if (t2 < tg) off = off + v; }
    const f32x2 eb = {__expf(blast.x), __expf(blast.y)};
#pragma unroll
    for (int ii = 0; ii < 8; ++ii) { const int s = 8 * tg + ii; const f32x2 bb = off + c[ii]; const f32x2 e = {__expf(bb.x), __expf(bb.y)}; const f32x2 km = {kv[ii].x * __builtin_amdgcn_rcpf(e.x), kv[ii].y * __builtin_amdgcn_rcpf(e.y)};
        const unsigned o = offb(s, jp >> 2) + (jp & 3) * 4; const f32x2 ke = km * eb;
        *(LAS unsigned*)(lds + GL_KE + o) = pk2(ke.x, ke.y);
        if (FULL) { const f32x2 qe = qv[ii] * e; *(LAS unsigned*)(lds + GL_QE + o) = pk2(qe.x, qe.y); *(LAS unsigned*)(lds + GL_KM + o) = pk2(km.x, km.y); } }
    if (tg == 0) ((LAS f32x2*)(lds + GL_DEC))[jp] = eb;
    __syncthreads();
    return blast;
}
DI void gla_state_update(f32x4 (&S)[8][2], const LAS unsigned char* lds, int w, int lane) {
    const int g4 = lane >> 4; const LAS unsigned char* Vimg = lds + GL_V + (w >> 2) * 16384; const int cv = 2 * (w & 3);
#pragma unroll
    for (int mt = 0; mt < 8; ++mt) { const f32x4 dc = *(const LAS f32x4*)(lds + GL_DEC + (16 * mt + 4 * g4) * 4); S[mt][0] = S[mt][0] * dc; S[mt][1] = S[mt][1] * dc; }
#pragma unroll
    for (int ks = 0; ks < 2; ++ks) { bf16x8 bfr[2];
#pragma unroll
        for (int nt = 0; nt < 2; ++nt) bfr[nt] = cat8(tr4(Vimg, 32 * ks + 8 * g4, cv + nt, lane), tr4(Vimg, 32 * ks + 8 * g4 + 4, cv + nt, lane));
#pragma unroll
        for (int mt = 0; mt < 8; ++mt) { const bf16x8 a = cat8(tr4(lds + GL_KE, 32 * ks + 8 * g4, mt, lane), tr4(lds + GL_KE, 32 * ks + 8 * g4 + 4, mt, lane));
            S[mt][0] = MFMA16(a, bfr[0], S[mt][0]); S[mt][1] = MFMA16(a, bfr[1], S[mt][1]); } }
}
DI void gla_pass1(const Ptrs& P, LAS unsigned char* lds, int unit, int tid0) {
    const int lane0 = tid0 & 63, w = __builtin_amdgcn_readfirstlane(tid0 >> 6); const int bh = unit >> 5, sc = unit & 31, b = bh >> 2, h = bh & 3;
    const bf16* Kp = proj_plane(P.ws, 40 + h); const bf16* Gp = proj_plane(P.ws, 60 + h); const bf16* Vp = proj_plane(P.ws, 44) + (size_t)h * T * 256;
    f32x4 S[8][2];
#pragma unroll
    for (int mt = 0; mt < 8; ++mt) { S[mt][0] = (f32x4){0.f, 0.f, 0.f, 0.f}; S[mt][1] = (f32x4){0.f, 0.f, 0.f, 0.f}; }
    f32x2 logd = {0.f, 0.f}; const size_t m0 = (size_t)b * SEQ + (size_t)(8 * sc) * 64;
    GlaPre<false> R; gla_fetch<false>(R, Kp, Gp, nullptr, Vp, m0, tid0); gla_put<false>(R, lds, tid0);
    __syncthreads();
#pragma unroll 1
    for (int ci = 0; ci < 8; ++ci) {
        int tid = tid0; asm volatile("" : "+v"(tid));
        if (ci < 7) gla_fetch<false>(R, Kp, Gp, nullptr, Vp, m0 + (size_t)(ci + 1) * 64, tid);
        logd = logd + gla_prep<false>(lds, tid);
        const int lane = tid & 63;
        gla_state_update(S, lds, w, lane);
        __syncthreads();
        if (ci < 7) { gla_put<false>(R, lds, tid); __syncthreads(); } }
    float* GS = (float*)(P.ws + WS_GSTATE) + (size_t)unit * 32768;
#pragma unroll
    for (int mt = 0; mt < 8; ++mt)
#pragma unroll
        for (int nt = 0; nt < 2; ++nt)
#pragma unroll
            for (int rg = 0; rg < 4; ++rg) GS[((w * 16 + mt * 2 + nt) * 4 + rg) * 64 + lane0] = S[mt][nt][rg];
    if (tid0 < 64) ((f32x2*)(P.ws + WS_GDEC))[unit * 64 + tid0] = (f32x2){__expf(logd.x), __expf(logd.y)};
}
DI void gla_scan(const Ptrs& P, int vcu, int G, int tid) {
    float* GS = (float*)(P.ws + WS_GSTATE); const float* GD = (const float*)(P.ws + WS_GDEC);
    for (int cid = vcu * 512 + tid; cid < 8 * 32768; cid += G * 512) { const int bh = cid >> 15, e = cid & 32767, ln = e & 63, rg = (e >> 6) & 3, mt = ((e >> 8) & 15) >> 1, dk = 16 * mt + 4 * (ln >> 4) + rg;
        float ev[32], dv[32];
#pragma unroll
        for (int sc = 0; sc < 32; ++sc) { ev[sc] = GS[((size_t)(bh * 32 + sc) << 15) + e]; dv[sc] = GD[(bh * 32 + sc) * 128 + dk]; }
        float carry = 0.f;
#pragma unroll
        for (int sc = 0; sc < 32; ++sc) { GS[((size_t)(bh * 32 + sc) << 15) + e] = carry; carry = dv[sc] * carry + ev[sc]; } }
}
DI void gla_pass2(const Ptrs& P, LAS unsigned char* lds, int unit, int tid0) {
    const int lane0 = tid0 & 63, w = __builtin_amdgcn_readfirstlane(tid0 >> 6); const int bh = unit >> 5, sc = unit & 31, b = bh >> 2, h = bh & 3;
    const bf16* Qp = proj_plane(P.ws, 36 + h); const bf16* Kp = proj_plane(P.ws, 40 + h); const bf16* Gp = proj_plane(P.ws, 60 + h);
    const bf16* Vp = proj_plane(P.ws, 44) + (size_t)h * T * 256; const bf16* Op = proj_plane(P.ws, 52) + (size_t)h * T * 256; bf16* OB = (bf16*)(P.ws + WS_OB);
    f32x4 S[8][2];
    { const float* GS = (const float*)(P.ws + WS_GSTATE) + (size_t)unit * 32768;
#pragma unroll
      for (int mt = 0; mt < 8; ++mt)
#pragma unroll
          for (int nt = 0; nt < 2; ++nt)
#pragma unroll
              for (int rg = 0; rg < 4; ++rg) S[mt][nt][rg] = GS[((w * 16 + mt * 2 + nt) * 4 + rg) * 64 + lane0]; }
    const size_t m0 = (size_t)b * SEQ + (size_t)(8 * sc) * 64;
    GlaPre<true> R; gla_fetch<true>(R, Kp, Gp, Qp, Vp, m0, tid0); gla_put<true>(R, lds, tid0);
    __syncthreads();
#pragma unroll 1
    for (int ci = 0; ci < 8; ++ci) { const size_t mbase = m0 + (size_t)ci * 64;
        int tid = tid0; asm volatile("" : "+v"(tid));
        const int erow = tid >> 3, ep = tid & 7;
        if (ci < 7) gla_fetch_kgq<true>(R, Kp, Gp, Qp, mbase + 64, tid);
        (void)gla_prep<true>(lds, tid);
        if (ci < 7) gla_fetch_v<true>(R, Vp, mbase + 64, tid);
        u32x4 gog[4];
#pragma unroll
        for (int k = 0; k < 4; ++k) gog[k] = *(const u32x4*)(Op + (mbase + erow) * 256 + 8 * (ep + 8 * k));
        const int lane = tid & 63, i = lane & 15, g4 = lane >> 4;
        const LAS unsigned char* Vimg = lds + GL_V + (w >> 2) * 16384; const int cv = 2 * (w & 3);
        { const int mi = w >> 1;
#pragma unroll
          for (int nn = 0; nn < 2; ++nn) { const int nj = 2 * (w & 1) + nn; f32x4 a = {0.f, 0.f, 0.f, 0.f};
#pragma unroll
              for (int ks = 0; ks < 4; ++ks) { const bf16x8 af = *(const LAS bf16x8*)(lds + GL_QE + offb(16 * mi + i, 4 * ks + g4)), bfr = *(const LAS bf16x8*)(lds + GL_KM + offb(16 * nj + i, 4 * ks + g4)); a = MFMA16(af, bfr, a); }
#pragma unroll
              for (int rg = 0; rg < 4; ++rg) { const int sq = 16 * mi + 4 * g4 + rg, sk = 16 * nj + i; *(LAS bf16*)(lds + GL_ATT + sq * 144 + sk * 2) = f2bf(sk <= sq ? a[rg] : 0.f); } } }
        __syncthreads();
        f32x4 o[4][2];
#pragma unroll
        for (int mt = 0; mt < 4; ++mt) { o[mt][0] = (f32x4){0.f, 0.f, 0.f, 0.f}; o[mt][1] = (f32x4){0.f, 0.f, 0.f, 0.f}; }
#pragma unroll
        for (int ks = 0; ks < 2; ++ks) { bf16x8 bfr[2];
#pragma unroll
            for (int nt = 0; nt < 2; ++nt) bfr[nt] = cat8(tr4(Vimg, 32 * ks + 8 * g4, cv + nt, lane), tr4(Vimg, 32 * ks + 8 * g4 + 4, cv + nt, lane));
#pragma unroll
            for (int mt = 0; mt < 4; ++mt) { const bf16x8 a = *(const LAS bf16x8*)(lds + GL_ATT + (16 * mt + i) * 144 + 64 * ks + 16 * g4); o[mt][0] = MFMA16(a, bfr[0], o[mt][0]); o[mt][1] = MFMA16(a, bfr[1], o[mt][1]); } }
#pragma unroll
        for (int ks = 0; ks < 4; ++ks) { bf16x8 sb[2];
#pragma unroll
            for (int nt = 0; nt < 2; ++nt) { u32x4 pw; pw.x = pk2(S[2 * ks][nt][0], S[2 * ks][nt][1]); pw.y = pk2(S[2 * ks][nt][2], S[2 * ks][nt][3]); pw.z = pk2(S[2 * ks + 1][nt][0], S[2 * ks + 1][nt][1]); pw.w = pk2(S[2 * ks + 1][nt][2], S[2 * ks + 1][nt][3]); sb[nt] = __builtin_bit_cast(bf16x8, pw); }
#pragma unroll
            for (int mt = 0; mt < 4; ++mt) { const u32x2 lo = *(const LAS u32x2*)(lds + GL_QE + offb(16 * mt + i, 4 * ks + (g4 >> 1)) + (g4 & 1) * 8), hi = *(const LAS u32x2*)(lds + GL_QE + offb(16 * mt + i, 4 * ks + 2 + (g4 >> 1)) + (g4 & 1) * 8);
                u32x4 aw; aw.x = lo.x; aw.y = lo.y; aw.z = hi.x; aw.w = hi.y; const bf16x8 a = __builtin_bit_cast(bf16x8, aw);
                o[mt][0] = MFMA16(a, sb[0], o[mt][0]); o[mt][1] = MFMA16(a, sb[1], o[mt][1]); } }
#pragma unroll
        for (int mt = 0; mt < 4; ++mt)
#pragma unroll
            for (int rg = 0; rg < 4; ++rg) { const int sq = 16 * mt + 4 * g4 + rg; LAS bf16* op = (LAS bf16*)(lds + GL_OST + sq * 512 + (32 * w + i) * 2); op[0] = f2bf(o[mt][0][rg]); op[16] = f2bf(o[mt][1][rg]); }
        gla_state_update(S, lds, w, lane);
        __syncthreads();
        { u32x4 ov[4]; float ss = 0.f;
#pragma unroll
          for (int k = 0; k < 4; ++k) { ov[k] = *(const LAS u32x4*)(lds + GL_OST + erow * 512 + 16 * (ep + 8 * k));
              const float a0 = bflo(ov[k].x), a1 = bfhi(ov[k].x), a2 = bflo(ov[k].y), a3 = bfhi(ov[k].y), a4 = bflo(ov[k].z), a5 = bfhi(ov[k].z), a6 = bflo(ov[k].w), a7 = bfhi(ov[k].w);
              ss += (a0 * a0 + a1 * a1) + (a2 * a2 + a3 * a3) + (a4 * a4 + a5 * a5) + (a6 * a6 + a7 * a7); }
          ss += __shfl_xor(ss, 1); ss += __shfl_xor(ss, 2); ss += __shfl_xor(ss, 4);
          const float rstd = 1.0f / sqrtf(ss * (1.0f / 256.0f) + RMS_EPS);
#pragma unroll
          for (int k = 0; k < 4; ++k) { const int col = 8 * (ep + 8 * k); const f32x4 n0v = *(const f32x4*)(P.gnorm + col), n1v = *(const f32x4*)(P.gnorm + col + 4);
              const unsigned ow[4] = {ov[k].x, ov[k].y, ov[k].z, ov[k].w}, gw[4] = {gog[k].x, gog[k].y, gog[k].z, gog[k].w}; const float nw[8] = {n0v.x, n0v.y, n0v.z, n0v.w, n1v.x, n1v.y, n1v.z, n1v.w}; unsigned rw[4];
#pragma unroll
              for (int q = 0; q < 4; ++q) { const float ga = bflo(gw[q]), gb = bfhi(gw[q]); rw[q] = pk2(bflo(ow[q]) * rstd * nw[2 * q] * ga * sigmoidf_fast(ga), bfhi(ow[q]) * rstd * nw[2 * q + 1] * gb * sigmoidf_fast(gb)); }
              u32x4 res; res.x = rw[0]; res.y = rw[1]; res.z = rw[2]; res.w = rw[3];
              *(u32x4*)(OB + (mbase + erow) * D + h * 256 + col) = res; } }
        __syncthreads();
        if (ci < 7) { gla_put<true>(R, lds, tid); __syncthreads(); } }
}

DI void attn_merge(const Ptrs& P, int vcu, int G, int tid) {
    const int lane = tid & 63, wave = tid >> 6, gw = vcu * 8 + wave, NGW = G * 8, h = lane >> 4;
    const unsigned char* OG8 = (const unsigned char*)P.out + OUT_OG; const float* LSE = (const float*)((const unsigned char*)P.out + OUT_LSE); bf16* OA = (bf16*)(P.ws + WS_OA);
    for (int m0 = gw * 4; m0 < T; m0 += NGW * 4) {
        float l[4][3]; u32x2 v[4][3];
#pragma unroll
        for (int q = 0; q < 4; ++q)
#pragma unroll
            for (int g = 0; g < 3; ++g) { l[q][g] = LSE[((size_t)g * T + m0 + q) * 4 + h]; v[q][g] = *(const u32x2*)(OG8 + ((size_t)g * T + m0 + q) * 512 + 8 * lane); }
#pragma unroll
        for (int q = 0; q < 4; ++q) { const float mx = fmaxf(l[q][0], fmaxf(l[q][1], l[q][2])); float w0 = __expf(l[q][0] - mx), w1 = __expf(l[q][1] - mx), w2 = __expf(l[q][2] - mx); const float inv = 1.0f / (w0 + w1 + w2); w0 *= inv; w1 *= inv; w2 *= inv;
            const u32x2 a = v[q][0], bq = v[q][1], c = v[q][2];
            const f32x2 a0 = __builtin_amdgcn_cvt_pk_f32_fp8((int)a.x, false), a1 = __builtin_amdgcn_cvt_pk_f32_fp8((int)a.x, true), a2 = __builtin_amdgcn_cvt_pk_f32_fp8((int)a.y, false), a3 = __builtin_amdgcn_cvt_pk_f32_fp8((int)a.y, true);
            const f32x2 b0 = __builtin_amdgcn_cvt_pk_f32_fp8((int)bq.x, false), b1 = __builtin_amdgcn_cvt_pk_f32_fp8((int)bq.x, true), b2 = __builtin_amdgcn_cvt_pk_f32_fp8((int)bq.y, false), b3 = __builtin_amdgcn_cvt_pk_f32_fp8((int)bq.y, true);
            const f32x2 c0 = __builtin_amdgcn_cvt_pk_f32_fp8((int)c.x, false), c1 = __builtin_amdgcn_cvt_pk_f32_fp8((int)c.x, true), c2 = __builtin_amdgcn_cvt_pk_f32_fp8((int)c.y, false), c3 = __builtin_amdgcn_cvt_pk_f32_fp8((int)c.y, true);
            u32x4 o;
            o.x = pk2(w0 * a0.x + w1 * b0.x + w2 * c0.x, w0 * a0.y + w1 * b0.y + w2 * c0.y);
            o.y = pk2(w0 * a1.x + w1 * b1.x + w2 * c1.x, w0 * a1.y + w1 * b1.y + w2 * c1.y);
            o.z = pk2(w0 * a2.x + w1 * b2.x + w2 * c2.x, w0 * a2.y + w1 * b2.y + w2 * c2.y);
            o.w = pk2(w0 * a3.x + w1 * b3.x + w2 * c3.x, w0 * a3.y + w1 * b3.y + w2 * c3.y);
            *(u32x4*)(OA + (size_t)(m0 + q) * 512 + 8 * lane) = o; } }
}

DI void router_phase(const Ptrs& P, LAS unsigned char* lds, int G, int tid0) {
    int tid = tid0;
    const bf16* H1 = (const bf16*)(P.ws + WS_H1); unsigned char* HN8 = P.ws + WS_HN; const bf16* WRT = (const bf16*)(P.ws + WS_WRT);
    { int* RT = (int*)(P.ws + WS_ROWTOK); for (int idx = blockIdx.x * 512 + tid; idx < MAXTILES * 256; idx += G * 512) RT[idx] = 0; }
    int* ASG_E = (int*)(P.ws + WS_ASG_E); int* ASG_SLOT = (int*)(P.ws + WS_ASG_SLOT); float* ASG_G = (float*)(P.ws + WS_ASG_G);
    LAS float* LG = (LAS float*)lds; LAS int* lcnt = (LAS int*)(lds + 17408); LAS int* lbase = (LAS int*)(lds + 17536);
    unsigned* gcnt = (unsigned*)(P.ctl + CW_CNT);
    for (int tb = blockIdx.x; tb < T / 128; tb += G) {
        asm volatile("" : "+v"(tid));
        const int lane = tid & 63, w = tid >> 6, i = lane & 15, g4 = lane >> 4;
        if (tid < 32) lcnt[tid] = 0;
        __syncthreads();
        const int t = tb * 128 + 16 * w + i; const bf16* hrow = H1 + (size_t)t * D + 8 * g4;
        float ss = 0.f; { const float* ps = (const float*)(P.ws + WS_PS) + t;
#pragma unroll
            for (int j = 0; j < 16; ++j) ss += ps[(size_t)j * T]; }
        const float rstd = 1.0f / sqrtf(ss * (1.0f / D) + RMS_EPS);
        f32x4 a0 = {0.f, 0.f, 0.f, 0.f}, a1 = {0.f, 0.f, 0.f, 0.f};
#pragma unroll 1
        for (int cb = 0; cb < 32; cb += 8) {
            u32x4 hv[8]; f32x4 w0[8], w1[8]; bf16x8 b0[8], b1[8];
#pragma unroll
            for (int j = 0; j < 8; ++j) { const int c = cb + j; hv[j] = *(const u32x4*)(hrow + 32 * c); w0[j] = *(const f32x4*)(P.ln2 + 32 * c + 8 * g4); w1[j] = *(const f32x4*)(P.ln2 + 32 * c + 8 * g4 + 4);
                b0[j] = *(const bf16x8*)(WRT + (size_t)i * D + 32 * c + 8 * g4); b1[j] = *(const bf16x8*)(WRT + (size_t)(16 + i) * D + 32 * c + 8 * g4); }
#pragma unroll
            for (int j = 0; j < 8; ++j) { const int c = cb + j; const f32x4 u0 = w0[j] * rstd, u1 = w1[j] * rstd;
                const float y0 = bflo(hv[j].x) * u0.x, y1 = bfhi(hv[j].x) * u0.y, y2 = bflo(hv[j].y) * u0.z, y3 = bfhi(hv[j].y) * u0.w, y4 = bflo(hv[j].z) * u1.x, y5 = bfhi(hv[j].z) * u1.y, y6 = bflo(hv[j].w) * u1.z, y7 = bfhi(hv[j].w) * u1.w;
                int q0 = 0, q1 = 0; q0 = __builtin_amdgcn_cvt_pk_fp8_f32(y0, y1, q0, false); q0 = __builtin_amdgcn_cvt_pk_fp8_f32(y2, y3, q0, true); q1 = __builtin_amdgcn_cvt_pk_fp8_f32(y4, y5, q1, false); q1 = __builtin_amdgcn_cvt_pk_fp8_f32(y6, y7, q1, true);
                u32x2 q; q.x = (unsigned)q0; q.y = (unsigned)q1; *(u32x2*)(HN8 + (size_t)t * D + 32 * c + 8 * g4) = q;
                u32x4 y; y.x = pk2(y0, y1); y.y = pk2(y2, y3); y.z = pk2(y4, y5); y.w = pk2(y6, y7);
                const bf16x8 af = __builtin_bit_cast(bf16x8, y); a0 = MFMA16(af, b0[j], a0); a1 = MFMA16(af, b1[j], a1); } }
        const float br0 = P.br[i], br1 = P.br[16 + i];
#pragma unroll
        for (int rg = 0; rg < 4; ++rg) { LG[(w * 16 + 4 * g4 + rg) * 33 + i] = a0[rg] + br0; LG[(w * 16 + 4 * g4 + rg) * 33 + 16 + i] = a1[rg] + br1; }
        LDS_WAIT(); asm volatile("" ::: "memory");
        int es[4] = {0, 0, 0, 0}, ls[4] = {0, 0, 0, 0}; float gs[4] = {0.f, 0.f, 0.f, 0.f};
        if (lane < 16) { float lg[32];
#pragma unroll
            for (int e = 0; e < 32; ++e) lg[e] = LG[(w * 16 + lane) * 33 + e];
            unsigned taken = 0u; float tv[4];
#pragma unroll
            for (int k = 0; k < 4; ++k) { float best = -3.0e38f; int bi = 0;
#pragma unroll
                for (int e = 0; e < 32; ++e) { const bool ok = !((taken >> e) & 1u) && lg[e] > best; best = ok ? lg[e] : best; bi = ok ? e : bi; }
                taken |= 1u << bi; es[k] = bi; tv[k] = best; }
            const float e1 = __expf(tv[1] - tv[0]), e2 = __expf(tv[2] - tv[0]), e3 = __expf(tv[3] - tv[0]), inv = 1.0f / (1.0f + e1 + e2 + e3);
            gs[0] = inv; gs[1] = e1 * inv; gs[2] = e2 * inv; gs[3] = e3 * inv;
#pragma unroll
            for (int k = 0; k < 4; ++k) ls[k] = __hip_atomic_fetch_add(lcnt + es[k], 1, __ATOMIC_RELAXED, __HIP_MEMORY_SCOPE_WORKGROUP); }
        if (lane < 16) { const int tt = tb * 128 + 16 * w + lane;
#pragma unroll
            for (int k = 0; k < 4; ++k) { ASG_E[4 * tt + k] = es[k]; ASG_SLOT[4 * tt + k] = ls[k]; ASG_G[4 * tt + k] = gs[k]; } }
        __syncthreads();
        if (tid < 32) gcnt[tb * 32 + tid] = (unsigned)lcnt[tid];
        __syncthreads();
    }
}
DI void moe_colsum(const unsigned* cnt, int nrows, LAS int* red, int tid, int& out) {
    const int e = tid & 31, part = tid >> 5; unsigned c = 0;
#pragma unroll 4
    for (int r = part; r < nrows; r += 16) c += cnt[r * 32 + e];
    red[tid] = (int)c;
    __syncthreads();
    if (tid < 32) { int t = 0;
#pragma unroll
        for (int p = 0; p < 16; ++p) t += red[p * 32 + tid];
        out = t; }
}
DI void moe_tables(const Ptrs& P, LAS int* ts, int tid) {
    int c = 0; moe_colsum((const unsigned*)(P.ctl + CW_CNT), T / 128, ts + 128, tid, c);
    if (tid < 64) { int tiles = (tid < 32) ? ((c + 255) >> 8) : 0, inc = tiles;
#pragma unroll
        for (int o = 1; o < 32; o <<= 1) { const int v = __shfl_up(inc, o); if ((tid & 63) >= o) inc += v; }
        if (tid < 32) { ts[tid] = inc - tiles; ts[40 + tid] = c; } if (tid == 31) ts[32] = inc; }
    __syncthreads();
}
DI void moe_scatter(const Ptrs& P, LAS unsigned char* lds, int vcu, int G, int tid) {
    LAS int* ts = (LAS int*)(lds + TBL_OFF); moe_tables(P, ts, tid); LAS int* bs = ts + 80;
    const int* ASG_E = (const int*)(P.ws + WS_ASG_E); const int* ASG_SLOT = (const int*)(P.ws + WS_ASG_SLOT); int* ASG_ROW = (int*)(P.ws + WS_ASG_ROW); int* RT = (int*)(P.ws + WS_ROWTOK);
    const unsigned* cnt = (const unsigned*)(P.ctl + CW_CNT);
    for (int tb = blockIdx.x; tb < T / 128; tb += G) {
        { int c = 0; moe_colsum(cnt, tb, ts + 128, tid, c); if (tid < 32) bs[tid] = c; }
        __syncthreads();
        { const int a = tb * 512 + tid, e = ASG_E[a], row = ts[e] * 256 + bs[e] + ASG_SLOT[a]; ASG_ROW[a] = row; RT[row] = a >> 2; }
        __syncthreads(); }
}
constexpr int LT_OFF = 131072 + 2048;
template <class Sched> DI void moe_unit_tokens(const Ptrs& P, const Sched& S, LAS unsigned short* lt, int tid) {
    const int* RT = (const int*)(P.ws + WS_ROWTOK); int pmv[17];
#pragma unroll
    for (int i = 0; i < 17; ++i) { pg8::Unit u; pmv[i] = S.next(i, u) ? u.pm : -1; }
    if (tid < 256) { int tk[17];
#pragma unroll
        for (int i = 0; i < 17; ++i) tk[i] = (pmv[i] >= 0) ? RT[pmv[i] * 256 + tid] : 0;
#pragma unroll
        for (int i = 0; i < 17; ++i) if (pmv[i] >= 0) lt[i * 256 + tid] = (unsigned short)tk[i]; }
    __syncthreads();
}
DI void final_phase(const Ptrs& P, int vcu, int G, int tid) {
    const int lane = tid & 63, wave = tid >> 6, gw = vcu * 8 + wave, NGW = G * 8;
    const int* ASG_ROW = (const int*)(P.ws + WS_ASG_ROW); const float* ASG_G = (const float*)(P.ws + WS_ASG_G); const unsigned char* YB8 = P.ws + WS_YB;
#if BRINGUP == 1
    for (int t = gw; t < T; t += NGW) { const f32x4* hr = (const f32x4*)(P.x + (size_t)t * D) + lane; f32x4 v[4]; float s = 0.f;
#pragma unroll
        for (int j = 0; j < 4; ++j) { v[j] = hr[64 * j]; s += (v[j].x * v[j].x + v[j].y * v[j].y) + (v[j].z * v[j].z + v[j].w * v[j].w); }
        const float rstd = 1.f / sqrtf(wave_sum(s) * (1.f / D) + RMS_EPS); f32x4* orow = (f32x4*)(P.out + (size_t)t * D) + lane; const f32x4* wr = (const f32x4*)P.lnf + lane;
#pragma unroll
        for (int j = 0; j < 4; ++j) orow[64 * j] = v[j] * rstd * wr[64 * j]; }
#else
    const bf16* H1 = (const bf16*)(P.ws + WS_H1);
    f32x4 lw[4];
#pragma unroll
    for (int j = 0; j < 4; ++j) lw[j] = ((const f32x4*)P.lnf + lane)[64 * j];
    typedef int i32x4 __attribute__((ext_vector_type(4)));
    constexpr int TPI = 4;
    int t0 = gw * TPI;
    i32x4 rws[TPI]; f32x4 gts[TPI];
    if (t0 < T) {
#pragma unroll
        for (int q = 0; q < TPI; ++q) { rws[q] = *(const i32x4*)(ASG_ROW + 4 * (t0 + q)); gts[q] = *(const f32x4*)(ASG_G + 4 * (t0 + q)); } }
    for (; t0 < T; t0 += NGW * TPI) {
        u32x2 hq[TPI][4]; unsigned yq[TPI][4][4];
#pragma unroll
        for (int q = 0; q < TPI; ++q) { const u32x2* hr = (const u32x2*)(H1 + (size_t)(t0 + q) * D) + lane;
#pragma unroll
            for (int j = 0; j < 4; ++j) hq[q][j] = hr[64 * j];
#pragma unroll
            for (int k = 0; k < 4; ++k) { const unsigned* yr = (const unsigned*)(YB8 + (size_t)rws[q][k] * D) + lane;
#pragma unroll
                for (int j = 0; j < 4; ++j) yq[q][k][j] = yr[64 * j]; } }
        f32x4 gc[TPI];
#pragma unroll
        for (int q = 0; q < TPI; ++q) gc[q] = gts[q];
        const int tn = t0 + NGW * TPI;
        if (tn < T) {
#pragma unroll
            for (int q = 0; q < TPI; ++q) { rws[q] = *(const i32x4*)(ASG_ROW + 4 * (tn + q)); gts[q] = *(const f32x4*)(ASG_G + 4 * (tn + q)); } }
#pragma unroll
        for (int q = 0; q < TPI; ++q) { f32x4 v[4]; float s = 0.f;
#pragma unroll
            for (int j = 0; j < 4; ++j) { v[j].x = bflo(hq[q][j].x); v[j].y = bfhi(hq[q][j].x); v[j].z = bflo(hq[q][j].y); v[j].w = bfhi(hq[q][j].y);
#pragma unroll
                for (int k = 0; k < 4; ++k) { const float gk = gc[q][k]; const int y = (int)yq[q][k][j]; const f32x2 lo = __builtin_amdgcn_cvt_pk_f32_fp8(y, false), hi = __builtin_amdgcn_cvt_pk_f32_fp8(y, true);
                    v[j].x += gk * lo.x; v[j].y += gk * lo.y; v[j].z += gk * hi.x; v[j].w += gk * hi.y; }
                s += (v[j].x * v[j].x + v[j].y * v[j].y) + (v[j].z * v[j].z + v[j].w * v[j].w); }
            const float rstd = 1.f / sqrtf(wave_sum(s) * (1.f / D) + RMS_EPS);
            f32x4* orow = (f32x4*)(P.out + (size_t)(t0 + q) * D) + lane;
#pragma unroll
            for (int j = 0; j < 4; ++j) { f32x4 ov = v[j] * rstd * lw[j];
#if STAMP_PHASE >= 0
                if (t0 + q == 0 && lane == 0 && j == 0) { const unsigned long long* st = (const unsigned long long*)(P.ws + WS_CTL + 65536); ov.x += (float)(st[STAMP_PHASE + 1] - st[STAMP_PHASE]) * 0.0005f; }
#endif
                orow[64 * j] = ov; } }
    }
#endif
}

constexpr int N_PHASES = 12;
struct Args { const float* in[17]; float* out; unsigned char* ws; int ph_lo, ph_hi; };
__global__ void __launch_bounds__(512, 2) fwd(Args args) {
    extern __shared__ __attribute__((aligned(16))) unsigned char lds_raw[];
    LAS unsigned char* lds = (LAS unsigned char*)lds_raw;
    const int tid = threadIdx.x, G = gridDim.x; const int bx = blockIdx.x; const int vcu = (G % 8 == 0) ? (bx % 8) * (G / 8) + bx / 8 : bx;
    Ptrs P;
    P.x = args.in[0]; P.ln1 = args.in[1]; P.w_in = args.in[2]; P.w_gk2 = args.in[3]; P.b_gk2 = args.in[4]; P.gnorm = args.in[5]; P.wpa = args.in[6]; P.wpb = args.in[7]; P.wout = args.in[8];
    P.ln2 = args.in[9]; P.wr = args.in[10]; P.br = args.in[11]; P.wup = args.in[12]; P.bup = args.in[13]; P.wdn = args.in[14]; P.bdn = args.in[15]; P.lnf = args.in[16];
    P.out = args.out; P.ws = args.ws; P.ctl = (gu32*)(args.ws + WS_CTL);
    volatile LAS unsigned* MISC = (volatile LAS unsigned*)(lds + MISC_OFF);
    for (int u = tid; u < (LDS_BYTES - MISC_OFF) / 4; u += 512) ((LAS unsigned*)(lds + MISC_OFF))[u] = 0u;
    __syncthreads();
    XcdBarrier bar; bar.bar = (unsigned*)(P.ctl + CW_BAR); bar.x = 0; bar.st = nullptr;
    if (MK_N_LAUNCHES == 1) bar = xcd_barrier_post((unsigned*)(P.ctl + CW_BAR), MISC + 8);
    const int lo = args.ph_lo, hi = args.ph_hi;
#ifndef PH_MASK
#define PH_MASK 0xFFF
#endif
#define IN(k) (((PH_MASK >> (k)) & 1) && lo <= (k) && (k) < hi)
#define SEAM(k) do { if (IN(k) && IN((k) + 1)) xcd_barrier(bar); } while (0)
#define STAMP(k) do { if (STAMP_PHASE >= 0 && bx == 0 && tid == 0) ((unsigned long long*)(P.ws + WS_CTL + 65536))[k] = wall_clock64(); } while (0)
#define DUP(k, ...) do { __VA_ARGS__; if ((DUP_MASK >> (k)) & 1) { __syncthreads(); __VA_ARGS__; } } while (0)
    bf16* PROJ = (bf16*)(P.ws + WS_PROJ); bf16* XN = (bf16*)(P.ws + WS_XN); bf16* MIXED = XN;

    STAMP(0);
    if (IN(0)) { DUP(0, p0_prologue(P, lds, vcu, G, tid)); } SEAM(0);
#if BRINGUP == 0
    STAMP(1);
    if (IN(1)) { pg8::Gemm g{XN, (const bf16*)(P.ws + WS_WIN), T, NP, D / 2, 0}; pg8::StaticOrder S; S.init(T, NP, G, bx);
        pg8::EpiProj<true> E{PROJ, P.b_gk2, (const float*)(P.ws + WS_SX), (const float*)(P.ws + WS_SWIN)};
        const int nq_items = (32 * 64 + 32 * 32 + G - 1) / G, rounds = (S.nwg + G - 1) / G, phs = bx & 1;
        if (!phs) { p0_quant_all(P, lds, vcu, G, tid, 0, nq_items); __syncthreads(); }
        { int t_ = tid; asm volatile("" : "+v"(t_)); pg8::gemm_phase<pg8::EpiProj<true>, pg8::StaticOrder, 2>(lds, g, S, E, t_); }
        if (phs) { __syncthreads(); p0_quant_all(P, lds, vcu, G, tid, 0, nq_items); }
    } SEAM(1);
    STAMP(2);
    if (IN(2)) { bf16* OG = (bf16*)((unsigned char*)P.out + OUT_OG); float* LSE = (float*)((unsigned char*)P.out + OUT_LSE);
        DUP(12, for (int u = vcu; u < 768; u += G) attn_task(P.ws, OG, LSE, lds, u, tid));
        DUP(13, for (int u = bx; u < 256; u += G) gla_pass1(P, lds, u, tid)); } SEAM(2);
    STAMP(3);
    if (IN(3)) { gla_scan(P, vcu, G, tid); attn_merge(P, vcu, G, tid); } SEAM(3);
    STAMP(4);
    if (IN(4)) { DUP(4, for (int u = bx; u < 256; u += G) gla_pass2(P, lds, u, tid)); } SEAM(4);
    STAMP(5);
    if (IN(5)) { { pg8::Gemm g{(const bf16*)(P.ws + WS_OA), (const bf16*)(P.ws + WS_WPA), T, D, 512, 0}; pg8::StaticOrder S; S.init(T, D, G, bx); pg8::EpiGate<false> E{MIXED, (const unsigned char*)(PROJ + 64 * PLANE), (unsigned char*)P.out  }; pg8::gemm_phase(lds, g, S, E); }
                 { pg8::Gemm g{(const bf16*)(P.ws + WS_OB), (const bf16*)(P.ws + WS_WPB), T, D, D, 0}; pg8::StaticOrder S; S.init(T, D, G, bx); pg8::EpiGate<true> E{MIXED, (const unsigned char*)(PROJ + 64 * PLANE) + 1024, (unsigned char*)P.out}; pg8::gemm_phase(lds, g, S, E); } } SEAM(5);
    STAMP(6);
    if (IN(6)) { pg8::Gemm g{MIXED, (const bf16*)(P.ws + WS_WOUT), T, D, D, 0}; pg8::StaticOrder S; S.init(T, D, G, bx); pg8::EpiResBf16 E{P.x, (bf16*)(P.ws + WS_H1), (float*)(P.ws + WS_PS)}; pg8::gemm_phase(lds, g, S, E); } SEAM(6);
#elif BRINGUP == 2
    if (IN(6)) { for (size_t idx = (size_t)vcu * 512 + tid; idx < (size_t)T * D / 2; idx += (size_t)G * 512) ((unsigned*)(P.ws + WS_H1))[idx] = pk2(P.x[2 * idx], P.x[2 * idx + 1]); } SEAM(6);
#endif
#if BRINGUP != 1
    STAMP(7);
    if (IN(7)) { router_phase(P, lds, G, tid); } SEAM(7);
    STAMP(8);
    if (IN(8)) { moe_scatter(P, lds, vcu, G, tid); } SEAM(8);
    STAMP(9);
    if (IN(9)) { LAS int* ts = (LAS int*)(lds + TBL_OFF); moe_tables(P, ts, tid); LAS unsigned short* lt = (LAS unsigned short*)(lds + LT_OFF);
        pg8::MoeOrder S; S.init(ts[32] * 256, 2048, G, bx); S.ts = ts; moe_unit_tokens(P, S, lt, tid);
        pg8::Gemm g{(const bf16*)(P.ws + WS_HN), (const bf16*)(P.ws + WS_WUP), 0, 2048, D / 2, (size_t)2048 * 512, lt};
        pg8::EpiSwiGLU8 E{P.ws + WS_ACT, P.bup, (const float*)(P.ws + WS_SUP)}; DUP(9, pg8::gemm_phase<pg8::EpiSwiGLU8, pg8::MoeOrder, 1, true>(lds, g, S, E)); } SEAM(9);
    STAMP(10);
    if (IN(10)) { LAS int* ts = (LAS int*)(lds + TBL_OFF); moe_tables(P, ts, tid);
        pg8::Gemm g{(const bf16*)(P.ws + WS_ACT), (const bf16*)(P.ws + WS_WDN), 0, D, D / 2, (size_t)1024 * 512, nullptr}; pg8::MoeOrder S; S.init(ts[32] * 256, D, G, bx); S.ts = ts;
        pg8::EpiDown8 E{P.ws + WS_YB, P.bdn, (const float*)(P.ws + WS_SDN)}; DUP(10, pg8::gemm_phase<pg8::EpiDown8, pg8::MoeOrder, 1, false>(lds, g, S, E)); } SEAM(10);
#endif
    STAMP(11);
    if (IN(11)) { DUP(11, final_phase(P, vcu, G, tid)); }
#undef IN
#undef SEAM
}

extern "C" void kernel_launch(void* const* d_in, const int* in_sizes, int n_in, void* d_out, int out_size, void* d_ws, size_t ws_size, hipStream_t stream) {
    static int grid = 0;
    if (grid == 0) {
        if (n_in != 17 || out_size != T * D || ws_size < WS_END) { fprintf(stderr, "kernel_launch: unexpected shapes (n_in %d out %d ws %zu, need %zu)\n", n_in, out_size, ws_size, (size_t)WS_END); grid = -1; return; }
        int dev = 0, cus = 0;
        if (hipGetDevice(&dev) != hipSuccess || hipDeviceGetAttribute(&cus, hipDeviceAttributeMultiprocessorCount, dev) != hipSuccess) { grid = -1; return; }
        if (hipFuncSetAttribute((const void*)fwd, hipFuncAttributeMaxDynamicSharedMemorySize, LDS_BYTES) != hipSuccess) { grid = -1; return; }
        int per_cu = 0; (void)hipOccupancyMaxActiveBlocksPerMultiprocessor(&per_cu, (const void*)fwd, 512, LDS_BYTES); (void)hipGetLastError();
        grid = cus;
    }
    if (grid < 0) return;
    (void)hipMemsetAsync((char*)d_ws + WS_CTL, 0, CTL_ZERO_BYTES, stream);
    Args a{};
    for (int i = 0; i < 17; ++i) a.in[i] = (const float*)d_in[i];
    a.out = (float*)d_out; a.ws = (unsigned char*)d_ws;
    if (MK_N_LAUNCHES == 1) { a.ph_lo = 0; a.ph_hi = N_PHASES; hipLaunchKernelGGL(fwd, dim3(grid), dim3(512), LDS_BYTES, stream, a); }
    else { for (int p = 0; p < N_PHASES; ++p) { a.ph_lo = p; a.ph_hi = p + 1; hipLaunchKernelGGL(fwd, dim3(grid), dim3(512), LDS_BYTES, stream, a); } }
}
```

```cpp
#include <hip/hip_runtime.h>
#include <cstdio>
#include <cstdint>

#ifndef MK_N_LAUNCHES
#define MK_N_LAUNCHES 1
#endif
#ifndef DUP_MASK
#define DUP_MASK 0
#endif
#ifndef STAMP_PHASE
#define STAMP_PHASE -1
#endif
#ifndef BRINGUP
#define BRINGUP 0
#endif

#define DI __device__ __forceinline__
#define LAS __attribute__((address_space(3)))
#define GAS __attribute__((address_space(1)))
typedef unsigned short bf16;
typedef short bf16x8 __attribute__((ext_vector_type(8)));
typedef short s16x4 __attribute__((ext_vector_type(4)));
typedef short v4i16_t __attribute__((ext_vector_type(4)));
typedef float f32x4 __attribute__((ext_vector_type(4)));
typedef float f32x2 __attribute__((ext_vector_type(2)));
typedef unsigned u32x4 __attribute__((ext_vector_type(4)));
typedef unsigned u32x2 __attribute__((ext_vector_type(2)));
typedef __bf16 bf16v2 __attribute__((ext_vector_type(2)));
typedef GAS unsigned gu32;
#define RLX_AGENT __ATOMIC_RELAXED, __HIP_MEMORY_SCOPE_AGENT
#define LDS_WAIT() asm volatile("s_waitcnt lgkmcnt(0)" ::: "memory")
#define VM_WAIT() asm volatile("s_waitcnt vmcnt(0)" ::: "memory")

DI unsigned pk2(float a, float b) { bf16v2 v; v.x = (__bf16)a; v.y = (__bf16)b; return __builtin_bit_cast(unsigned, v); }
DI float bflo(unsigned w) { return __uint_as_float(w << 16); }
DI float bfhi(unsigned w) { return __uint_as_float(w & 0xffff0000u); }
DI float bf2f(bf16 b) { return __uint_as_float(((unsigned)b) << 16); }
DI bf16 f2bf(float f) { return (bf16)(pk2(f, 0.f) & 0xffffu); }
DI float sigmoidf_fast(float z) { return __builtin_amdgcn_rcpf(1.0f + __builtin_amdgcn_exp2f(-1.4426950408889634f * z)); }
DI bf16x8 cat8(s16x4 lo, s16x4 hi) { bf16x8 r; r[0] = lo[0]; r[1] = lo[1]; r[2] = lo[2]; r[3] = lo[3]; r[4] = hi[0]; r[5] = hi[1]; r[6] = hi[2]; r[7] = hi[3]; return r; }
#define MFMA16(a, b, c) __builtin_amdgcn_mfma_f32_16x16x32_bf16((a), (b), (c), 0, 0, 0)

constexpr int T = 32768, SEQ = 16384, D = 1024, NP = 10240, IN_W = 9744;
constexpr int C_GQ = 4608, C_GK = 5120, C_GV = 5632, C_GOG = 6656, C_GF = 7680, C_MA = 8192, C_MB = 9216;
constexpr int NEXP = 32, NASG = T * 4, MAXTILES = 544;
constexpr float RMS_EPS = 1e-5f;

namespace pg8 {
#define PG8_LAS __attribute__((address_space(3)))
typedef unsigned short bf16_t;
constexpr int BM = 256, BK = 64, HALF = 128, HTB = HALF * BK * 2, STAGE_BYTES = 8 * HTB, NXCD = 8, WGM = 8;
__host__ __device__ __forceinline__ int lds_byte(int r, int c) { const int st = (r >> 4) * 2 + (c >> 5), rr = r & 15, cc = c & 31, ob = rr * 64 + cc * 2; return st * 1024 + (ob ^ (((ob >> 9) & 1) << 5)); }
__host__ __device__ __forceinline__ void stage_rc(int b, int& R, int& C) { const int st = b / 1024, sb = b % 1024, swz = sb ^ (((sb >> 9) & 1) << 5); R = (st >> 1) * 16 + swz / 64; C = (st & 1) * 32 + (swz % 64) / 2; }
__host__ __device__ __forceinline__ int perm32(int rho) { const int n = rho >> 4, i = rho & 15; return 8 * (i >> 2) + 4 * n + (i & 3); }

struct Unit { int pm, pn, e; };
struct Gemm { const bf16_t* A; const bf16_t* Bt; int M, N, K; size_t bstride; const PG8_LAS unsigned short* lt; };

struct StaticOrder {
    int nM, nN, nwg, G, c, ibeg = 0, iend = 0x7fffffff;
    __host__ __device__ void init(int M, int N, int G_, int c_) { nM = M / BM; nN = N / BM; nwg = nM * nN; G = G_; c = c_; ibeg = 0; iend = 0x7fffffff; }
    __host__ __device__ bool next(int i, Unit& u) const {
        i += ibeg; if (i >= iend) return false;
        const long L = (long)i * G + c; if (L >= nwg) return false;
        int wgid = (int)L; { const int q = nwg / NXCD, r = nwg % NXCD, xcd = wgid % NXCD, off = wgid / NXCD; wgid = (xcd < r ? xcd * (q + 1) : r * (q + 1) + (xcd - r) * q) + off; }
        const int nig = WGM * nN, gid = wgid / nig, fm = gid * WGM, gsz = (nM - fm) < WGM ? (nM - fm) : WGM;
        u.pm = fm + ((wgid % nig) % gsz); u.pn = (wgid % nig) / gsz; u.e = 0; return true;
    }
};
struct MoeOrder : StaticOrder {
    const PG8_LAS int* ts;
    __device__ __forceinline__ bool next(int i, Unit& u) const {
        if (!StaticOrder::next(i, u)) return false;
        int e = 0;
#pragma unroll 1
        while (e < 31 && u.pm >= ts[e + 1]) ++e;
        u.e = e; return true;
    }
};

struct EpiStoreBf16 {
    static constexpr bool PERM = true, HAS_VEC = false;
    bf16_t* O; int ldc; const float* bias; int bias_estride;
    __device__ __forceinline__ void operator()(const f32x4 (&acc)[2][2][4][2], const Unit& u, int wr, int wc, int fr, int fq, const PG8_LAS float* vec) const {
        const int row0 = u.pm * BM + wr * 64 + fr, col0 = u.pn * BM + wc * 32 + 8 * fq;
        f32x4 bv[2][2];
#pragma unroll
        for (int bj = 0; bj < 2; ++bj)
#pragma unroll
            for (int n = 0; n < 2; ++n) bv[bj][n] = bias ? *(const f32x4*)(bias + (size_t)u.e * bias_estride + col0 + bj * HALF + 4 * n) : (f32x4){0.f, 0.f, 0.f, 0.f};
#pragma unroll
        for (int ai = 0; ai < 2; ++ai)
#pragma unroll
            for (int m = 0; m < 4; ++m) { bf16_t* rowp = O + (size_t)(row0 + ai * HALF + m * 16) * ldc + col0;
#pragma unroll
                for (int bj = 0; bj < 2; ++bj) { const f32x4 v0 = acc[ai][bj][m][0] + bv[bj][0], v1 = acc[ai][bj][m][1] + bv[bj][1];
                    u32x4 w; w.x = pk2(v0[0], v0[1]); w.y = pk2(v0[2], v0[3]); w.z = pk2(v1[0], v1[1]); w.w = pk2(v1[2], v1[3]);
                    *(u32x4*)(rowp + bj * HALF) = w; } }
    }
};
template <bool I8> struct EpiProj {
    static constexpr bool PERM = true, HAS_VEC = I8;
    bf16_t* P; const float* bgk2; const float* sx; const float* sw;
    __device__ __forceinline__ const float* vec_src(const Unit& u, int L) const { const int o = (L & 63) * 4; return L < 64 ? sw + u.pn * BM + o : sx + u.pm * BM + o; }
    template <bool ISG, bool F8> __device__ __forceinline__ void block(const f32x4 (&acc)[2][2][4][2], int bj, int cb, size_t base, int pitch, int dsh, float sc, int row0, int x0, int wr, int fr, const PG8_LAS float* vec) const {
        f32x4 b0 = {0.f, 0.f, 0.f, 0.f}, b1 = {0.f, 0.f, 0.f, 0.f};
        if (ISG) { b0 = *(const f32x4*)(bgk2 + (cb - 60) * 128 + x0); b1 = *(const f32x4*)(bgk2 + (cb - 60) * 128 + x0 + 4); }
        f32x4 c0 = {sc, sc, sc, sc}, c1 = {sc, sc, sc, sc};
        if (I8) { c0 = *(const PG8_LAS f32x4*)(vec + bj * HALF + x0) * sc; c1 = *(const PG8_LAS f32x4*)(vec + bj * HALF + x0 + 4) * sc; }
#pragma unroll
        for (int ai = 0; ai < 2; ++ai)
#pragma unroll
            for (int m = 0; m < 4; ++m) { const int r = row0 + ai * HALF + m * 16, s = r & (SEQ - 1); const size_t rp = (size_t)(r & ~(SEQ - 1)) + (size_t)((s & ((1 << dsh) - 1)) << (14 - dsh)) + (size_t)(s >> dsh);
                f32x4 v0 = acc[ai][bj][m][0], v1 = acc[ai][bj][m][1];
                if (I8) { const float rs = vec[256 + wr * 64 + fr + ai * HALF + m * 16]; const f32x4 d0 = c0 * rs, d1 = c1 * rs;
#pragma unroll
                    for (int j = 0; j < 4; ++j) { v0[j] = (float)__float_as_int(v0[j]) * d0[j]; v1[j] = (float)__float_as_int(v1[j]) * d1[j]; } }
                else { v0 = v0 * c0; v1 = v1 * c1; }
                if (ISG) {
#pragma unroll
                    for (int j = 0; j < 4; ++j) { const float xa = v0[j] + b0[j], xb = v1[j] + b1[j];
                        v0[j] = (fminf(xa, 0.f) - __logf(1.0f + __expf(-fabsf(xa)))) * (1.0f / 16.0f); v1[j] = (fminf(xb, 0.f) - __logf(1.0f + __expf(-fabsf(xb)))) * (1.0f / 16.0f); } }
                if (F8) { int w0 = 0, w1 = 0; w0 = __builtin_amdgcn_cvt_pk_fp8_f32(v0[0], v0[1], w0, false); w0 = __builtin_amdgcn_cvt_pk_fp8_f32(v0[2], v0[3], w0, true);
                    w1 = __builtin_amdgcn_cvt_pk_fp8_f32(v1[0], v1[1], w1, false); w1 = __builtin_amdgcn_cvt_pk_fp8_f32(v1[2], v1[3], w1, true);
                    u32x2 w; w.x = (unsigned)w0; w.y = (unsigned)w1; *(u32x2*)((unsigned char*)P + 2 * base + rp * pitch + x0) = w; }
                else { u32x4 w; w.x = pk2(v0[0], v0[1]); w.y = pk2(v0[2], v0[3]); w.z = pk2(v1[0], v1[1]); w.w = pk2(v1[2], v1[3]);
                    *(u32x4*)(P + base + rp * pitch + x0) = w; } }
    }
    __device__ __forceinline__ void operator()(const f32x4 (&acc)[2][2][4][2], const Unit& u, int wr, int wc, int fr, int fq, const PG8_LAS float* vec) const {
        const int row0 = u.pm * BM + wr * 64 + fr, x0 = wc * 32 + 8 * fq;
#pragma unroll
        for (int bj = 0; bj < 2; ++bj) { const int cb = __builtin_amdgcn_readfirstlane(2 * u.pn + bj);
            size_t base; int pitch = 128, dsh = 0; float sc = 1.0f;
            if (cb < 36) { base = (size_t)cb * T * 128; dsh = 2 * (cb / 12); if ((cb % 12) < 4) sc = 0.08838834764831845f * 1.4426950408889634f; }
            else if (cb < 44) { base = (size_t)cb * T * 128; if (cb < 40) sc = 0.08838834764831845f; }
            else if (cb < 60) { const int gb = (cb < 52) ? 44 : 52; base = (size_t)gb * T * 128 + (size_t)((cb - gb) >> 1) * T * 256 + ((cb - gb) & 1) * 128; pitch = 256; }
            else if (cb < 64) { base = (size_t)cb * T * 128; }
            else { base = (size_t)64 * T * 128 + (size_t)(cb - 64) * 64; pitch = 2048; }
            if (cb >= 60 && cb < 64) block<true, false>(acc, bj, cb, base, pitch, dsh, sc, row0, x0, wr, fr, vec);
            else if (cb >= 64 || cb < 36) block<false, true>(acc, bj, cb, base, pitch, dsh, sc, row0, x0, wr, fr, vec);
            else block<false, false>(acc, bj, cb, base, pitch, dsh, sc, row0, x0, wr, fr, vec); }
    }
};
template <bool ADD> struct EpiGate {
    static constexpr bool PERM = true, HAS_VEC = false; static constexpr int NSTORE = 16;
    bf16_t* O; const unsigned char* G8; unsigned char* PART8;
    __device__ __forceinline__ void operator()(const f32x4 (&acc)[2][2][4][2], const Unit& u, int wr, int wc, int fr, int fq, const PG8_LAS float* vec) const {
        const int row0 = u.pm * BM + wr * 64 + fr, col0 = u.pn * BM + wc * 32 + 8 * fq;
#pragma unroll
        for (int ai = 0; ai < 2; ++ai)
#pragma unroll
            for (int m = 0; m < 4; ++m) { const size_t r = (size_t)(row0 + ai * HALF + m * 16);
#pragma unroll
                for (int bj = 0; bj < 2; ++bj) { const u32x2 gw = *(const u32x2*)(G8 + r * 2048 + col0 + bj * HALF);
                    u32x2 pw = {0u, 0u}; if (ADD) pw = *(const u32x2*)(PART8 + r * D + col0 + bj * HALF);
                    const f32x2 g0 = __builtin_amdgcn_cvt_pk_f32_fp8((int)gw.x, false), g1 = __builtin_amdgcn_cvt_pk_f32_fp8((int)gw.x, true), g2 = __builtin_amdgcn_cvt_pk_f32_fp8((int)gw.y, false), g3 = __builtin_amdgcn_cvt_pk_f32_fp8((int)gw.y, true);
                    f32x2 p0 = {0.f, 0.f}, p1 = {0.f, 0.f}, p2 = {0.f, 0.f}, p3 = {0.f, 0.f};
                    if (ADD) { p0 = __builtin_amdgcn_cvt_pk_f32_fp8((int)pw.x, false); p1 = __builtin_amdgcn_cvt_pk_f32_fp8((int)pw.x, true); p2 = __builtin_amdgcn_cvt_pk_f32_fp8((int)pw.y, false); p3 = __builtin_amdgcn_cvt_pk_f32_fp8((int)pw.y, true); }
                    const f32x4 v0 = acc[ai][bj][m][0], v1 = acc[ai][bj][m][1];
                    const float r0 = p0.x + sigmoidf_fast(g0.x) * v0[0], r1 = p0.y + sigmoidf_fast(g0.y) * v0[1], r2 = p1.x + sigmoidf_fast(g1.x) * v0[2], r3 = p1.y + sigmoidf_fast(g1.y) * v0[3];
                    const float r4 = p2.x + sigmoidf_fast(g2.x) * v1[0], r5 = p2.y + sigmoidf_fast(g2.y) * v1[1], r6 = p3.x + sigmoidf_fast(g3.x) * v1[2], r7 = p3.y + sigmoidf_fast(g3.y) * v1[3];
                    if (ADD) { u32x4 w; w.x = pk2(r0, r1); w.y = pk2(r2, r3); w.z = pk2(r4, r5); w.w = pk2(r6, r7); *(u32x4*)(O + r * D + col0 + bj * HALF) = w; }
                    else { int w0 = 0, w1 = 0; w0 = __builtin_amdgcn_cvt_pk_fp8_f32(r0, r1, w0, false); w0 = __builtin_amdgcn_cvt_pk_fp8_f32(r2, r3, w0, true); w1 = __builtin_amdgcn_cvt_pk_fp8_f32(r4, r5, w1, false); w1 = __builtin_amdgcn_cvt_pk_fp8_f32(r6, r7, w1, true);
                        u32x2 w; w.x = (unsigned)w0; w.y = (unsigned)w1; *(u32x2*)(PART8 + r * D + col0 + bj * HALF) = w; } } }
    }
};
struct EpiResBf16 {
    static constexpr bool PERM = true, HAS_VEC = false; static constexpr int NSTORE = 16;
    const float* base; bf16_t* O; float* PS;
    __device__ __forceinline__ void operator()(const f32x4 (&acc)[2][2][4][2], const Unit& u, int wr, int wc, int fr, int fq, const PG8_LAS float* vec) const {
        const int row0 = u.pm * BM + wr * 64 + fr, col0 = u.pn * BM + wc * 32 + 8 * fq;
#pragma unroll
        for (int ai = 0; ai < 2; ++ai)
#pragma unroll
            for (int m = 0; m < 4; ++m) { const size_t off = (size_t)(row0 + ai * HALF + m * 16) * D + col0; float ss = 0.f;
#pragma unroll
                for (int bj = 0; bj < 2; ++bj) { const f32x4 v0 = *(const f32x4*)(base + off + bj * HALF) + acc[ai][bj][m][0], v1 = *(const f32x4*)(base + off + bj * HALF + 4) + acc[ai][bj][m][1];
                    ss += (v0[0] * v0[0] + v0[1] * v0[1]) + (v0[2] * v0[2] + v0[3] * v0[3]) + (v1[0] * v1[0] + v1[1] * v1[1]) + (v1[2] * v1[2] + v1[3] * v1[3]);
                    u32x4 w; w.x = pk2(v0[0], v0[1]); w.y = pk2(v0[2], v0[3]); w.z = pk2(v1[0], v1[1]); w.w = pk2(v1[2], v1[3]);
                    *(u32x4*)(O + off + bj * HALF) = w; }
                ss += __shfl_xor(ss, 16); ss += __shfl_xor(ss, 32);
                if (fq == 0) PS[(size_t)(u.pn * 4 + wc) * T + row0 + ai * HALF + m * 16] = ss; }
    }
};
struct EpiSwiGLU8 {
    static constexpr bool PERM = true, HAS_VEC = true;
    unsigned char* O; const float* bup; const float* cs;
    __device__ __forceinline__ const float* vec_src(const Unit& u, int L) const { const int seg = L >> 5, o = (L & 31) * 4;
        return seg == 0 ? bup + (size_t)u.e * 2048 + u.pn * 128 + o : seg == 1 ? bup + (size_t)u.e * 2048 + 1024 + u.pn * 128 + o : seg == 2 ? cs + (size_t)u.e * 2048 + u.pn * 256 + o : cs + (size_t)u.e * 2048 + u.pn * 256 + 128 + o; }
    __device__ __forceinline__ void operator()(const f32x4 (&acc)[2][2][4][2], const Unit& u, int wr, int wc, int fr, int fq, const PG8_LAS float* vec) const {
        const int row0 = u.pm * BM + wr * 64 + fr, x0 = wc * 32 + 8 * fq;
        const f32x4 bgv[2] = {*(const PG8_LAS f32x4*)(vec + x0), *(const PG8_LAS f32x4*)(vec + x0 + 4)}, blv[2] = {*(const PG8_LAS f32x4*)(vec + 128 + x0), *(const PG8_LAS f32x4*)(vec + 128 + x0 + 4)};
        const f32x4 sgv[2] = {*(const PG8_LAS f32x4*)(vec + 256 + x0), *(const PG8_LAS f32x4*)(vec + 256 + x0 + 4)}, slv[2] = {*(const PG8_LAS f32x4*)(vec + 384 + x0), *(const PG8_LAS f32x4*)(vec + 384 + x0 + 4)};
#pragma unroll
        for (int ai = 0; ai < 2; ++ai)
#pragma unroll
            for (int m = 0; m < 4; ++m) { float r[8];
#pragma unroll
                for (int n = 0; n < 2; ++n) { const f32x4 gv = acc[ai][0][m][n] * sgv[n] + bgv[n], lv = acc[ai][1][m][n] * slv[n] + blv[n];
#pragma unroll
                    for (int j = 0; j < 4; ++j) { const float xg = fminf(gv[j], 7.0f), xl = fminf(fmaxf(lv[j], -7.0f), 7.0f); r[4 * n + j] = xg * sigmoidf_fast(1.702f * xg) * (xl + 1.0f); } }
                int w0 = 0, w1 = 0;
                w0 = __builtin_amdgcn_cvt_pk_fp8_f32(r[0], r[1], w0, false); w0 = __builtin_amdgcn_cvt_pk_fp8_f32(r[2], r[3], w0, true);
                w1 = __builtin_amdgcn_cvt_pk_fp8_f32(r[4], r[5], w1, false); w1 = __builtin_amdgcn_cvt_pk_fp8_f32(r[6], r[7], w1, true);
                u32x2 w; w.x = (unsigned)w0; w.y = (unsigned)w1;
                *(u32x2*)(O + (size_t)(row0 + ai * HALF + m * 16) * D + u.pn * 128 + x0) = w; }
    }
};
struct EpiDown8 {
    static constexpr bool PERM = true, HAS_VEC = true;
    unsigned char* O; const float* bias; const float* cs;
    __device__ __forceinline__ const float* vec_src(const Unit& u, int L) const { const int o = (L & 63) * 4; return (L < 64 ? bias : cs) + (size_t)u.e * D + u.pn * BM + o; }
    __device__ __forceinline__ void operator()(const f32x4 (&acc)[2][2][4][2], const Unit& u, int wr, int wc, int fr, int fq, const PG8_LAS float* vec) const {
        const int row0 = u.pm * BM + wr * 64 + fr, col0 = u.pn * BM + wc * 32 + 8 * fq;
        f32x4 bv[2][2], sv[2][2];
#pragma unroll
        for (int bj = 0; bj < 2; ++bj)
#pragma unroll
            for (int n = 0; n < 2; ++n) { bv[bj][n] = *(const PG8_LAS f32x4*)(vec + wc * 32 + 8 * fq + bj * HALF + 4 * n); sv[bj][n] = *(const PG8_LAS f32x4*)(vec + 256 + wc * 32 + 8 * fq + bj * HALF + 4 * n); }
#pragma unroll
        for (int ai = 0; ai < 2; ++ai)
#pragma unroll
            for (int m = 0; m < 4; ++m) { unsigned char* rowp = O + (size_t)(row0 + ai * HALF + m * 16) * D + col0;
#pragma unroll
                for (int bj = 0; bj < 2; ++bj) { const f32x4 v0 = acc[ai][bj][m][0] * sv[bj][0] + bv[bj][0], v1 = acc[ai][bj][m][1] * sv[bj][1] + bv[bj][1];
                    int w0 = 0, w1 = 0; w0 = __builtin_amdgcn_cvt_pk_fp8_f32(v0[0], v0[1], w0, false); w0 = __builtin_amdgcn_cvt_pk_fp8_f32(v0[2], v0[3], w0, true);
                    w1 = __builtin_amdgcn_cvt_pk_fp8_f32(v1[0], v1[1], w1, false); w1 = __builtin_amdgcn_cvt_pk_fp8_f32(v1[2], v1[3], w1, true);
                    u32x2 w; w.x = (unsigned)w0; w.y = (unsigned)w1; *(u32x2*)(rowp + bj * HALF) = w; } }
    }
};
constexpr int EPV_OFF = 131072 + 12288;
typedef int v8i_t __attribute__((ext_vector_type(8)));
typedef int v4i_t __attribute__((ext_vector_type(4)));
template <class Epi, class Sched, int DT = 0, bool GATHER = false, bool ALIGN_EPI = true, bool SP2 = true>
__device__ __forceinline__ void gemm_phase(PG8_LAS unsigned char* lds, const Gemm g, const Sched& S, const Epi& E, const int tid = threadIdx.x) {
    const int wid = __builtin_amdgcn_readfirstlane(tid >> 6), lane = tid & 63, wr = wid >> 2, wc = wid & 3, fr = lane & 15, fq = lane >> 4;
    const int K = g.K, nt = K / BK;
    unsigned voffA[2], voffB[2]; int gR[2], gC[2];
#pragma unroll
    for (int i = 0; i < 2; ++i) { int R, C; stage_rc(tid * 16 + i * 8192, R, C); const int Rb = Epi::PERM ? ((R & ~31) + perm32(R & 31)) : R;
        voffA[i] = (unsigned)(R * K + C) * 2u; voffB[i] = (unsigned)(Rb * K + C) * 2u; gR[i] = R; gC[i] = C * 2; }
    unsigned offC[2][2], offN[2][2];
#define PG8_GOFF(dst, uidx) do { _Pragma("unroll") for (int _h = 0; _h < 2; ++_h) _Pragma("unroll") for (int _i = 0; _i < 2; ++_i) \
        dst[_h][_i] = (unsigned)g.lt[(uidx) * 256 + _h * 128 + gR[_i]] * (unsigned)(K * 2) + (unsigned)gC[_i]; } while (0)
    const size_t kstep = (size_t)(BK * 2), hstep = (size_t)HALF * K * 2, tstep = 2 * hstep, estep = g.bstride * 2;
    const unsigned ldsw = (unsigned)wid * 1024u;
    const int aoff = lds_byte(wr * 64 + fr, fq * 8), boff = lds_byte(wc * 32 + fr, fq * 8);
#define PG8_SA(b, h) (((b) * 2 + (h)) * HTB)
#define PG8_SB(b, h) ((4 + (b) * 2 + (h)) * HTB)
#define PG8_STAGE(bufoff, gbase, voff) do { _Pragma("unroll") for (int _i = 0; _i < 2; ++_i) \
        __builtin_amdgcn_global_load_lds((const unsigned*)((const char*)(gbase) + (voff)[_i]), (PG8_LAS unsigned*)(lds + (bufoff) + ldsw + _i * 8192), 16, 0, 0); } while (0)
#define PG8_LDA(dst, b, h) do { if constexpr (DT == 1) { _Pragma("unroll") for (int m = 0; m < 4; ++m) dst##8[m] = __builtin_shufflevector(*(const PG8_LAS v4i_t*)(lds + PG8_SA(b, h) + aoff + m * 2048), *(const PG8_LAS v4i_t*)(lds + PG8_SA(b, h) + aoff + m * 2048 + 1024), 0, 1, 2, 3, 4, 5, 6, 7); } \
        else { _Pragma("unroll") for (int m = 0; m < 4; ++m) _Pragma("unroll") for (int k = 0; k < 2; ++k) dst[m][k] = *(const PG8_LAS bf16x8*)(lds + PG8_SA(b, h) + aoff + m * 2048 + k * 1024); } } while (0)
#define PG8_LDB(dst, b, h) do { if constexpr (DT == 1) { _Pragma("unroll") for (int n = 0; n < 2; ++n) dst##8[n] = __builtin_shufflevector(*(const PG8_LAS v4i_t*)(lds + PG8_SB(b, h) + boff + n * 2048), *(const PG8_LAS v4i_t*)(lds + PG8_SB(b, h) + boff + n * 2048 + 1024), 0, 1, 2, 3, 4, 5, 6, 7); } \
        else { _Pragma("unroll") for (int n = 0; n < 2; ++n) _Pragma("unroll") for (int k = 0; k < 2; ++k) dst[n][k] = *(const PG8_LAS bf16x8*)(lds + PG8_SB(b, h) + boff + n * 2048 + k * 1024); } } while (0)
#define PG8_MMA(ai, bj, At, Bt) do { __builtin_amdgcn_s_setprio(1); if constexpr (DT == 1) { _Pragma("unroll") for (int m = 0; m < 4; ++m) _Pragma("unroll") for (int n = 0; n < 2; ++n) \
        asm volatile("v_mfma_scale_f32_16x16x128_f8f6f4 %0, %1, %2, %0, %3, %3 op_sel_hi:[0,0,0]" : "+v"(acc[ai][bj][m][n]) : "v"(Bt##8[n]), "v"(At##8[m]), "v"(sc1)); } \
        else if constexpr (DT == 2) { _Pragma("unroll") for (int m = 0; m < 4; ++m) _Pragma("unroll") for (int n = 0; n < 2; ++n) _Pragma("unroll") for (int k = 0; k < 2; ++k) \
        asm volatile("v_mfma_i32_16x16x64_i8 %0, %1, %2, %0" : "+v"(acc[ai][bj][m][n]) : "v"(Bt[n][k]), "v"(At[m][k])); } \
        else { _Pragma("unroll") for (int m = 0; m < 4; ++m) _Pragma("unroll") for (int n = 0; n < 2; ++n) _Pragma("unroll") for (int k = 0; k < 2; ++k) \
        acc[ai][bj][m][n] = __builtin_amdgcn_mfma_f32_16x16x32_bf16(Bt[n][k], At[m][k], acc[ai][bj][m][n], 0, 0, 0); } __builtin_amdgcn_s_setprio(0); } while (0)
#define PG8_STAGE_A(bufoff, h, which) do { if constexpr (GATHER) { _Pragma("unroll") for (int _i = 0; _i < 2; ++_i) { \
            const unsigned _o = ((which) == 1) ? offC[h][_i] : (last ? offN[h][_i] : offC[h][_i]); const size_t _kb = ((which) == 1) ? (size_t)(t + 1) * kstep : ((last ? (size_t)0 : (size_t)(t + 2) * kstep) + ((which) == 3 ? kstep : 0)); \
            __builtin_amdgcn_global_load_lds((const unsigned*)((const char*)g.A + _kb + _o), (PG8_LAS unsigned*)(lds + (bufoff) + ldsw + _i * 8192), 16, 0, 0); } } \
        else { const char* _p = ((which) == 1 ? a1 : ((which) == 2 ? a2 : a3)) + (h) * hstep; PG8_STAGE(bufoff, _p, voffA); } } while (0)
#define PG8_WAIT_V(n) asm volatile("s_waitcnt vmcnt(" #n ")" ::: "memory")
#define PG8_WAIT_L(n) asm volatile("s_waitcnt lgkmcnt(" #n ")" ::: "memory")
#define PG8_BAR __builtin_amdgcn_s_barrier()
#define PG8_SCHED __builtin_amdgcn_sched_barrier(0)
    static_assert(!GATHER || SP2, "GATHER is written for the SP2 loop");
    Unit cur, nxt; int ui = 0;
    if (!S.next(0, cur)) return;
#define PG8_EPV(u, uidx) do { if constexpr (Epi::HAS_VEC) { int _te = tid; asm volatile("" : "+v"(_te)); if (wid < 2) __builtin_amdgcn_global_load_lds((const unsigned*)E.vec_src(u, _te), (PG8_LAS unsigned*)(lds + EPV_OFF + ((uidx) & 1) * 2048 + wid * 1024), 16, 0, 0); } } while (0)
    PG8_EPV(cur, 0);
    f32x4 acc[2][2][4][2];
#pragma unroll
    for (int a = 0; a < 2; ++a)
#pragma unroll
        for (int b = 0; b < 2; ++b)
#pragma unroll
            for (int m = 0; m < 4; ++m)
#pragma unroll
                for (int n = 0; n < 2; ++n) acc[a][b][m][n] = (f32x4){0.f, 0.f, 0.f, 0.f};
    bf16x8 At[4][2], B0[2][2], B1[2][2]; v8i_t At8[4], B08[2], B18[2];
    int sc1 = 0x7F7F7F7F; asm volatile("" : "+v"(sc1));
    const char* cA = GATHER ? (const char*)g.A : (const char*)g.A + (size_t)cur.pm * tstep; const char* cB = (const char*)g.Bt + (size_t)cur.e * estep + (size_t)cur.pn * tstep;
    if constexpr (GATHER) { PG8_GOFF(offC, 0); }
#define PG8_STAGE_A0(bufoff, h, kb) do { if constexpr (GATHER) { _Pragma("unroll") for (int _i = 0; _i < 2; ++_i) \
            __builtin_amdgcn_global_load_lds((const unsigned*)((const char*)g.A + (size_t)(kb) + offC[h][_i]), (PG8_LAS unsigned*)(lds + (bufoff) + ldsw + _i * 8192), 16, 0, 0); } \
        else PG8_STAGE(bufoff, cA + (h) * hstep + (kb), voffA); } while (0)
    if constexpr (SP2) {
        PG8_STAGE(PG8_SB(0, 0), cB, voffB); PG8_STAGE(PG8_SB(0, 1), cB + hstep, voffB); PG8_STAGE_A0(PG8_SA(0, 0), 0, 0); PG8_STAGE_A0(PG8_SA(0, 1), 1, 0);
        if (wr == 1) PG8_BAR;
        PG8_WAIT_V(2); PG8_BAR;
        PG8_STAGE(PG8_SB(1, 0), cB + kstep, voffB); PG8_STAGE_A0(PG8_SA(1, 0), 0, kstep); PG8_STAGE(PG8_SB(1, 1), cB + hstep + kstep, voffB);
        PG8_WAIT_V(6); PG8_BAR;
    } else {
        PG8_STAGE(PG8_SB(0, 0), cB, voffB); PG8_STAGE(PG8_SA(0, 0), cA, voffA); PG8_STAGE(PG8_SB(0, 1), cB + hstep, voffB); PG8_STAGE(PG8_SA(0, 1), cA + hstep, voffA);
        if (wr == 1) PG8_BAR;
        PG8_WAIT_V(4); PG8_BAR;
        PG8_STAGE(PG8_SB(1, 0), cB + kstep, voffB); PG8_STAGE(PG8_SA(1, 0), cA + kstep, voffA); PG8_STAGE(PG8_SB(1, 1), cB + hstep + kstep, voffB);
        PG8_WAIT_V(6); PG8_BAR;
    }
    for (;;) {
        const bool has_next = S.next(ui + 1, nxt);
        const char* nA = (has_next && !GATHER) ? (const char*)g.A + (size_t)nxt.pm * tstep : cA; const char* nB = has_next ? (const char*)g.Bt + (size_t)nxt.e * estep + (size_t)nxt.pn * tstep : cB;
        if constexpr (GATHER) { if (has_next) { PG8_GOFF(offN, ui + 1); } else {
#pragma unroll
            for (int _h = 0; _h < 2; ++_h) { offN[_h][0] = offC[_h][0]; offN[_h][1] = offC[_h][1]; } } }
#pragma unroll 1
        for (int t = 0; t < nt; t += 2) {
            const bool last = (t == nt - 2);
            const char* a1 = cA + (size_t)(t + 1) * kstep;
            const char* a2 = last ? nA : cA + (size_t)(t + 2) * kstep; const char* b2 = last ? nB : cB + (size_t)(t + 2) * kstep;
            const char* a3 = a2 + kstep; const char* b3 = b2 + kstep;
            if constexpr (SP2) {
            PG8_LDB(B0, 0, 0); PG8_LDB(B1, 0, 1); PG8_SCHED; PG8_LDA(At, 0, 0); PG8_STAGE_A(PG8_SA(1, 1), 1, 1);
            PG8_WAIT_V(8); PG8_WAIT_L(0); PG8_BAR; PG8_MMA(0, 0, At, B0); PG8_MMA(0, 1, At, B1); PG8_BAR; PG8_SCHED;
            PG8_LDA(At, 0, 1); PG8_STAGE(PG8_SB(0, 0), b2, voffB); PG8_STAGE(PG8_SB(0, 1), b2 + hstep, voffB); PG8_STAGE_A(PG8_SA(0, 0), 0, 2);
            PG8_WAIT_V(8); PG8_WAIT_L(0); PG8_BAR; PG8_MMA(1, 0, At, B0); PG8_MMA(1, 1, At, B1); PG8_BAR; PG8_SCHED;
            PG8_LDB(B0, 1, 0); PG8_LDB(B1, 1, 1); PG8_SCHED; PG8_LDA(At, 1, 0); PG8_STAGE_A(PG8_SA(0, 1), 1, 2);
            PG8_WAIT_V(8); PG8_WAIT_L(0); PG8_BAR; PG8_MMA(0, 0, At, B0); PG8_MMA(0, 1, At, B1); PG8_BAR; PG8_SCHED;
            PG8_LDA(At, 1, 1); PG8_STAGE(PG8_SB(1, 0), b3, voffB); PG8_STAGE(PG8_SB(1, 1), b3 + hstep, voffB); PG8_STAGE_A(PG8_SA(1, 0), 0, 3);
            PG8_WAIT_V(8); PG8_WAIT_L(0); PG8_BAR; PG8_MMA(1, 0, At, B0); PG8_MMA(1, 1, At, B1); PG8_BAR; PG8_SCHED;
            } else {
            PG8_LDB(B0, 0, 0); PG8_SCHED; PG8_LDA(At, 0, 0); PG8_STAGE(PG8_SA(1, 1), a1 + hstep, voffA);
            PG8_WAIT_L(8); PG8_BAR; PG8_WAIT_L(0); PG8_MMA(0, 0, At, B0); PG8_BAR; PG8_SCHED;
            PG8_LDB(B1, 0, 1); PG8_STAGE(PG8_SB(0, 0), b2, voffB);
            PG8_BAR; PG8_WAIT_L(0); PG8_MMA(0, 1, At, B1); PG8_BAR;
            PG8_LDA(At, 0, 1); PG8_STAGE(PG8_SA(0, 0), a2, voffA);
            PG8_BAR; PG8_WAIT_L(0); PG8_MMA(1, 0, At, B0); PG8_BAR; PG8_SCHED;
            PG8_STAGE(PG8_SB(0, 1), b2 + hstep, voffB);
            PG8_WAIT_V(6); PG8_BAR; PG8_MMA(1, 1, At, B1); PG8_BAR;
            PG8_LDB(B0, 1, 0); PG8_SCHED; PG8_LDA(At, 1, 0); PG8_STAGE(PG8_SA(0, 1), a2 + hstep, voffA);
            PG8_WAIT_L(8); PG8_BAR; PG8_WAIT_L(0); PG8_MMA(0, 0, At, B0); PG8_BAR; PG8_SCHED;
            PG8_LDB(B1, 1, 1); PG8_STAGE(PG8_SB(1, 0), b3, voffB);
            PG8_BAR; PG8_WAIT_L(0); PG8_MMA(0, 1, At, B1); PG8_BAR;
            PG8_LDA(At, 1, 1); PG8_STAGE(PG8_SA(1, 0), a3, voffA);
            PG8_BAR; PG8_WAIT_L(0); PG8_MMA(1, 0, At, B0); PG8_BAR; PG8_SCHED;
            PG8_STAGE(PG8_SB(1, 1), b3 + hstep, voffB);
            PG8_WAIT_V(6); PG8_BAR; PG8_MMA(1, 1, At, B1); PG8_BAR;
            }
        }
        if constexpr (DT != 0) asm volatile("s_nop 15\n\ts_nop 15\n\ts_nop 7" ::: "memory");
        if constexpr (ALIGN_EPI) { if (wr == 0) PG8_BAR; }
        E(acc, cur, wr, wc, fr, fq, (const PG8_LAS float*)(lds + EPV_OFF + (ui & 1) * 2048));
        if (!has_next) break;
#pragma unroll
        for (int a = 0; a < 2; ++a)
#pragma unroll
            for (int b = 0; b < 2; ++b)
#pragma unroll
                for (int m = 0; m < 4; ++m)
#pragma unroll
                    for (int n = 0; n < 2; ++n) acc[a][b][m][n] = (f32x4){0.f, 0.f, 0.f, 0.f};
        cur = nxt; cA = nA; cB = nB; ++ui;
        PG8_EPV(cur, ui);
        if constexpr (GATHER) {
#pragma unroll
            for (int _h = 0; _h < 2; ++_h) { offC[_h][0] = offN[_h][0]; offC[_h][1] = offN[_h][1]; } }
        if constexpr (ALIGN_EPI) { if (wr == 1) PG8_BAR; }
    }
    PG8_WAIT_V(0);
    if constexpr (!ALIGN_EPI) { if (wr == 0) PG8_BAR; }
    PG8_BAR;
#undef PG8_SA
#undef PG8_SB
#undef PG8_STAGE
#undef PG8_EPV
#undef PG8_STAGE_A
#undef PG8_STAGE_A0
#undef PG8_GOFF
#undef PG8_LDA
#undef PG8_LDB
#undef PG8_MMA
#undef PG8_WAIT_V
#undef PG8_WAIT_L
#undef PG8_BAR
#undef PG8_SCHED
}
}

constexpr size_t MiB = 1u << 20;
constexpr size_t WS_CTL = 0, CTL_ZERO_BYTES = 1 * MiB;
constexpr size_t WS_ASG_E = 1 * MiB, WS_ASG_SLOT = WS_ASG_E + (size_t)NASG * 4, WS_ASG_G = WS_ASG_SLOT + (size_t)NASG * 4, WS_ASG_ROW = WS_ASG_G + (size_t)NASG * 4;
constexpr size_t WS_WRT = 3 * MiB;
constexpr size_t WS_SUP = WS_WRT + 64 * 1024, WS_SDN = WS_SUP + 32 * 2048 * 4;
constexpr size_t WS_ROWTOK = WS_SDN + 32 * 1024 * 4;
constexpr size_t WS_WPA = 4 * MiB, WS_WPB = 5 * MiB, WS_WOUT = 7 * MiB, WS_WIN = 9 * MiB;
constexpr size_t WS_WUP = 29 * MiB, WS_WDN = 93 * MiB;
constexpr size_t WS_XN = 125 * MiB;
constexpr size_t WS_GSTATE = WS_XN, WS_GDEC = WS_XN + 32 * MiB;
constexpr size_t WS_SX = WS_XN + 40 * MiB, WS_SWIN = WS_XN + 41 * MiB;
constexpr size_t WS_OA = 189 * MiB, WS_OB = 221 * MiB;
constexpr size_t WS_H1 = WS_OA;
constexpr size_t WS_HN = WS_OB + 32 * MiB;
constexpr size_t WS_PROJ = 285 * MiB;
constexpr size_t WS_ACT = WS_PROJ, WS_YB = WS_PROJ + 136 * MiB;
constexpr size_t WS_PS = WS_PROJ + 300 * MiB;
constexpr size_t WS_END = 925 * MiB;
static_assert(WS_ROWTOK + (size_t)MAXTILES * 256 * 4 <= WS_WPA && WS_PROJ + (size_t)T * NP * 2 == WS_END && WS_YB + (size_t)MAXTILES * 256 * D * 2 <= WS_END && (size_t)MAXTILES * 256 * D <= 136 * MiB, "d_ws map");
constexpr size_t OUT_OG = 0, OUT_LSE = 96 * MiB;
constexpr int CW_BAR = 4096, CW_CNT = 32768;
constexpr int RING_BYTES = 131072, MISC_OFF = RING_BYTES, TBL_OFF = RING_BYTES + 512, LDS_BYTES = 147456;

#define XB_TMO      128
#define XB_XCNT(j)  (256  + 64 * (j))
#define XB_XSUB(j)  (1280 + 64 * (j))
#define XB_XGEN(j)  (2304 + 64 * (j))
#define XB_TOP      3328
#define XB_TOPGEN   3392
#define XCD_BAR_WORDS 3456
#define XB_SPIN_CAP (1u << 18)
__device__ __forceinline__ unsigned xb_ld(unsigned* p)              { return __hip_atomic_load(p, __ATOMIC_RELAXED, __HIP_MEMORY_SCOPE_AGENT); }
__device__ __forceinline__ unsigned xb_add(unsigned* p, unsigned v) { return __hip_atomic_fetch_add(p, v, __ATOMIC_RELAXED, __HIP_MEMORY_SCOPE_AGENT); }
__device__ __forceinline__ unsigned xb_xcc_id() { return (unsigned)__builtin_amdgcn_s_getreg((3 << 11) | 20) & 0xFu; }
#define XB_SPIN(cond, bar) do { unsigned _sp = 0; while (cond) { __builtin_amdgcn_s_sleep(1); \
    if ((++_sp & 255u) == 0u) { if (xb_ld(&(bar)[XB_TMO])) break; if (_sp > XB_SPIN_CAP) { atomicAdd(&(bar)[XB_TMO], 1u); break; } } } } while (0)
struct XcdBarrier { unsigned* bar; unsigned x; volatile LAS unsigned* st; };
__device__ __forceinline__ XcdBarrier xcd_barrier_post(unsigned* bar, volatile LAS unsigned* st) {
    XcdBarrier b; b.bar = bar; b.x = xb_xcc_id(); b.st = st;
    if (threadIdx.x == 0) (void)xb_add(&bar[XB_XCNT(b.x)], 1u);
    return b;
}
__device__ __forceinline__ void xcd_barrier_complete(unsigned* bar, unsigned x, unsigned& nloc, unsigned& nx) {
    const unsigned G = gridDim.x * gridDim.y * gridDim.z;
    unsigned sum, cnt, mine, sp = 0u;
    for (;;) {
        sum = 0u; cnt = 0u; mine = 0u;
#pragma unroll
        for (unsigned j = 0; j < 16; ++j) { const unsigned c = xb_ld(&bar[XB_XCNT(j)]); sum += c; cnt += (c > 0u) ? 1u : 0u; mine = (j == x) ? c : mine; }
        if (sum == G) break;
        __builtin_amdgcn_s_sleep(1);
        if ((++sp & 255u) == 0u) { if (xb_ld(&bar[XB_TMO])) break; if (sp > XB_SPIN_CAP) { atomicAdd(&bar[XB_TMO], 1u); break; } }
    }
    nloc = mine > 0u ? mine : 1u; nx = cnt > 0u ? cnt : 1u;
}
__device__ __forceinline__ void xcd_barrier(const XcdBarrier& b) {
    asm volatile("s_waitcnt vmcnt(0)" ::: "memory");
    __syncthreads();
    if (threadIdx.x == 0) {
        unsigned* bar = b.bar;
        __builtin_amdgcn_s_waitcnt(0);
        unsigned nloc = b.st[0], nx = b.st[1];
        if (nloc == 0u) { xcd_barrier_complete(bar, b.x, nloc, nx); b.st[0] = nloc; b.st[1] = nx; }
        const unsigned old = xb_add(&bar[XB_XSUB(b.x)], 1u);
        const unsigned gen = old / nloc;
        if (old + 1u == (gen + 1u) * nloc) {
            __builtin_amdgcn_fence(__ATOMIC_RELEASE, "agent");
            asm volatile("s_waitcnt vmcnt(0)" ::: "memory");
            const unsigned og = xb_add(&bar[XB_TOP], 1u);
            const unsigned tg = og / nx;
            if (og + 1u == (tg + 1u) * nx) xb_add(&bar[XB_TOPGEN], 1u);
            else XB_SPIN(xb_ld(&bar[XB_TOPGEN]) == tg, bar);
            __builtin_amdgcn_fence(__ATOMIC_ACQUIRE, "agent");
            xb_add(&bar[XB_XGEN(b.x)], 1u);
            asm volatile("s_waitcnt vmcnt(0)" ::: "memory");
        } else {
            XB_SPIN(xb_ld(&bar[XB_XGEN(b.x)]) == gen, bar);
            __builtin_amdgcn_fence(__ATOMIC_ACQUIRE, "agent");
            asm volatile("s_waitcnt vmcnt(0)" ::: "memory");
        }
    }
    __syncthreads();
}

DI float wave_sum(float v) {
#pragma unroll
    for (int o = 1; o < 64; o <<= 1) v += __shfl_xor(v, o);
    return v;
}
DI unsigned offb(unsigned row, unsigned ch) { return 256u * row + 16u * (ch ^ (((row & 3u) << 2) | ((row >> 2) & 3u))); }
DI s16x4 vtr(const LAS unsigned char* p) { return __builtin_bit_cast(s16x4, __builtin_amdgcn_ds_read_tr16_b64_v4i16((LAS v4i16_t*)p)); }
DI s16x4 tr4(const LAS unsigned char* img, int rowbase, int c, int lane) { const int q = (lane & 15) >> 2, p = lane & 3; return vtr(img + offb((unsigned)(rowbase + q), (unsigned)(2 * c + (p >> 1))) + 8 * (p & 1)); }

struct Ptrs {
    const float *x, *ln1, *w_in, *w_gk2, *b_gk2, *gnorm, *wpa, *wpb, *wout, *ln2, *wr, *br, *wup, *bup, *wdn, *bdn, *lnf;
    float* out; unsigned char* ws; gu32* ctl;
};

DI void p0_tile(const float* W, int ldw, int k0, int sc0, bf16* WT, int K, int dr0, LAS float* scr, int lane) {
#pragma unroll 8
    for (int i = 0; i < 32; ++i) { const int kk = 2 * i + (lane >> 5); scr[kk * 33 + (lane & 31)] = W[(size_t)(k0 + kk) * ldw + sc0 + (lane & 31)]; }
    LDS_WAIT(); asm volatile("" ::: "memory");
    const int c = lane & 7;
#pragma unroll
    for (int j = 0; j < 4; ++j) { const int n = (lane >> 3) + 8 * j; const LAS float* s = scr + (8 * c) * 33 + n;
        u32x4 o; o.x = pk2(s[0 * 33], s[1 * 33]); o.y = pk2(s[2 * 33], s[3 * 33]); o.z = pk2(s[4 * 33], s[5 * 33]); o.w = pk2(s[6 * 33], s[7 * 33]);
        *(u32x4*)(WT + (size_t)(dr0 + n) * K + k0 + 8 * c) = o; }
    LDS_WAIT(); asm volatile("" ::: "memory");
}
DI void rms_row_to_bf16(const float* xrow, const float* w, bf16* orow, int lane) {
    const f32x4* xr = (const f32x4*)xrow + lane; const f32x4* wr = (const f32x4*)w + lane;
    f32x4 v[4]; float s = 0.f;
#pragma unroll
    for (int j = 0; j < 4; ++j) { v[j] = xr[64 * j]; s += (v[j].x * v[j].x + v[j].y * v[j].y) + (v[j].z * v[j].z + v[j].w * v[j].w); }
    const float rstd = 1.f / sqrtf(wave_sum(s) * (1.f / D) + RMS_EPS);
    u32x2* o8 = (u32x2*)orow + lane;
#pragma unroll
    for (int j = 0; j < 4; ++j) { const f32x4 ww = wr[64 * j]; u32x2 o; o.x = pk2(v[j].x * rstd * ww.x, v[j].y * rstd * ww.y); o.y = pk2(v[j].z * rstd * ww.z, v[j].w * rstd * ww.w); o8[64 * j] = o; }
}
constexpr int PMAX_OFF = 131072 + 1024;
struct QItem { const float* W; int ldw, sc0, dr0; unsigned char* W8; float* sc; };
DI QItem p0_qitem(const Ptrs& P, int it) { QItem q;
    if (it < 32 * 64) { const int e = it >> 6, nb = it & 63, c0 = 32 * nb; q.W = P.wup + (size_t)e * 1024 * 2048; q.ldw = 2048; q.sc0 = c0;
        q.dr0 = (c0 < 1024) ? 256 * (c0 >> 7) + (c0 & 127) : 256 * ((c0 - 1024) >> 7) + 128 + (c0 & 127); q.W8 = P.ws + WS_WUP + (size_t)e * 2048 * 1024; q.sc = (float*)(P.ws + WS_SUP) + e * 2048; }
    else { const int r = it - 32 * 64, e = r >> 5, nb = r & 31; q.W = P.wdn + (size_t)e * 1024 * 1024; q.ldw = 1024; q.sc0 = 32 * nb; q.dr0 = 32 * nb; q.W8 = P.ws + WS_WDN + (size_t)e * 1024 * 1024; q.sc = (float*)(P.ws + WS_SDN) + e * 1024; }
    return q; }
DI void p0_qload(f32x4 (&v)[16], const QItem& q, int w, int lane) {
#pragma unroll
    for (int i = 0; i < 16; ++i) v[i] = *(const f32x4*)(q.W + (size_t)(128 * w + 8 * i + (lane >> 3)) * q.ldw + q.sc0 + 4 * (lane & 7));
}
DI void p0_quant_all(const Ptrs& P, LAS unsigned char* lds, int vcu, int G, int tid, int j0, int j1) {
    const int lane = tid & 63, w = tid >> 6; LAS float* scr = (LAS float*)(lds + w * 16384); LAS float* PM = (LAS float*)(lds + PMAX_OFF);
    constexpr int NQ = 32 * 64 + 32 * 32; const int NQE = (vcu + (long)j1 * G < NQ) ? vcu + j1 * G : NQ;
    f32x4 v[16]; int it = vcu + j0 * G;
    if (it < NQE) p0_qload(v, p0_qitem(P, it), w, lane);
#pragma unroll 1
    for (; it < NQE; it += G) { const QItem q = p0_qitem(P, it);
        { const int ng8 = lane & 7, rsub = lane >> 3; f32x4 mx = {0.f, 0.f, 0.f, 0.f};
#pragma unroll
          for (int i = 0; i < 16; ++i) { const int kk = 8 * i + rsub; *(LAS f32x4*)(scr + kk * 32 + 4 * ((ng8 + (kk >> 4)) & 7)) = v[i];
              mx.x = fmaxf(mx.x, fabsf(v[i].x)); mx.y = fmaxf(mx.y, fabsf(v[i].y)); mx.z = fmaxf(mx.z, fabsf(v[i].z)); mx.w = fmaxf(mx.w, fabsf(v[i].w)); }
#pragma unroll
          for (int o = 8; o < 64; o <<= 1) { mx.x = fmaxf(mx.x, __shfl_xor(mx.x, o)); mx.y = fmaxf(mx.y, __shfl_xor(mx.y, o)); mx.z = fmaxf(mx.z, __shfl_xor(mx.z, o)); mx.w = fmaxf(mx.w, __shfl_xor(mx.w, o)); }
          if (lane < 8) *(LAS f32x4*)(PM + w * 32 + 4 * lane) = mx; }
        __syncthreads();
        if (it + G < NQE) p0_qload(v, p0_qitem(P, it + G), w, lane);
        { const int c = lane & 7, ng = lane >> 3; f32x4 am = {0.f, 0.f, 0.f, 0.f};
#pragma unroll
          for (int w2 = 0; w2 < 8; ++w2) { const f32x4 t = *(const LAS f32x4*)(PM + w2 * 32 + 4 * ng); am.x = fmaxf(am.x, t.x); am.y = fmaxf(am.y, t.y); am.z = fmaxf(am.z, t.z); am.w = fmaxf(am.w, t.w); }
          float sc[4], inv[4];
#pragma unroll
          for (int j = 0; j < 4; ++j) { const float a = am[j]; const int ex = (int)((__float_as_uint(a) >> 23) & 0xffu) - 127;
              sc[j] = (a > 0.f) ? __uint_as_float((unsigned)(127 + 7 - ex) << 23) : 1.0f; inv[j] = (a > 0.f) ? __uint_as_float((unsigned)(127 - 7 + ex) << 23) : 1.0f; }
          if (w == 0 && c == 0) *(f32x4*)(q.sc + q.dr0 + 4 * ng) = (f32x4){inv[0], inv[1], inv[2], inv[3]};
          f32x4 x[16];
#pragma unroll
          for (int i = 0; i < 16; ++i) x[i] = *(const LAS f32x4*)(scr + (16 * c + i) * 32 + 4 * ((ng + c) & 7));
#pragma unroll
          for (int j = 0; j < 4; ++j) { int o[4];
#pragma unroll
              for (int qq = 0; qq < 4; ++qq) { int t = 0; t = __builtin_amdgcn_cvt_pk_fp8_f32(x[4 * qq][j] * sc[j], x[4 * qq + 1][j] * sc[j], t, false); t = __builtin_amdgcn_cvt_pk_fp8_f32(x[4 * qq + 2][j] * sc[j], x[4 * qq + 3][j] * sc[j], t, true); o[qq] = t; }
              u32x4 ov; ov.x = (unsigned)o[0]; ov.y = (unsigned)o[1]; ov.z = (unsigned)o[2]; ov.w = (unsigned)o[3];
              *(u32x4*)(q.W8 + (size_t)(q.dr0 + 4 * ng + j) * 1024 + 128 * w + 16 * c) = ov; } }
        __syncthreads(); }
}
DI void p0_quant_win(const Ptrs& P, LAS unsigned char* lds, int vcu, int G, int tid) {
    const int lane = tid & 63, w = tid >> 6; LAS float* scr = (LAS float*)(lds + w * 16384); LAS float* PM = (LAS float*)(lds + PMAX_OFF);
    signed char* W8 = (signed char*)(P.ws + WS_WIN); float* SW = (float*)(P.ws + WS_SWIN);
    constexpr int NQ = 320;
#pragma unroll 1
    for (int it = vcu; it < NQ; it += G) { const int dr0 = (it < 240) ? 32 * it : ((it < 304) ? C_MA + 32 * (it - 240) : C_GF + 32 * (it - 304));
        const int ng8 = lane & 7, rsub = lane >> 3; f32x4 mx = {0.f, 0.f, 0.f, 0.f};
        if (it < 304) { const int sc0 = (it < 240) ? 32 * it : 7696 + 32 * (it - 240); f32x4 v[16];
#pragma unroll
            for (int i = 0; i < 16; ++i) v[i] = *(const f32x4*)(P.w_in + (size_t)(128 * w + 8 * i + rsub) * IN_W + sc0 + 4 * ng8);
#pragma unroll
            for (int i = 0; i < 16; ++i) { const int kk = 8 * i + rsub; *(LAS f32x4*)(scr + kk * 32 + 4 * ((ng8 + (kk >> 4)) & 7)) = v[i];
                mx.x = fmaxf(mx.x, fabsf(v[i].x)); mx.y = fmaxf(mx.y, fabsf(v[i].y)); mx.z = fmaxf(mx.z, fabsf(v[i].z)); mx.w = fmaxf(mx.w, fabsf(v[i].w)); } }
        else { const int j0 = 32 * (it - 304) + 4 * ng8; f32x4 w2[16];
#pragma unroll
            for (int r = 0; r < 16; ++r) w2[r] = *(const f32x4*)(P.w_gk2 + r * 512 + j0);
#pragma unroll 2
            for (int i = 0; i < 16; ++i) { const int kk = 8 * i + rsub; const f32x4* src = (const f32x4*)(P.w_in + (size_t)(128 * w + kk) * IN_W + 7680); f32x4 a = {0.f, 0.f, 0.f, 0.f};
#pragma unroll
                for (int q = 0; q < 4; ++q) { const f32x4 t = src[q]; a = a + w2[4 * q] * t.x + w2[4 * q + 1] * t.y + w2[4 * q + 2] * t.z + w2[4 * q + 3] * t.w; }
                *(LAS f32x4*)(scr + kk * 32 + 4 * ((ng8 + (kk >> 4)) & 7)) = a;
                mx.x = fmaxf(mx.x, fabsf(a.x)); mx.y = fmaxf(mx.y, fabsf(a.y)); mx.z = fmaxf(mx.z, fabsf(a.z)); mx.w = fmaxf(mx.w, fabsf(a.w)); } }
#pragma unroll
        for (int o = 8; o < 64; o <<= 1) { mx.x = fmaxf(mx.x, __shfl_xor(mx.x, o)); mx.y = fmaxf(mx.y, __shfl_xor(mx.y, o)); mx.z = fmaxf(mx.z, __shfl_xor(mx.z, o)); mx.w = fmaxf(mx.w, __shfl_xor(mx.w, o)); }
        if (lane < 8) *(LAS f32x4*)(PM + w * 32 + 4 * lane) = mx;
        __syncthreads();
        { const int c = lane & 7, ng = lane >> 3; f32x4 am = {0.f, 0.f, 0.f, 0.f};
#pragma unroll
          for (int w2 = 0; w2 < 8; ++w2) { const f32x4 t = *(const LAS f32x4*)(PM + w2 * 32 + 4 * ng); am.x = fmaxf(am.x, t.x); am.y = fmaxf(am.y, t.y); am.z = fmaxf(am.z, t.z); am.w = fmaxf(am.w, t.w); }
          float sc[4], inv[4];
#pragma unroll
          for (int j = 0; j < 4; ++j) { sc[j] = (am[j] > 0.f) ? 127.0f / am[j] : 1.0f; inv[j] = (am[j] > 0.f) ? am[j] * (1.0f / 127.0f) : 1.0f; }
          if (w == 0 && c == 0) *(f32x4*)(SW + dr0 + 4 * ng) = (f32x4){inv[0], inv[1], inv[2], inv[3]};
          f32x4 x[16];
#pragma unroll
          for (int i = 0; i < 16; ++i) x[i] = *(const LAS f32x4*)(scr + (16 * c + i) * 32 + 4 * ((ng + c) & 7));
#pragma unroll
          for (int j = 0; j < 4; ++j) { unsigned o[4];
#pragma unroll
              for (int qq = 0; qq < 4; ++qq) { unsigned t = 0u;
#pragma unroll
                  for (int e = 0; e < 4; ++e) t |= ((unsigned)(int)rintf(x[4 * qq + e][j] * sc[j]) & 0xffu) << (8 * e);
                  o[qq] = t; }
              u32x4 ov; ov.x = o[0]; ov.y = o[1]; ov.z = o[2]; ov.w = o[3];
              *(u32x4*)(W8 + (size_t)(dr0 + 4 * ng + j) * 1024 + 128 * w + 16 * c) = ov; } }
        __syncthreads(); }
}
template <int NR> DI void rms_rows_to_i8(const float* x0, const float* w, signed char* o0, float* sx0, int lane) {
    const f32x4* xr = (const f32x4*)x0 + lane; const f32x4* wr = (const f32x4*)w + lane;
    f32x4 v[NR][4], wv[4]; float ss[NR], mx[NR];
#pragma unroll
    for (int j = 0; j < 4; ++j) wv[j] = wr[64 * j];
#pragma unroll
    for (int q = 0; q < NR; ++q)
#pragma unroll
        for (int j = 0; j < 4; ++j) v[q][j] = xr[256 * q + 64 * j];
#pragma unroll
    for (int q = 0; q < NR; ++q) { float s = 0.f;
#pragma unroll
        for (int j = 0; j < 4; ++j) s += (v[q][j].x * v[q][j].x + v[q][j].y * v[q][j].y) + (v[q][j].z * v[q][j].z + v[q][j].w * v[q][j].w);
        ss[q] = s; }
#pragma unroll
    for (int o = 1; o < 64; o <<= 1)
#pragma unroll
        for (int q = 0; q < NR; ++q) ss[q] += __shfl_xor(ss[q], o);
#pragma unroll
    for (int q = 0; q < NR; ++q) { const float r = 1.f / sqrtf(ss[q] * (1.f / D) + RMS_EPS); float m = 0.f;
#pragma unroll
        for (int j = 0; j < 4; ++j) { v[q][j] = v[q][j] * r * wv[j]; m = fmaxf(m, fmaxf(fmaxf(fabsf(v[q][j].x), fabsf(v[q][j].y)), fmaxf(fabsf(v[q][j].z), fabsf(v[q][j].w)))); }
        mx[q] = m; }
#pragma unroll
    for (int o = 1; o < 64; o <<= 1)
#pragma unroll
        for (int q = 0; q < NR; ++q) mx[q] = fmaxf(mx[q], __shfl_xor(mx[q], o));
#pragma unroll
    for (int q = 0; q < NR; ++q) { const float qa = (mx[q] > 0.f) ? 127.0f / mx[q] : 1.0f; if (lane == 0) sx0[q] = (mx[q] > 0.f) ? mx[q] * (1.0f / 127.0f) : 1.0f;
        unsigned* o4 = (unsigned*)o0 + 256 * q + lane;
#pragma unroll
        for (int j = 0; j < 4; ++j) o4[64 * j] = ((unsigned)(int)rintf(v[q][j].x * qa) & 0xffu) | (((unsigned)(int)rintf(v[q][j].y * qa) & 0xffu) << 8) | (((unsigned)(int)rintf(v[q][j].z * qa) & 0xffu) << 16) | (((unsigned)(int)rintf(v[q][j].w * qa) & 0xffu) << 24); }
}
DI void rms_rows2_to_bf16(const float* x0, const float* w, bf16* o0, int lane) {
    const f32x4* xr = (const f32x4*)x0 + lane; const f32x4* wr = (const f32x4*)w + lane;
    f32x4 va[4], vb[4], wv[4]; float sa = 0.f, sb = 0.f;
#pragma unroll
    for (int j = 0; j < 4; ++j) { va[j] = xr[64 * j]; vb[j] = xr[256 + 64 * j]; wv[j] = wr[64 * j]; }
#pragma unroll
    for (int j = 0; j < 4; ++j) { sa += (va[j].x * va[j].x + va[j].y * va[j].y) + (va[j].z * va[j].z + va[j].w * va[j].w); sb += (vb[j].x * vb[j].x + vb[j].y * vb[j].y) + (vb[j].z * vb[j].z + vb[j].w * vb[j].w); }
    const float ra = 1.f / sqrtf(wave_sum(sa) * (1.f / D) + RMS_EPS), rb = 1.f / sqrtf(wave_sum(sb) * (1.f / D) + RMS_EPS);
    u32x2* o8 = (u32x2*)o0 + lane;
#pragma unroll
    for (int j = 0; j < 4; ++j) { const f32x4 ww = wv[j]; u32x2 oa, ob; oa.x = pk2(va[j].x * ra * ww.x, va[j].y * ra * ww.y); oa.y = pk2(va[j].z * ra * ww.z, va[j].w * ra * ww.w);
        ob.x = pk2(vb[j].x * rb * ww.x, vb[j].y * rb * ww.y); ob.y = pk2(vb[j].z * rb * ww.z, vb[j].w * rb * ww.w); o8[64 * j] = oa; o8[256 + 64 * j] = ob; }
}
DI void p0_prologue(const Ptrs& P, LAS unsigned char* lds, int vcu, int G, int tid) {
    const int lane = tid & 63, wave = tid >> 6;
    LAS float* scr = (LAS float*)(lds + wave * 16384);
    const int gw = vcu * 8 + wave, NGW = G * 8;
    bf16* WIN_T = (bf16*)(P.ws + WS_WIN); bf16* WPA_T = (bf16*)(P.ws + WS_WPA); bf16* WPB_T = (bf16*)(P.ws + WS_WPB); bf16* WOUT_T = (bf16*)(P.ws + WS_WOUT);
    bf16* WRT = (bf16*)(P.ws + WS_WRT); unsigned char* WUP8 = P.ws + WS_WUP; unsigned char* WDN8 = P.ws + WS_WDN; bf16* XN = (bf16*)(P.ws + WS_XN);
#if BRINGUP != 1
    p0_quant_win(P, lds, vcu, G, tid);
    constexpr int I_PA = 8 * 32, I_PB = 16 * 32, I_OUT = 16 * 32, I_R = 16;
    constexpr int NITEMS = I_PA + I_PB + I_OUT + I_R;
    for (int it = gw; it < NITEMS; it += NGW) {
        int r = it;
        if (r < I_PA) { const int kb = r >> 5, nb = r & 31; p0_tile(P.wpa, 1024, 64 * kb, 32 * nb, WPA_T, 512, 32 * nb, scr, lane); continue; } r -= I_PA;
        if (r < I_PB) { const int kb = r >> 5, nb = r & 31; p0_tile(P.wpb, 1024, 64 * kb, 32 * nb, WPB_T, 1024, 32 * nb, scr, lane); continue; } r -= I_PB;
        if (r < I_OUT) { const int kb = r >> 5, nb = r & 31; p0_tile(P.wout, 1024, 64 * kb, 32 * nb, WOUT_T, 1024, 32 * nb, scr, lane); continue; } r -= I_OUT;
        p0_tile(P.wr, 32, 64 * r, 0, WRT, 1024, 0, scr, lane);
    }
    for (int m = gw * 4; m < T; m += NGW * 4) rms_rows_to_i8<4>(P.x + (size_t)m * D, P.ln1, (signed char*)(P.ws + WS_XN) + (size_t)m * D, (float*)(P.ws + WS_SX) + m, lane);
#endif
}

constexpr size_t PLANE = (size_t)T * 128;
DI bf16* proj_plane(unsigned char* ws, int cb) { return (bf16*)(ws + WS_PROJ) + (size_t)cb * PLANE; }

DI void attn_task(unsigned char* ws, bf16* OG, float* LSE, LAS unsigned char* lds, int task, int tid0) {
    int tid = tid0; const int w = __builtin_amdgcn_readfirstlane(tid0 >> 6); int lane = tid & 63, i = lane & 15, g4 = lane >> 4;
    const int grp = task >> 8, idx = task & 255, b = idx >> 7, h = (idx >> 5) & 3, q5 = idx & 31;
    const int dsh = 2 * grp, d = 1 << dsh, rsh = 5 - dsh, r = q5 >> rsh, n0 = 4 * (q5 & ((1 << rsh) - 1)), Lsub = SEQ >> dsh;
    const unsigned char* Qp = (const unsigned char*)ws + WS_PROJ + (size_t)(12 * grp + h) * PLANE * 2 + ((size_t)b * SEQ + (size_t)r * Lsub) * 128;
#define ATT_Q8(dst, ptr) do { const u32x2 _q = *(const u32x2*)(ptr); const f32x2 _a = __builtin_amdgcn_cvt_pk_f32_fp8((int)_q.x, false), _b = __builtin_amdgcn_cvt_pk_f32_fp8((int)_q.x, true), _c = __builtin_amdgcn_cvt_pk_f32_fp8((int)_q.y, false), _d = __builtin_amdgcn_cvt_pk_f32_fp8((int)_q.y, true); \
        u32x4 _w; _w.x = pk2(_a.x, _a.y); _w.y = pk2(_b.x, _b.y); _w.z = pk2(_c.x, _c.y); _w.w = pk2(_d.x, _d.y); dst = __builtin_bit_cast(bf16x8, _w); } while (0)
    const unsigned char* Kp = (const unsigned char*)ws + WS_PROJ + (size_t)(12 * grp + 4 + h) * PLANE * 2 + ((size_t)b * SEQ + (size_t)r * Lsub) * 128;
    const unsigned char* Vp = (const unsigned char*)ws + WS_PROJ + (size_t)(12 * grp + 8 + h) * PLANE * 2 + ((size_t)b * SEQ + (size_t)r * Lsub) * 128;
    LAS unsigned char* KL = lds; LAS unsigned char* VL = lds + 65536;
    u32x4 pk[2], pv[2]; bf16x8 qf[4], nq[4];
#define ATT_PUT8(img, v8, id_) do { const int _row = (id_) >> 3, _c = (id_) & 7; const unsigned _w[4] = {(v8).x, (v8).y, (v8).z, (v8).w}; unsigned _o[8]; \
        _Pragma("unroll") for (int _q = 0; _q < 4; ++_q) { const f32x2 _lo = __builtin_amdgcn_cvt_pk_f32_fp8((int)_w[_q], false), _hi = __builtin_amdgcn_cvt_pk_f32_fp8((int)_w[_q], true); _o[2 * _q] = pk2(_lo.x, _lo.y); _o[2 * _q + 1] = pk2(_hi.x, _hi.y); } \
        *(LAS u32x4*)((img) + offb(_row, 2 * _c)) = (u32x4){_o[0], _o[1], _o[2], _o[3]}; *(LAS u32x4*)((img) + offb(_row, 2 * _c + 1)) = (u32x4){_o[4], _o[5], _o[6], _o[7]}; } while (0)
#pragma unroll
    for (int ii = 0; ii < 2; ++ii) { const int id = tid + 512 * ii; const int s0 = (n0 - 1) & 1, s1 = n0 & 1;
        u32x4 k0 = {0u, 0u, 0u, 0u}, v0 = {0u, 0u, 0u, 0u};
        if (n0 > 0) { k0 = *(const u32x4*)(Kp + (size_t)(n0 - 1) * 16384 + id * 16); v0 = *(const u32x4*)(Vp + (size_t)(n0 - 1) * 16384 + id * 16); }
        const u32x4 k1 = *(const u32x4*)(Kp + (size_t)n0 * 16384 + id * 16), v1 = *(const u32x4*)(Vp + (size_t)n0 * 16384 + id * 16);
        ATT_PUT8(KL + s0 * 32768, k0, id); ATT_PUT8(VL + s0 * 32768, v0, id); ATT_PUT8(KL + s1 * 32768, k1, id); ATT_PUT8(VL + s1 * 32768, v1, id); }
#pragma unroll
    for (int ks = 0; ks < 4; ++ks) ATT_Q8(qf[ks], Qp + (size_t)(n0 * 128 + 16 * w + i) * 128 + 32 * ks + 8 * g4);
    __syncthreads();
    const int kt0 = (w == 0) ? 0 : w - 1;
#pragma unroll 1
    for (int u = 0; u < 4; ++u) { const int n = n0 + u;
        asm volatile("" : "+v"(tid)); lane = tid & 63; i = lane & 15; g4 = lane >> 4;
        if (u < 3) {
#pragma unroll
            for (int ii = 0; ii < 2; ++ii) { const int id = tid + 512 * ii; pk[ii] = *(const u32x4*)(Kp + (size_t)(n + 1) * 16384 + id * 16); pv[ii] = *(const u32x4*)(Vp + (size_t)(n + 1) * 16384 + id * 16); }
        }
        f32x4 st[10];
#pragma unroll
        for (int tt = 0; tt < 10; ++tt) st[tt] = (f32x4){0.f, 0.f, 0.f, 0.f};
#pragma unroll
        for (int ks = 0; ks < 4; ++ks)
#pragma unroll
            for (int hb = 0; hb < 2; ++hb) { bf16x8 kf[5];
#pragma unroll
                for (int t5 = 0; t5 < 5; ++t5) { const int kt = kt0 + 5 * hb + t5; kf[t5] = *(const LAS bf16x8*)(KL + ((n - 1 + (kt >> 3)) & 1) * 32768 + offb(16 * (kt & 7) + i, 4 * ks + g4)); }
                __builtin_amdgcn_sched_barrier(0);
#pragma unroll
                for (int t5 = 0; t5 < 5; ++t5) st[5 * hb + t5] = MFMA16(kf[t5], qf[ks], st[5 * hb + t5]);
                __builtin_amdgcn_sched_barrier(0); }
        const int iq = 16 * w + i; float mx = -3.0e38f;
#pragma unroll
        for (int tt = 0; tt < 10; ++tt)
#pragma unroll
            for (int rg = 0; rg < 4; ++rg) { const int j = 16 * (kt0 + tt) + 4 * g4 + rg, dist = iq + 128 - j; const bool ok = ((unsigned)dist <= 128u) && (n > 0 || j >= 128);
                st[tt][rg] = ok ? st[tt][rg] : -__builtin_inff(); mx = fmaxf(mx, st[tt][rg]); }
        mx = fmaxf(mx, __shfl_xor(mx, 16)); mx = fmaxf(mx, __shfl_xor(mx, 32));
        float sum = 0.f;
#pragma unroll
        for (int tt = 0; tt < 10; ++tt)
#pragma unroll
            for (int rg = 0; rg < 4; ++rg) { const float p = __builtin_amdgcn_exp2f(st[tt][rg] - mx); st[tt][rg] = p; sum += p; }
        sum += __shfl_xor(sum, 16); sum += __shfl_xor(sum, 32);
        f32x4 o[8];
#pragma unroll
        for (int c = 0; c < 8; ++c) o[c] = (f32x4){0.f, 0.f, 0.f, 0.f};
#pragma unroll
        for (int kk = 0; kk < 5; ++kk) { u32x4 pw; pw.x = pk2(st[2 * kk][0], st[2 * kk][1]); pw.y = pk2(st[2 * kk][2], st[2 * kk][3]); pw.z = pk2(st[2 * kk + 1][0], st[2 * kk + 1][1]); pw.w = pk2(st[2 * kk + 1][2], st[2 * kk + 1][3]);
            const bf16x8 pa = __builtin_bit_cast(bf16x8, pw); const int ka = kt0 + 2 * kk, kb2 = ka + 1;
            const LAS unsigned char* va = VL + ((n - 1 + (ka >> 3)) & 1) * 32768; const LAS unsigned char* vb = VL + ((n - 1 + (kb2 >> 3)) & 1) * 32768;
            bf16x8 vf[8];
#pragma unroll
            for (int c = 0; c < 8; ++c) vf[c] = cat8(tr4(va, 16 * (ka & 7) + 4 * g4, c, lane), tr4(vb, 16 * (kb2 & 7) + 4 * g4, c, lane));
            __builtin_amdgcn_sched_barrier(0);
#pragma unroll
            for (int c = 0; c < 8; ++c) o[c] = MFMA16(pa, vf[c], o[c]);
            __builtin_amdgcn_sched_barrier(0); }
        if (u < 3) {
#pragma unroll
            for (int ks = 0; ks < 4; ++ks) ATT_Q8(nq[ks], Qp + (size_t)((n + 1) * 128 + 16 * w + i) * 128 + 32 * ks + 8 * g4); }
        const float linv = 1.0f / sum;
        const size_t mrow0 = (size_t)b * SEQ;
        if (lane < 16) { const size_t m = mrow0 + (size_t)((n * 128 + iq) * d + r); LSE[((size_t)grp * T + m) * 4 + h] = (mx + __log2f(sum)) * 0.6931471805599453f; }
        __syncthreads();
        { LAS unsigned char* ost = KL + ((n - 1) & 1) * 32768 + w * 4096;
#pragma unroll
          for (int rg = 0; rg < 4; ++rg) { const float li = __shfl(linv, 4 * g4 + rg);
#pragma unroll
              for (int c = 0; c < 8; ++c) *(LAS bf16*)(ost + (4 * g4 + rg) * 256 + (16 * c + i) * 2) = f2bf(o[c][rg] * li); }
          LDS_WAIT(); asm volatile("" ::: "memory");
#pragma unroll
          for (int k = 0; k < 2; ++k) { const int pid = lane + 64 * k, qr = pid >> 3, ch = pid & 7;
              const u32x4 va = *(const LAS u32x4*)(ost + qr * 256 + ch * 32), vb = *(const LAS u32x4*)(ost + qr * 256 + ch * 32 + 16);
              int w0 = 0, w1 = 0, w2 = 0, w3 = 0;
              w0 = __builtin_amdgcn_cvt_pk_fp8_f32(bflo(va.x), bfhi(va.x), w0, false); w0 = __builtin_amdgcn_cvt_pk_fp8_f32(bflo(va.y), bfhi(va.y), w0, true);
              w1 = __builtin_amdgcn_cvt_pk_fp8_f32(bflo(va.z), bfhi(va.z), w1, false); w1 = __builtin_amdgcn_cvt_pk_fp8_f32(bflo(va.w), bfhi(va.w), w1, true);
              w2 = __builtin_amdgcn_cvt_pk_fp8_f32(bflo(vb.x), bfhi(vb.x), w2, false); w2 = __builtin_amdgcn_cvt_pk_fp8_f32(bflo(vb.y), bfhi(vb.y), w2, true);
              w3 = __builtin_amdgcn_cvt_pk_fp8_f32(bflo(vb.z), bfhi(vb.z), w3, false); w3 = __builtin_amdgcn_cvt_pk_fp8_f32(bflo(vb.w), bfhi(vb.w), w3, true);
              u32x4 v; v.x = (unsigned)w0; v.y = (unsigned)w1; v.z = (unsigned)w2; v.w = (unsigned)w3;
              const size_t m = mrow0 + (size_t)((n * 128 + 16 * w + qr) * d + r); *(u32x4*)((unsigned char*)OG + ((size_t)grp * T + m) * 512 + h * 128 + 16 * ch) = v; } }
        if (u < 3) { __syncthreads(); const int s1 = (n + 1) & 1;
#pragma unroll
            for (int ii = 0; ii < 2; ++ii) { const int id = tid + 512 * ii; ATT_PUT8(KL + s1 * 32768, pk[ii], id); ATT_PUT8(VL + s1 * 32768, pv[ii], id); }
#pragma unroll
            for (int ks = 0; ks < 4; ++ks) qf[ks] = nq[ks];
            __syncthreads(); }
    }
    __syncthreads();
#undef ATT_PUT8
}

constexpr int GL_RK = 0, GL_RG = 16384, GL_RQ = 32768, GL_OST = 0, GL_QE = 49152, GL_KM = 65536, GL_KE = 81920, GL_V = 98304;
constexpr int GL_TOT = 131072 + 2048, GL_DEC = 131072 + 6144, GL_ATT = 131072 + 6656;
template <bool FULL> struct GlaPre { u32x4 k[2], g[2], q[FULL ? 2 : 1], v[4]; };
template <bool FULL> DI void gla_fetch_kgq(GlaPre<FULL>& R, const bf16* Kp, const bf16* Gp, const bf16* Qp, size_t mbase, int tid) {
#pragma unroll
    for (int ii = 0; ii < 2; ++ii) { const size_t o = mbase * 128 + (size_t)(tid + 512 * ii) * 8; R.k[ii] = *(const u32x4*)(Kp + o); R.g[ii] = *(const u32x4*)(Gp + o); if (FULL) R.q[ii] = *(const u32x4*)(Qp + o); }
}
template <bool FULL> DI void gla_fetch_v(GlaPre<FULL>& R, const bf16* Vp, size_t mbase, int tid) {
#pragma unroll
    for (int ii = 0; ii < 4; ++ii) R.v[ii] = *(const u32x4*)(Vp + mbase * 256 + (size_t)(tid + 512 * ii) * 8);
}
template <bool FULL> DI void gla_fetch(GlaPre<FULL>& R, const bf16* Kp, const bf16* Gp, const bf16* Qp, const bf16* Vp, size_t mbase, int tid) { gla_fetch_kgq<FULL>(R, Kp, Gp, Qp, mbase, tid); gla_fetch_v<FULL>(R, Vp, mbase, tid); }
template <bool FULL> DI void gla_put(const GlaPre<FULL>& R, LAS unsigned char* lds, int tid) {
#pragma unroll
    for (int ii = 0; ii < 2; ++ii) { const int o = (tid + 512 * ii) * 16; *(LAS u32x4*)(lds + GL_RK + o) = R.k[ii]; *(LAS u32x4*)(lds + GL_RG + o) = R.g[ii]; if (FULL) *(LAS u32x4*)(lds + GL_RQ + o) = R.q[ii]; }
#pragma unroll
    for (int ii = 0; ii < 4; ++ii) { const int id = tid + 512 * ii, row = id >> 5, c32 = id & 31; *(LAS u32x4*)(lds + GL_V + (c32 >> 4) * 16384 + offb(row, c32 & 15)) = R.v[ii]; }
}
template <bool FULL> DI f32x2 gla_prep(LAS unsigned char* lds, int tid) {
    const int jp = tid & 63, tg = tid >> 6;
    f32x2 c[8], kv[8], qv[8]; f32x2 run = {0.f, 0.f};
#pragma unroll
    for (int ii = 0; ii < 8; ++ii) { const int o = (8 * tg + ii) * 256 + jp * 4; const unsigned gw = *(const LAS unsigned*)(lds + GL_RG + o), kw = *(const LAS unsigned*)(lds + GL_RK + o);
        run.x += bflo(gw); run.y += bfhi(gw); c[ii] = run; kv[ii] = (f32x2){bflo(kw), bfhi(kw)};
        if (FULL) { const unsigned qw = *(const LAS unsigned*)(lds + GL_RQ + o); qv[ii] = (f32x2){bflo(qw), bfhi(qw)}; } }
    LAS f32x2* TOT = (LAS f32x2*)(lds + GL_TOT);
    TOT[tg * 64 + jp] = run;
    __syncthreads();
    f32x2 off = {0.f, 0.f}, blast = {0.f, 0.f};
#pragma unroll
    for (int t2 = 0; t2 < 8; ++t2) { const f32x2 v = TOT[t2 * 64 + jp]; blast = blast + v; if (t2 < tg) off = off + v; }
    const f32x2 eb = {__expf(blast.x), __expf(blast.y)};
#pragma unroll
    for (int ii = 0; ii < 8; ++ii) { const int s = 8 * tg + ii; const f32x2 bb = off + c[ii]; const f32x2 e = {__expf(bb.x), __expf(bb.y)}; const f32x2 km = {kv[ii].x * __builtin_amdgcn_rcpf(e.x), kv[ii].y * __builtin_amdgcn_rcpf(e.y)};
        const unsigned o = offb(s, jp >> 2) + (jp & 3) * 4; const f32x2 ke = km * eb;
        *(LAS unsigned*)(lds + GL_KE + o) = pk2(ke.x, ke.y);
        if (FULL) { const f32x2 qe = qv[ii] * e; *(LAS unsigned*)(lds + GL_QE + o) = pk2(qe.x, qe.y); *(LAS unsigned*)(lds + GL_KM + o) = pk2(km.x, km.y); } }
    if (tg == 0) ((LAS f32x2*)(lds + GL_DEC))[jp] = eb;
    __syncthreads();
    return blast;
}
DI void gla_state_update(f32x4 (&S)[8][2], const LAS unsigned char* lds, int w, int lane) {
    const int g4 = lane >> 4; const LAS unsigned char* Vimg = lds + GL_V + (w >> 2) * 16384; const int cv = 2 * (w & 3);
#pragma unroll
    for (int mt = 0; mt < 8; ++mt) { const f32x4 dc = *(const LAS f32x4*)(lds + GL_DEC + (16 * mt + 4 * g4) * 4); S[mt][0] = S[mt][0] * dc; S[mt][1] = S[mt][1] * dc; }
#pragma unroll
    for (int ks = 0; ks < 2; ++ks) { bf16x8 bfr[2];
#pragma unroll
        for (int nt = 0; nt < 2; ++nt) bfr[nt] = cat8(tr4(Vimg, 32 * ks + 8 * g4, cv + nt, lane), tr4(Vimg, 32 * ks + 8 * g4 + 4, cv + nt, lane));
#pragma unroll
        for (int mt = 0; mt < 8; ++mt) { const bf16x8 a = cat8(tr4(lds + GL_KE, 32 * ks + 8 * g4, mt, lane), tr4(lds + GL_KE, 32 * ks + 8 * g4 + 4, mt, lane));
            S[mt][0] = MFMA16(a, bfr[0], S[mt][0]); S[mt][1] = MFMA16(a, bfr[1], S[mt][1]); } }
}
DI void gla_pass1(const Ptrs& P, LAS unsigned char* lds, int unit, int tid0) {
    const int lane0 = tid0 & 63, w = __builtin_amdgcn_readfirstlane(tid0 >> 6); const int bh = unit >> 5, sc = unit & 31, b = bh >> 2, h = bh & 3;
    const bf16* Kp = proj_plane(P.ws, 40 + h); const bf16* Gp = proj_plane(P.ws, 60 + h); const bf16* Vp = proj_plane(P.ws, 44) + (size_t)h * T * 256;
    f32x4 S[8][2];
#pragma unroll
    for (int mt = 0; mt < 8; ++mt) { S[mt][0] = (f32x4){0.f, 0.f, 0.f, 0.f}; S[mt][1] = (f32x4){0.f, 0.f, 0.f, 0.f}; }
    f32x2 logd = {0.f, 0.f}; const size_t m0 = (size_t)b * SEQ + (size_t)(8 * sc) * 64;
    GlaPre<false> R; gla_fetch<false>(R, Kp, Gp, nullptr, Vp, m0, tid0); gla_put<false>(R, lds, tid0);
    __syncthreads();
#pragma unroll 1
    for (int ci = 0; ci < 8; ++ci) {
        int tid = tid0; asm volatile("" : "+v"(tid));
        if (ci < 7) gla_fetch<false>(R, Kp, Gp, nullptr, Vp, m0 + (size_t)(ci + 1) * 64, tid);
        logd = logd + gla_prep<false>(lds, tid);
        const int lane = tid & 63;
        gla_state_update(S, lds, w, lane);
        __syncthreads();
        if (ci < 7) { gla_put<false>(R, lds, tid); __syncthreads(); } }
    float* GS = (float*)(P.ws + WS_GSTATE) + (size_t)unit * 32768;
#pragma unroll
    for (int mt = 0; mt < 8; ++mt)
#pragma unroll
        for (int nt = 0; nt < 2; ++nt)
#pragma unroll
            for (int rg = 0; rg < 4; ++rg) GS[((w * 16 + mt * 2 + nt) * 4 + rg) * 64 + lane0] = S[mt][nt][rg];
    if (tid0 < 64) ((f32x2*)(P.ws + WS_GDEC))[unit * 64 + tid0] = (f32x2){__expf(logd.x), __expf(logd.y)};
}
DI void gla_scan(const Ptrs& P, int vcu, int G, int tid) {
    float* GS = (float*)(P.ws + WS_GSTATE); const float* GD = (const float*)(P.ws + WS_GDEC);
    for (int cid = vcu * 512 + tid; cid < 8 * 32768; cid += G * 512) { const int bh = cid >> 15, e = cid & 32767, ln = e & 63, rg = (e >> 6) & 3, mt = ((e >> 8) & 15) >> 1, dk = 16 * mt + 4 * (ln >> 4) + rg;
        float ev[32], dv[32];
#pragma unroll
        for (int sc = 0; sc < 32; ++sc) { ev[sc] = GS[((size_t)(bh * 32 + sc) << 15) + e]; dv[sc] = GD[(bh * 32 + sc) * 128 + dk]; }
        float carry = 0.f;
#pragma unroll
        for (int sc = 0; sc < 32; ++sc) { GS[((size_t)(bh * 32 + sc) << 15) + e] = carry; carry = dv[sc] * carry + ev[sc]; } }
}
DI void gla_pass2(const Ptrs& P, LAS unsigned char* lds, int unit, int tid0) {
    const int lane0 = tid0 & 63, w = __builtin_amdgcn_readfirstlane(tid0 >> 6); const int bh = unit >> 5, sc = unit & 31, b = bh >> 2, h = bh & 3;
    const bf16* Qp = proj_plane(P.ws, 36 + h); const bf16* Kp = proj_plane(P.ws, 40 + h); const bf16* Gp = proj_plane(P.ws, 60 + h);
    const bf16* Vp = proj_plane(P.ws, 44) + (size_t)h * T * 256; const bf16* Op = proj_plane(P.ws, 52) + (size_t)h * T * 256; bf16* OB = (bf16*)(P.ws + WS_OB);
    f32x4 S[8][2];
    { const float* GS = (const float*)(P.ws + WS_GSTATE) + (size_t)unit * 32768;
#pragma unroll
      for (int mt = 0; mt < 8; ++mt)
#pragma unroll
          for (int nt = 0; nt < 2; ++nt)
#pragma unroll
              for (int rg = 0; rg < 4; ++rg) S[mt][nt][rg] = GS[((w * 16 + mt * 2 + nt) * 4 + rg) * 64 + lane0]; }
    const size_t m0 = (size_t)b * SEQ + (size_t)(8 * sc) * 64;
    GlaPre<true> R; gla_fetch<true>(R, Kp, Gp, Qp, Vp, m0, tid0); gla_put<true>(R, lds, tid0);
    __syncthreads();
#pragma unroll 1
    for (int ci = 0; ci < 8; ++ci) { const size_t mbase = m0 + (size_t)ci * 64;
        int tid = tid0; asm volatile("" : "+v"(tid));
        const int erow = tid >> 3, ep = tid & 7;
        if (ci < 7) gla_fetch_kgq<true>(R, Kp, Gp, Qp, mbase + 64, tid);
        (void)gla_prep<true>(lds, tid);
        if (ci < 7) gla_fetch_v<true>(R, Vp, mbase + 64, tid);
        u32x4 gog[4];
#pragma unroll
        for (int k = 0; k < 4; ++k) gog[k] = *(const u32x4*)(Op + (mbase + erow) * 256 + 8 * (ep + 8 * k));
        const int lane = tid & 63, i = lane & 15, g4 = lane >> 4;
        const LAS unsigned char* Vimg = lds + GL_V + (w >> 2) * 16384; const int cv = 2 * (w & 3);
        { const int mi = w >> 1;
#pragma unroll
          for (int nn = 0; nn < 2; ++nn) { const int nj = 2 * (w & 1) + nn; f32x4 a = {0.f, 0.f, 0.f, 0.f};
#pragma unroll
              for (int ks = 0; ks < 4; ++ks) { const bf16x8 af = *(const LAS bf16x8*)(lds + GL_QE + offb(16 * mi + i, 4 * ks + g4)), bfr = *(const LAS bf16x8*)(lds + GL_KM + offb(16 * nj + i, 4 * ks + g4)); a = MFMA16(af, bfr, a); }
#pragma unroll
              for (int rg = 0; rg < 4; ++rg) { const int sq = 16 * mi + 4 * g4 + rg, sk = 16 * nj + i; *(LAS bf16*)(lds + GL_ATT + sq * 144 + sk * 2) = f2bf(sk <= sq ? a[rg] : 0.f); } } }
        __syncthreads();
        f32x4 o[4][2];
#pragma unroll
        for (int mt = 0; mt < 4; ++mt) { o[mt][0] = (f32x4){0.f, 0.f, 0.f, 0.f}; o[mt][1] = (f32x4){0.f, 0.f, 0.f, 0.f}; }
#pragma unroll
        for (int ks = 0; ks < 2; ++ks) { bf16x8 bfr[2];
#pragma unroll
            for (int nt = 0; nt < 2; ++nt) bfr[nt] = cat8(tr4(Vimg, 32 * ks + 8 * g4, cv + nt, lane), tr4(Vimg, 32 * ks + 8 * g4 + 4, cv + nt, lane));
#pragma unroll
            for (int mt = 0; mt < 4; ++mt) { const bf16x8 a = *(const LAS bf16x8*)(lds + GL_ATT + (16 * mt + i) * 144 + 64 * ks + 16 * g4); o[mt][0] = MFMA16(a, bfr[0], o[mt][0]); o[mt][1] = MFMA16(a, bfr[1], o[mt][1]); } }
#pragma unroll
        for (int ks = 0; ks < 4; ++ks) { bf16x8 sb[2];
#pragma unroll
            for (int nt = 0; nt < 2; ++nt) { u32x4 pw; pw.x = pk2(S[2 * ks][nt][0], S[2 * ks][nt][1]); pw.y = pk2(S[2 * ks][nt][2], S[2 * ks][nt][3]); pw.z = pk2(S[2 * ks + 1][nt][0], S[2 * ks + 1][nt][1]); pw.w = pk2(S[2 * ks + 1][nt][2], S[2 * ks + 1][nt][3]); sb[nt] = __builtin_bit_cast(bf16x8, pw); }
#pragma unroll
            for (int mt = 0; mt < 4; ++mt) { const u32x2 lo = *(const LAS u32x2*)(lds + GL_QE + offb(16 * mt + i, 4 * ks + (g4 >> 1)) + (g4 & 1) * 8), hi = *(const LAS u32x2*)(lds + GL_QE + offb(16 * mt + i, 4 * ks + 2 + (g4 >> 1)) + (g4 & 1) * 8);
                u32x4 aw; aw.x = lo.x; aw.y = lo.y; aw.z = hi.x; aw.w = hi.y; const bf16x8 a = __builtin_bit_cast(bf16x8, aw);
                o[mt][0] = MFMA16(a, sb[0], o[mt][0]); o[mt][1] = MFMA16(a, sb[1], o[mt][1]); } }
#pragma unroll
        for (int mt = 0; mt < 4; ++mt)
#pragma unroll
            for (int rg = 0; rg < 4; ++rg) { const int sq = 16 * mt + 4 * g4 + rg; LAS bf16* op = (LAS bf16*)(lds + GL_OST + sq * 512 + (32 * w + i) * 2); op[0] = f2bf(o[mt][0][rg]); op[16] = f2bf(o[mt][1][rg]); }
        gla_state_update(S, lds, w, lane);
        __syncthreads();
        { u32x4 ov[4]; float ss = 0.f;
#pragma unroll
          for (int k = 0; k < 4; ++k) { ov[k] = *(const LAS u32x4*)(lds + GL_OST + erow * 512 + 16 * (ep + 8 * k));
              const float a0 = bflo(ov[k].x), a1 = bfhi(ov[k].x), a2 = bflo(ov[k].y), a3 = bfhi(ov[k].y), a4 = bflo(ov[k].z), a5 = bfhi(ov[k].z), a6 = bflo(ov[k].w), a7 = bfhi(ov[k].w);
              ss += (a0 * a0 + a1 * a1) + (a2 * a2 + a3 * a3) + (a4 * a4 + a5 * a5) + (a6 * a6 + a7 * a7); }
          ss += __shfl_xor(ss, 1); ss += __shfl_xor(ss, 2); ss += __shfl_xor(ss, 4);
          const float rstd = 1.0f / sqrtf(ss * (1.0f / 256.0f) + RMS_EPS);
#pragma unroll
          for (int k = 0; k < 4; ++k) { const int col = 8 * (ep + 8 * k); const f32x4 n0v = *(const f32x4*)(P.gnorm + col), n1v = *(const f32x4*)(P.gnorm + col + 4);
              const unsigned ow[4] = {ov[k].x, ov[k].y, ov[k].z, ov[k].w}, gw[4] = {gog[k].x, gog[k].y, gog[k].z, gog[k].w}; const float nw[8] = {n0v.x, n0v.y, n0v.z, n0v.w, n1v.x, n1v.y, n1v.z, n1v.w}; unsigned rw[4];
#pragma unroll
              for (int q = 0; q < 4; ++q) { const float ga = bflo(gw[q]), gb = bfhi(gw[q]); rw[q] = pk2(bflo(ow[q]) * rstd * nw[2 * q] * ga * sigmoidf_fast(ga), bfhi(ow[q]) * rstd * nw[2 * q + 1] * gb * sigmoidf_fast(gb)); }
              u32x4 res; res.x = rw[0]; res.y = rw[1]; res.z = rw[2]; res.w = rw[3];
              *(u32x4*)(OB + (mbase + erow) * D + h * 256 + col) = res; } }
        __syncthreads();
        if (ci < 7) { gla_put<true>(R, lds, tid); __syncthreads(); } }
}

DI void attn_merge(const Ptrs& P, int vcu, int G, int tid) {
    const int lane = tid & 63, wave = tid >> 6, gw = vcu * 8 + wave, NGW = G * 8, h = lane >> 4;
    const unsigned char* OG8 = (const unsigned char*)P.out + OUT_OG; const float* LSE = (const float*)((const unsigned char*)P.out + OUT_LSE); bf16* OA = (bf16*)(P.ws + WS_OA);
    for (int m0 = gw * 4; m0 < T; m0 += NGW * 4) {
        float l[4][3]; u32x2 v[4][3];
#pragma unroll
        for (int q = 0; q < 4; ++q)
#pragma unroll
            for (int g = 0; g < 3; ++g) { l[q][g] = LSE[((size_t)g * T + m0 + q) * 4 + h]; v[q][g] = *(const u32x2*)(OG8 + ((size_t)g * T + m0 + q) * 512 + 8 * lane); }
#pragma unroll
        for (int q = 0; q < 4; ++q) { const float mx = fmaxf(l[q][0], fmaxf(l[q][1], l[q][2])); float w0 = __expf(l[q][0] - mx), w1 = __expf(l[q][1] - mx), w2 = __expf(l[q][2] - mx); const float inv = 1.0f / (w0 + w1 + w2); w0 *= inv; w1 *= inv; w2 *= inv;
            const u32x2 a = v[q][0], bq = v[q][1], c = v[q][2];
            const f32x2 a0 = __builtin_amdgcn_cvt_pk_f32_fp8((int)a.x, false), a1 = __builtin_amdgcn_cvt_pk_f32_fp8((int)a.x, true), a2 = __builtin_amdgcn_cvt_pk_f32_fp8((int)a.y, false), a3 = __builtin_amdgcn_cvt_pk_f32_fp8((int)a.y, true);
            const f32x2 b0 = __builtin_amdgcn_cvt_pk_f32_fp8((int)bq.x, false), b1 = __builtin_amdgcn_cvt_pk_f32_fp8((int)bq.x, true), b2 = __builtin_amdgcn_cvt_pk_f32_fp8((int)bq.y, false), b3 = __builtin_amdgcn_cvt_pk_f32_fp8((int)bq.y, true);
            const f32x2 c0 = __builtin_amdgcn_cvt_pk_f32_fp8((int)c.x, false), c1 = __builtin_amdgcn_cvt_pk_f32_fp8((int)c.x, true), c2 = __builtin_amdgcn_cvt_pk_f32_fp8((int)c.y, false), c3 = __builtin_amdgcn_cvt_pk_f32_fp8((int)c.y, true);
            u32x4 o;
            o.x = pk2(w0 * a0.x + w1 * b0.x + w2 * c0.x, w0 * a0.y + w1 * b0.y + w2 * c0.y);
            o.y = pk2(w0 * a1.x + w1 * b1.x + w2 * c1.x, w0 * a1.y + w1 * b1.y + w2 * c1.y);
            o.z = pk2(w0 * a2.x + w1 * b2.x + w2 * c2.x, w0 * a2.y + w1 * b2.y + w2 * c2.y);
            o.w = pk2(w0 * a3.x + w1 * b3.x + w2 * c3.x, w0 * a3.y + w1 * b3.y + w2 * c3.y);
            *(u32x4*)(OA + (size_t)(m0 + q) * 512 + 8 * lane) = o; } }
}

DI void router_phase(const Ptrs& P, LAS unsigned char* lds, int G, int tid0) {
    int tid = tid0;
    const bf16* H1 = (const bf16*)(P.ws + WS_H1); unsigned char* HN8 = P.ws + WS_HN; const bf16* WRT = (const bf16*)(P.ws + WS_WRT);
    { int* RT = (int*)(P.ws + WS_ROWTOK); for (int idx = blockIdx.x * 512 + tid; idx < MAXTILES * 256; idx += G * 512) RT[idx] = 0; }
    int* ASG_E = (int*)(P.ws + WS_ASG_E); int* ASG_SLOT = (int*)(P.ws + WS_ASG_SLOT); float* ASG_G = (float*)(P.ws + WS_ASG_G);
    LAS float* LG = (LAS float*)lds; LAS int* lcnt = (LAS int*)(lds + 17408); LAS int* lbase = (LAS int*)(lds + 17536);
    unsigned* gcnt = (unsigned*)(P.ctl + CW_CNT);
    for (int tb = blockIdx.x; tb < T / 128; tb += G) {
        asm volatile("" : "+v"(tid));
        const int lane = tid & 63, w = tid >> 6, i = lane & 15, g4 = lane >> 4;
        if (tid < 32) lcnt[tid] = 0;
        __syncthreads();
        const int t = tb * 128 + 16 * w + i; const bf16* hrow = H1 + (size_t)t * D + 8 * g4;
        float ss = 0.f; { const float* ps = (const float*)(P.ws + WS_PS) + t;
#pragma unroll
            for (int j = 0; j < 16; ++j) ss += ps[(size_t)j * T]; }
        const float rstd = 1.0f / sqrtf(ss * (1.0f / D) + RMS_EPS);
        f32x4 a0 = {0.f, 0.f, 0.f, 0.f}, a1 = {0.f, 0.f, 0.f, 0.f};
#pragma unroll 1
        for (int cb = 0; cb < 32; cb += 8) {
            u32x4 hv[8]; f32x4 w0[8], w1[8]; bf16x8 b0[8], b1[8];
#pragma unroll
            for (int j = 0; j < 8; ++j) { const int c = cb + j; hv[j] = *(const u32x4*)(hrow + 32 * c); w0[j] = *(const f32x4*)(P.ln2 + 32 * c + 8 * g4); w1[j] = *(const f32x4*)(P.ln2 + 32 * c + 8 * g4 + 4);
                b0[j] = *(const bf16x8*)(WRT + (size_t)i * D + 32 * c + 8 * g4); b1[j] = *(const bf16x8*)(WRT + (size_t)(16 + i) * D + 32 * c + 8 * g4); }
#pragma unroll
            for (int j = 0; j < 8; ++j) { const int c = cb + j; const f32x4 u0 = w0[j] * rstd, u1 = w1[j] * rstd;
                const float y0 = bflo(hv[j].x) * u0.x, y1 = bfhi(hv[j].x) * u0.y, y2 = bflo(hv[j].y) * u0.z, y3 = bfhi(hv[j].y) * u0.w, y4 = bflo(hv[j].z) * u1.x, y5 = bfhi(hv[j].z) * u1.y, y6 = bflo(hv[j].w) * u1.z, y7 = bfhi(hv[j].w) * u1.w;
                int q0 = 0, q1 = 0; q0 = __builtin_amdgcn_cvt_pk_fp8_f32(y0, y1, q0, false); q0 = __builtin_amdgcn_cvt_pk_fp8_f32(y2, y3, q0, true); q1 = __builtin_amdgcn_cvt_pk_fp8_f32(y4, y5, q1, false); q1 = __builtin_amdgcn_cvt_pk_fp8_f32(y6, y7, q1, true);
                u32x2 q; q.x = (unsigned)q0; q.y = (unsigned)q1; *(u32x2*)(HN8 + (size_t)t * D + 32 * c + 8 * g4) = q;
                u32x4 y; y.x = pk2(y0, y1); y.y = pk2(y2, y3); y.z = pk2(y4, y5); y.w = pk2(y6, y7);
                const bf16x8 af = __builtin_bit_cast(bf16x8, y); a0 = MFMA16(af, b0[j], a0); a1 = MFMA16(af, b1[j], a1); } }
        const float br0 = P.br[i], br1 = P.br[16 + i];
#pragma unroll
        for (int rg = 0; rg < 4; ++rg) { LG[(w * 16 + 4 * g4 + rg) * 33 + i] = a0[rg] + br0; LG[(w * 16 + 4 * g4 + rg) * 33 + 16 + i] = a1[rg] + br1; }
        LDS_WAIT(); asm volatile("" ::: "memory");
        int es[4] = {0, 0, 0, 0}, ls[4] = {0, 0, 0, 0}; float gs[4] = {0.f, 0.f, 0.f, 0.f};
        if (lane < 16) { float lg[32];
#pragma unroll
            for (int e = 0; e < 32; ++e) lg[e] = LG[(w * 16 + lane) * 33 + e];
            unsigned taken = 0u; float tv[4];
#pragma unroll
            for (int k = 0; k < 4; ++k) { float best = -3.0e38f; int bi = 0;
#pragma unroll
                for (int e = 0; e < 32; ++e) { const bool ok = !((taken >> e) & 1u) && lg[e] > best; best = ok ? lg[e] : best; bi = ok ? e : bi; }
                taken |= 1u << bi; es[k] = bi; tv[k] = best; }
            const float e1 = __expf(tv[1] - tv[0]), e2 = __expf(tv[2] - tv[0]), e3 = __expf(tv[3] - tv[0]), inv = 1.0f / (1.0f + e1 + e2 + e3);
            gs[0] = inv; gs[1] = e1 * inv; gs[2] = e2 * inv; gs[3] = e3 * inv;
#pragma unroll
            for (int k = 0; k < 4; ++k) ls[k] = __hip_atomic_fetch_add(lcnt + es[k], 1, __ATOMIC_RELAXED, __HIP_MEMORY_SCOPE_WORKGROUP); }
        if (lane < 16) { const int tt = tb * 128 + 16 * w + lane;
#pragma unroll
            for (int k = 0; k < 4; ++k) { ASG_E[4 * tt + k] = es[k]; ASG_SLOT[4 * tt + k] = ls[k]; ASG_G[4 * tt + k] = gs[k]; } }
        __syncthreads();
        if (tid < 32) gcnt[tb * 32 + tid] = (unsigned)lcnt[tid];
        __syncthreads();
    }
}
DI void moe_colsum(const unsigned* cnt, int nrows, LAS int* red, int tid, int& out) {
    const int e = tid & 31, part = tid >> 5; unsigned c = 0;
#pragma unroll 4
    for (int r = part; r < nrows; r += 16) c += cnt[r * 32 + e];
    red[tid] = (int)c;
    __syncthreads();
    if (tid < 32) { int t = 0;
#pragma unroll
        for (int p = 0; p < 16; ++p) t += red[p * 32 + tid];
        out = t; }
}
DI void moe_tables(const Ptrs& P, LAS int* ts, int tid) {
    int c = 0; moe_colsum((const unsigned*)(P.ctl + CW_CNT), T / 128, ts + 128, tid, c);
    if (tid < 64) { int tiles = (tid < 32) ? ((c + 255) >> 8) : 0, inc = tiles;
#pragma unroll
        for (int o = 1; o < 32; o <<= 1) { const int v = __shfl_up(inc, o); if ((tid & 63) >= o) inc += v; }
        if (tid < 32) { ts[tid] = inc - tiles; ts[40 + tid] = c; } if (tid == 31) ts[32] = inc; }
    __syncthreads();
}
DI void moe_scatter(const Ptrs& P, LAS unsigned char* lds, int vcu, int G, int tid) {
    LAS int* ts = (LAS int*)(lds + TBL_OFF); moe_tables(P, ts, tid); LAS int* bs = ts + 80;
    const int* ASG_E = (const int*)(P.ws + WS_ASG_E); const int* ASG_SLOT = (const int*)(P.ws + WS_ASG_SLOT); int* ASG_ROW = (int*)(P.ws + WS_ASG_ROW); int* RT = (int*)(P.ws + WS_ROWTOK);
    const unsigned* cnt = (const unsigned*)(P.ctl + CW_CNT);
    for (int tb = blockIdx.x; tb < T / 128; tb += G) {
        { int c = 0; moe_colsum(cnt, tb, ts + 128, tid, c); if (tid < 32) bs[tid] = c; }
        __syncthreads();
        { const int a = tb * 512 + tid, e = ASG_E[a], row = ts[e] * 256 + bs[e] + ASG_SLOT[a]; ASG_ROW[a] = row; RT[row] = a >> 2; }
        __syncthreads(); }
}
constexpr int LT_OFF = 131072 + 2048;
template <class Sched> DI void moe_unit_tokens(const Ptrs& P, const Sched& S, LAS unsigned short* lt, int tid) {
    const int* RT = (const int*)(P.ws + WS_ROWTOK); int pmv[17];
#pragma unroll
    for (int i = 0; i < 17; ++i) { pg8::Unit u; pmv[i] = S.next(i, u) ? u.pm : -1; }
    if (tid < 256) { int tk[17];
#pragma unroll
        for (int i = 0; i < 17; ++i) tk[i] = (pmv[i] >= 0) ? RT[pmv[i] * 256 + tid] : 0;
#pragma unroll
        for (int i = 0; i < 17; ++i) if (pmv[i] >= 0) lt[i * 256 + tid] = (unsigned short)tk[i]; }
    __syncthreads();
}
DI void final_phase(const Ptrs& P, int vcu, int G, int tid) {
    const int lane = tid & 63, wave = tid >> 6, gw = vcu * 8 + wave, NGW = G * 8;
    const int* ASG_ROW = (const int*)(P.ws + WS_ASG_ROW); const float* ASG_G = (const float*)(P.ws + WS_ASG_G); const unsigned char* YB8 = P.ws + WS_YB;
#if BRINGUP == 1
    for (int t = gw; t < T; t += NGW) { const f32x4* hr = (const f32x4*)(P.x + (size_t)t * D) + lane; f32x4 v[4]; float s = 0.f;
#pragma unroll
        for (int j = 0; j < 4; ++j) { v[j] = hr[64 * j]; s += (v[j].x * v[j].x + v[j].y * v[j].y) + (v[j].z * v[j].z + v[j].w * v[j].w); }
        const float rstd = 1.f / sqrtf(wave_sum(s) * (1.f / D) + RMS_EPS); f32x4* orow = (f32x4*)(P.out + (size_t)t * D) + lane; const f32x4* wr = (const f32x4*)P.lnf + lane;
#pragma unroll
        for (int j = 0; j < 4; ++j) orow[64 * j] = v[j] * rstd * wr[64 * j]; }
#else
    const bf16* H1 = (const bf16*)(P.ws + WS_H1);
    f32x4 lw[4];
#pragma unroll
    for (int j = 0; j < 4; ++j) lw[j] = ((const f32x4*)P.lnf + lane)[64 * j];
    typedef int i32x4 __attribute__((ext_vector_type(4)));
    constexpr int TPI = 4;
    int t0 = gw * TPI;
    i32x4 rws[TPI]; f32x4 gts[TPI];
    if (t0 < T) {
#pragma unroll
        for (int q = 0; q < TPI; ++q) { rws[q] = *(const i32x4*)(ASG_ROW + 4 * (t0 + q)); gts[q] = *(const f32x4*)(ASG_G + 4 * (t0 + q)); } }
    for (; t0 < T; t0 += NGW * TPI) {
        u32x2 hq[TPI][4]; unsigned yq[TPI][4][4];
#pragma unroll
        for (int q = 0; q < TPI; ++q) { const u32x2* hr = (const u32x2*)(H1 + (size_t)(t0 + q) * D) + lane;
#pragma unroll
            for (int j = 0; j < 4; ++j) hq[q][j] = hr[64 * j];
#pragma unroll
            for (int k = 0; k < 4; ++k) { const unsigned* yr = (const unsigned*)(YB8 + (size_t)rws[q][k] * D) + lane;
#pragma unroll
                for (int j = 0; j < 4; ++j) yq[q][k][j] = yr[64 * j]; } }
        f32x4 gc[TPI];
#pragma unroll
        for (int q = 0; q < TPI; ++q) gc[q] = gts[q];
        const int tn = t0 + NGW * TPI;
        if (tn < T) {
#pragma unroll
            for (int q = 0; q < TPI; ++q) { rws[q] = *(const i32x4*)(ASG_ROW + 4 * (tn + q)); gts[q] = *(const f32x4*)(ASG_G + 4 * (tn + q)); } }
#pragma unroll
        for (int q = 0; q < TPI; ++q) { f32x4 v[4]; float s = 0.f;
#pragma unroll
            for (int j = 0; j < 4; ++j) { v[j].x = bflo(hq[q][j].x); v[j].y = bfhi(hq[q][j].x); v[j].z = bflo(hq[q][j].y); v[j].w = bfhi(hq[q][j].y);
#pragma unroll
                for (int k = 0; k < 4; ++k) { const float gk = gc[q][k]; const int y = (int)yq[q][k][j]; const f32x2 lo = __builtin_amdgcn_cvt_pk_f32_fp8(y, false), hi = __builtin_amdgcn_cvt_pk_f32_fp8(y, true);
                    v[j].x += gk * lo.x; v[j].y += gk * lo.y; v[j].z += gk * hi.x; v[j].w += gk * hi.y; }
                s += (v[j].x * v[j].x + v[j].y * v[j].y) + (v[j].z * v[j].z + v[j].w * v[j].w); }
            const float rstd = 1.f / sqrtf(wave_sum(s) * (1.f / D) + RMS_EPS);
            f32x4* orow = (f32x4*)(P.out + (size_t)(t0 + q) * D) + lane;
#pragma unroll
            for (int j = 0; j < 4; ++j) { f32x4 ov = v[j] * rstd * lw[j];
#if STAMP_PHASE >= 0
                if (t0 + q == 0 && lane == 0 && j == 0) { const unsigned long long* st = (const unsigned long long*)(P.ws + WS_CTL + 65536); ov.x += (float)(st[STAMP_PHASE + 1] - st[STAMP_PHASE]) * 0.0005f; }
#endif
                orow[64 * j] = ov; } }
    }
#endif
}

constexpr int N_PHASES = 12;
struct Args { const float* in[17]; float* out; unsigned char* ws; int ph_lo, ph_hi; };
__global__ void __launch_bounds__(512, 2) fwd(Args args) {
    extern __shared__ __attribute__((aligned(16))) unsigned char lds_raw[];
    LAS unsigned char* lds = (LAS unsigned char*)lds_raw;
    const int tid = threadIdx.x, G = gridDim.x; const int bx = blockIdx.x; const int vcu = (G % 8 == 0) ? (bx % 8) * (G / 8) + bx / 8 : bx;
    Ptrs P;
    P.x = args.in[0]; P.ln1 = args.in[1]; P.w_in = args.in[2]; P.w_gk2 = args.in[3]; P.b_gk2 = args.in[4]; P.gnorm = args.in[5]; P.wpa = args.in[6]; P.wpb = args.in[7]; P.wout = args.in[8];
    P.ln2 = args.in[9]; P.wr = args.in[10]; P.br = args.in[11]; P.wup = args.in[12]; P.bup = args.in[13]; P.wdn = args.in[14]; P.bdn = args.in[15]; P.lnf = args.in[16];
    P.out = args.out; P.ws = args.ws; P.ctl = (gu32*)(args.ws + WS_CTL);
    volatile LAS unsigned* MISC = (volatile LAS unsigned*)(lds + MISC_OFF);
    for (int u = tid; u < (LDS_BYTES - MISC_OFF) / 4; u += 512) ((LAS unsigned*)(lds + MISC_OFF))[u] = 0u;
    __syncthreads();
    XcdBarrier bar; bar.bar = (unsigned*)(P.ctl + CW_BAR); bar.x = 0; bar.st = nullptr;
    if (MK_N_LAUNCHES == 1) bar = xcd_barrier_post((unsigned*)(P.ctl + CW_BAR), MISC + 8);
    const int lo = args.ph_lo, hi = args.ph_hi;
#ifndef PH_MASK
#define PH_MASK 0xFFF
#endif
#define IN(k) (((PH_MASK >> (k)) & 1) && lo <= (k) && (k) < hi)
#define SEAM(k) do { if (IN(k) && IN((k) + 1)) xcd_barrier(bar); } while (0)
#define STAMP(k) do { if (STAMP_PHASE >= 0 && bx == 0 && tid == 0) ((unsigned long long*)(P.ws + WS_CTL + 65536))[k] = wall_clock64(); } while (0)
#define DUP(k, ...) do { __VA_ARGS__; if ((DUP_MASK >> (k)) & 1) { __syncthreads(); __VA_ARGS__; } } while (0)
    bf16* PROJ = (bf16*)(P.ws + WS_PROJ); bf16* XN = (bf16*)(P.ws + WS_XN); bf16* MIXED = XN;

    STAMP(0);
    if (IN(0)) { DUP(0, p0_prologue(P, lds, vcu, G, tid)); } SEAM(0);
#if BRINGUP == 0
    STAMP(1);
    if (IN(1)) { pg8::Gemm g{XN, (const bf16*)(P.ws + WS_WIN), T, NP, D / 2, 0}; pg8::StaticOrder S; S.init(T, NP, G, bx);
        pg8::EpiProj<true> E{PROJ, P.b_gk2, (const float*)(P.ws + WS_SX), (const float*)(P.ws + WS_SWIN)};
        const int nq_items = (32 * 64 + 32 * 32 + G - 1) / G, rounds = (S.nwg + G - 1) / G, phs = bx & 1;
        if (!phs) { p0_quant_all(P, lds, vcu, G, tid, 0, nq_items); __syncthreads(); }
        { int t_ = tid; asm volatile("" : "+v"(t_)); pg8::gemm_phase<pg8::EpiProj<true>, pg8::StaticOrder, 2>(lds, g, S, E, t_); }
        if (phs) { __syncthreads(); p0_quant_all(P, lds, vcu, G, tid, 0, nq_items); }
    } SEAM(1);
    STAMP(2);
    if (IN(2)) { bf16* OG = (bf16*)((unsigned char*)P.out + OUT_OG); float* LSE = (float*)((unsigned char*)P.out + OUT_LSE);
        DUP(12, for (int u = vcu; u < 768; u += G) attn_task(P.ws, OG, LSE, lds, u, tid));
        DUP(13, for (int u = bx; u < 256; u += G) gla_pass1(P, lds, u, tid)); } SEAM(2);
    STAMP(3);
    if (IN(3)) { gla_scan(P, vcu, G, tid); attn_merge(P, vcu, G, tid); } SEAM(3);
    STAMP(4);
    if (IN(4)) { DUP(4, for (int u = bx; u < 256; u += G) gla_pass2(P, lds, u, tid)); } SEAM(4);
    STAMP(5);
    if (IN(5)) { { pg8::Gemm g{(const bf16*)(P.ws + WS_OA), (const bf16*)(P.ws + WS_WPA), T, D, 512, 0}; pg8::StaticOrder S; S.init(T, D, G, bx); pg8::EpiGate<false> E{MIXED, (const unsigned char*)(PROJ + 64 * PLANE), (unsigned char*)P.out  }; pg8::gemm_phase(lds, g, S, E); }
                 { pg8::Gemm g{(const bf16*)(P.ws + WS_OB), (const bf16*)(P.ws + WS_WPB), T, D, D, 0}; pg8::StaticOrder S; S.init(T, D, G, bx); pg8::EpiGate<true> E{MIXED, (const unsigned char*)(PROJ + 64 * PLANE) + 1024, (unsigned char*)P.out}; pg8::gemm_phase(lds, g, S, E); } } SEAM(5);
    STAMP(6);
    if (IN(6)) { pg8::Gemm g{MIXED, (const bf16*)(P.ws + WS_WOUT), T, D, D, 0}; pg8::StaticOrder S; S.init(T, D, G, bx); pg8::EpiResBf16 E{P.x, (bf16*)(P.ws + WS_H1), (float*)(P.ws + WS_PS)}; pg8::gemm_phase(lds, g, S, E); } SEAM(6);
#elif BRINGUP == 2
    if (IN(6)) { for (size_t idx = (size_t)vcu * 512 + tid; idx < (size_t)T * D / 2; idx += (size_t)G * 512) ((unsigned*)(P.ws + WS_H1))[idx] = pk2(P.x[2 * idx], P.x[2 * idx + 1]); } SEAM(6);
#endif
#if BRINGUP != 1
    STAMP(7);
    if (IN(7)) { router_phase(P, lds, G, tid); } SEAM(7);
    STAMP(8);
    if (IN(8)) { moe_scatter(P, lds, vcu, G, tid); } SEAM(8);
    STAMP(9);
    if (IN(9)) { LAS int* ts = (LAS int*)(lds + TBL_OFF); moe_tables(P, ts, tid); LAS unsigned short* lt = (LAS unsigned short*)(lds + LT_OFF);
        pg8::MoeOrder S; S.init(ts[32] * 256, 2048, G, bx); S.ts = ts; moe_unit_tokens(P, S, lt, tid);
        pg8::Gemm g{(const bf16*)(P.ws + WS_HN), (const bf16*)(P.ws + WS_WUP), 0, 2048, D / 2, (size_t)2048 * 512, lt};
        pg8::EpiSwiGLU8 E{P.ws + WS_ACT, P.bup, (const float*)(P.ws + WS_SUP)}; DUP(9, pg8::gemm_phase<pg8::EpiSwiGLU8, pg8::MoeOrder, 1, true>(lds, g, S, E)); } SEAM(9);
    STAMP(10);
    if (IN(10)) { LAS int* ts = (LAS int*)(lds + TBL_OFF); moe_tables(P, ts, tid);
        pg8::Gemm g{(const bf16*)(P.ws + WS_ACT), (const bf16*)(P.ws + WS_WDN), 0, D, D / 2, (size_t)1024 * 512, nullptr}; pg8::MoeOrder S; S.init(ts[32] * 256, D, G, bx); S.ts = ts;
        pg8::EpiDown8 E{P.ws + WS_YB, P.bdn, (const float*)(P.ws + WS_SDN)}; DUP(10, pg8::gemm_phase<pg8::EpiDown8, pg8::MoeOrder, 1, false>(lds, g, S, E)); } SEAM(10);
#endif
    STAMP(11);
    if (IN(11)) { DUP(11, final_phase(P, vcu, G, tid)); }
#undef IN
#undef SEAM
}

extern "C" void kernel_launch(void* const* d_in, const int* in_sizes, int n_in, void* d_out, int out_size, void* d_ws, size_t ws_size, hipStream_t stream) {
    static int grid = 0;
    if (grid == 0) {
        if (n_in != 17 || out_size != T * D || ws_size < WS_END) { fprintf(stderr, "kernel_launch: unexpected shapes (n_in %d out %d ws %zu, need %zu)\n", n_in, out_size, ws_size, (size_t)WS_END); grid = -1; return; }
        int dev = 0, cus = 0;
        if (hipGetDevice(&dev) != hipSuccess || hipDeviceGetAttribute(&cus, hipDeviceAttributeMultiprocessorCount, dev) != hipSuccess) { grid = -1; return; }
        if (hipFuncSetAttribute((const void*)fwd, hipFuncAttributeMaxDynamicSharedMemorySize, LDS_BYTES) != hipSuccess) { grid = -1; return; }
        int per_cu = 0; (void)hipOccupancyMaxActiveBlocksPerMultiprocessor(&per_cu, (const void*)fwd, 512, LDS_BYTES); (void)hipGetLastError();
        grid = cus;
    }
    if (grid < 0) return;
    (void)hipMemsetAsync((char*)d_ws + WS_CTL, 0, CTL_ZERO_BYTES, stream);
    Args a{};
    for (int i = 0; i < 17; ++i) a.in[i] = (const float*)d_in[i];
    a.out = (float*)d_out; a.ws = (unsigned char*)d_ws;
    if (MK_N_LAUNCHES == 1) { a.ph_lo = 0; a.ph_hi = N_PHASES; hipLaunchKernelGGL(fwd, dim3(grid), dim3(512), LDS_BYTES, stream, a); }
    else { for (int p = 0; p < N_PHASES; ++p) { a.ph_lo = p; a.ph_hi = p + 1; hipLaunchKernelGGL(fwd, dim3(grid), dim3(512), LDS_BYTES, stream, a); } }
}
```

```cpp
#include <hip/hip_runtime.h>
#include <cstdio>
#include <cstdint>

#ifndef MK_N_LAUNCHES
#define MK_N_LAUNCHES 1
#endif
#ifndef DUP_MASK
#define DUP_MASK 0
#endif
#ifndef STAMP_PHASE
#define STAMP_PHASE -1
#endif
#ifndef BRINGUP
#define BRINGUP 0
#endif

#define DI __device__ __forceinline__
#define LAS __attribute__((address_space(3)))
#define GAS __attribute__((address_space(1)))
typedef unsigned short bf16;
typedef short bf16x8 __attribute__((ext_vector_type(8)));
typedef short s16x4 __attribute__((ext_vector_type(4)));
typedef short v4i16_t __attribute__((ext_vector_type(4)));
typedef float f32x4 __attribute__((ext_vector_type(4)));
typedef float f32x2 __attribute__((ext_vector_type(2)));
typedef unsigned u32x4 __attribute__((ext_vector_type(4)));
typedef unsigned u32x2 __attribute__((ext_vector_type(2)));
typedef __bf16 bf16v2 __attribute__((ext_vector_type(2)));
typedef GAS unsigned gu32;
#define RLX_AGENT __ATOMIC_RELAXED, __HIP_MEMORY_SCOPE_AGENT
#define LDS_WAIT() asm volatile("s_waitcnt lgkmcnt(0)" ::: "memory")
#define VM_WAIT() asm volatile("s_waitcnt vmcnt(0)" ::: "memory")

DI unsigned pk2(float a, float b) { bf16v2 v; v.x = (__bf16)a; v.y = (__bf16)b; return __builtin_bit_cast(unsigned, v); }
DI float bflo(unsigned w) { return __uint_as_float(w << 16); }
DI float bfhi(unsigned w) { return __uint_as_float(w & 0xffff0000u); }
DI float bf2f(bf16 b) { return __uint_as_float(((unsigned)b) << 16); }
DI bf16 f2bf(float f) { return (bf16)(pk2(f, 0.f) & 0xffffu); }
DI float sigmoidf_fast(float z) { return __builtin_amdgcn_rcpf(1.0f + __builtin_amdgcn_exp2f(-1.4426950408889634f * z)); }
DI bf16x8 cat8(s16x4 lo, s16x4 hi) { bf16x8 r; r[0] = lo[0]; r[1] = lo[1]; r[2] = lo[2]; r[3] = lo[3]; r[4] = hi[0]; r[5] = hi[1]; r[6] = hi[2]; r[7] = hi[3]; return r; }
#define MFMA16(a, b, c) __builtin_amdgcn_mfma_f32_16x16x32_bf16((a), (b), (c), 0, 0, 0)

constexpr int T = 32768, SEQ = 16384, D = 1024, NP = 10240, IN_W = 9744;
constexpr int C_GQ = 4608, C_GK = 5120, C_GV = 5632, C_GOG = 6656, C_GF = 7680, C_MA = 8192, C_MB = 9216;
constexpr int NEXP = 32, NASG = T * 4, MAXTILES = 544;
constexpr float RMS_EPS = 1e-5f;

namespace pg8 {
#define PG8_LAS __attribute__((address_space(3)))
typedef unsigned short bf16_t;
constexpr int BM = 256, BK = 64, HALF = 128, HTB = HALF * BK * 2, STAGE_BYTES = 8 * HTB, NXCD = 8, WGM = 8;
__host__ __device__ __forceinline__ int lds_byte(int r, int c) { const int st = (r >> 4) * 2 + (c >> 5), rr = r & 15, cc = c & 31, ob = rr * 64 + cc * 2; return st * 1024 + (ob ^ (((ob >> 9) & 1) << 5)); }
__host__ __device__ __forceinline__ void stage_rc(int b, int& R, int& C) { const int st = b / 1024, sb = b % 1024, swz = sb ^ (((sb >> 9) & 1) << 5); R = (st >> 1) * 16 + swz / 64; C = (st & 1) * 32 + (swz % 64) / 2; }
__host__ __device__ __forceinline__ int perm32(int rho) { const int n = rho >> 4, i = rho & 15; return 8 * (i >> 2) + 4 * n + (i & 3); }

struct Unit { int pm, pn, e; };
struct Gemm { const bf16_t* A; const bf16_t* Bt; int M, N, K; size_t bstride; const PG8_LAS unsigned short* lt; };

struct StaticOrder {
    int nM, nN, nwg, G, c, ibeg = 0, iend = 0x7fffffff;
    __host__ __device__ void init(int M, int N, int G_, int c_) { nM = M / BM; nN = N / BM; nwg = nM * nN; G = G_; c = c_; ibeg = 0; iend = 0x7fffffff; }
    __host__ __device__ bool next(int i, Unit& u) const {
        i += ibeg; if (i >= iend) return false;
        const long L = (long)i * G + c; if (L >= nwg) return false;
        int wgid = (int)L; { const int q = nwg / NXCD, r = nwg % NXCD, xcd = wgid % NXCD, off = wgid / NXCD; wgid = (xcd < r ? xcd * (q + 1) : r * (q + 1) + (xcd - r) * q) + off; }
        const int nig = WGM * nN, gid = wgid / nig, fm = gid * WGM, gsz = (nM - fm) < WGM ? (nM - fm) : WGM;
        u.pm = fm + ((wgid % nig) % gsz); u.pn = (wgid % nig) / gsz; u.e = 0; return true;
    }
};
struct MoeOrder : StaticOrder {
    const PG8_LAS int* ts;
    __device__ __forceinline__ bool next(int i, Unit& u) const {
        if (!StaticOrder::next(i, u)) return false;
        int e = 0;
#pragma unroll 1
        while (e < 31 && u.pm >= ts[e + 1]) ++e;
        u.e = e; return true;
    }
};

struct EpiStoreBf16 {
    static constexpr bool PERM = true, HAS_VEC = false;
    bf16_t* O; int ldc; const float* bias; int bias_estride;
    __device__ __forceinline__ void operator()(const f32x4 (&acc)[2][2][4][2], const Unit& u, int wr, int wc, int fr, int fq, const PG8_LAS float* vec) const {
        const int row0 = u.pm * BM + wr * 64 + fr, col0 = u.pn * BM + wc * 32 + 8 * fq;
        f32x4 bv[2][2];
#pragma unroll
        for (int bj = 0; bj < 2; ++bj)
#pragma unroll
            for (int n = 0; n < 2; ++n) bv[bj][n] = bias ? *(const f32x4*)(bias + (size_t)u.e * bias_estride + col0 + bj * HALF + 4 * n) : (f32x4){0.f, 0.f, 0.f, 0.f};
#pragma unroll
        for (int ai = 0; ai < 2; ++ai)
#pragma unroll
            for (int m = 0; m < 4; ++m) { bf16_t* rowp = O + (size_t)(row0 + ai * HALF + m * 16) * ldc + col0;
#pragma unroll
                for (int bj = 0; bj < 2; ++bj) { const f32x4 v0 = acc[ai][bj][m][0] + bv[bj][0], v1 = acc[ai][bj][m][1] + bv[bj][1];
                    u32x4 w; w.x = pk2(v0[0], v0[1]); w.y = pk2(v0[2], v0[3]); w.z = pk2(v1[0], v1[1]); w.w = pk2(v1[2], v1[3]);
                    *(u32x4*)(rowp + bj * HALF) = w; } }
    }
};
template <bool I8> struct EpiProj {
    static constexpr bool PERM = true, HAS_VEC = I8;
    bf16_t* P; const float* bgk2; const float* sx; const float* sw;
    __device__ __forceinline__ const float* vec_src(const Unit& u, int L) const { const int o = (L & 63) * 4; return L < 64 ? sw + u.pn * BM + o : sx + u.pm * BM + o; }
    template <bool ISG, bool F8> __device__ __forceinline__ void block(const f32x4 (&acc)[2][2][4][2], int bj, int cb, size_t base, int pitch, int dsh, float sc, int row0, int x0, int wr, int fr, const PG8_LAS float* vec) const {
        f32x4 b0 = {0.f, 0.f, 0.f, 0.f}, b1 = {0.f, 0.f, 0.f, 0.f};
        if (ISG) { b0 = *(const f32x4*)(bgk2 + (cb - 60) * 128 + x0); b1 = *(const f32x4*)(bgk2 + (cb - 60) * 128 + x0 + 4); }
        f32x4 c0 = {sc, sc, sc, sc}, c1 = {sc, sc, sc, sc};
        if (I8) { c0 = *(const PG8_LAS f32x4*)(vec + bj * HALF + x0) * sc; c1 = *(const PG8_LAS f32x4*)(vec + bj * HALF + x0 + 4) * sc; }
#pragma unroll
        for (int ai = 0; ai < 2; ++ai)
#pragma unroll
            for (int m = 0; m < 4; ++m) { const int r = row0 + ai * HALF + m * 16, s = r & (SEQ - 1); const size_t rp = (size_t)(r & ~(SEQ - 1)) + (size_t)((s & ((1 << dsh) - 1)) << (14 - dsh)) + (size_t)(s >> dsh);
                f32x4 v0 = acc[ai][bj][m][0], v1 = acc[ai][bj][m][1];
                if (I8) { const float rs = vec[256 + wr * 64 + fr + ai * HALF + m * 16]; const f32x4 d0 = c0 * rs, d1 = c1 * rs;
#pragma unroll
                    for (int j = 0; j < 4; ++j) { v0[j] = (float)__float_as_int(v0[j]) * d0[j]; v1[j] = (float)__float_as_int(v1[j]) * d1[j]; } }
                else { v0 = v0 * c0; v1 = v1 * c1; }
                if (ISG) {
#pragma unroll
                    for (int j = 0; j < 4; ++j) { const float xa = v0[j] + b0[j], xb = v1[j] + b1[j];
                        v0[j] = (fminf(xa, 0.f) - __logf(1.0f + __expf(-fabsf(xa)))) * (1.0f / 16.0f); v1[j] = (fminf(xb, 0.f) - __logf(1.0f + __expf(-fabsf(xb)))) * (1.0f / 16.0f); } }
                if (F8) { int w0 = 0, w1 = 0; w0 = __builtin_amdgcn_cvt_pk_fp8_f32(v0[0], v0[1], w0, false); w0 = __builtin_amdgcn_cvt_pk_fp8_f32(v0[2], v0[3], w0, true);
                    w1 = __builtin_amdgcn_cvt_pk_fp8_f32(v1[0], v1[1], w1, false); w1 = __builtin_amdgcn_cvt_pk_fp8_f32(v1[2], v1[3], w1, true);
                    u32x2 w; w.x = (unsigned)w0; w.y = (unsigned)w1; *(u32x2*)((unsigned char*)P + 2 * base + rp * pitch + x0) = w; }
                else { u32x4 w; w.x = pk2(v0[0], v0[1]); w.y = pk2(v0[2], v0[3]); w.z = pk2(v1[0], v1[1]); w.w = pk2(v1[2], v1[3]);
                    *(u32x4*)(P + base + rp * pitch + x0) = w; } }
    }
    __device__ __forceinline__ void operator()(const f32x4 (&acc)[2][2][4][2], const Unit& u, int wr, int wc, int fr, int fq, const PG8_LAS float* vec) const {
        const int row0 = u.pm * BM + wr * 64 + fr, x0 = wc * 32 + 8 * fq;
#pragma unroll
        for (int bj = 0; bj < 2; ++bj) { const int cb = __builtin_amdgcn_readfirstlane(2 * u.pn + bj);
            size_t base; int pitch = 128, dsh = 0; float sc = 1.0f;
            if (cb < 36) { base = (size_t)cb * T * 128; dsh = 2 * (cb / 12); if ((cb % 12) < 4) sc = 0.08838834764831845f * 1.4426950408889634f; }
            else if (cb < 44) { base = (size_t)cb * T * 128; if (cb < 40) sc = 0.08838834764831845f; }
            else if (cb < 60) { const int gb = (cb < 52) ? 44 : 52; base = (size_t)gb * T * 128 + (size_t)((cb - gb) >> 1) * T * 256 + ((cb - gb) & 1) * 128; pitch = 256; }
            else if (cb < 64) { base = (size_t)cb * T * 128; }
            else { base = (size_t)64 * T * 128 + (size_t)(cb - 64) * 64; pitch = 2048; }
            if (cb >= 60 && cb < 64) block<true, false>(acc, bj, cb, base, pitch, dsh, sc, row0, x0, wr, fr, vec);
            else if (cb >= 64 || cb < 36) block<false, true>(acc, bj, cb, base, pitch, dsh, sc, row0, x0, wr, fr, vec);
            else block<false, false>(acc, bj, cb, base, pitch, dsh, sc, row0, x0, wr, fr, vec); }
    }
};
template <bool ADD> struct EpiGate {
    static constexpr bool PERM = true, HAS_VEC = false; static constexpr int NSTORE = 16;
    bf16_t* O; const unsigned char* G8; unsigned char* PART8;
    __device__ __forceinline__ void operator()(const f32x4 (&acc)[2][2][4][2], const Unit& u, int wr, int wc, int fr, int fq, const PG8_LAS float* vec) const {
        const int row0 = u.pm * BM + wr * 64 + fr, col0 = u.pn * BM + wc * 32 + 8 * fq;
#pragma unroll
        for (int ai = 0; ai < 2; ++ai)
#pragma unroll
            for (int m = 0; m < 4; ++m) { const size_t r = (size_t)(row0 + ai * HALF + m * 16);
#pragma unroll
                for (int bj = 0; bj < 2; ++bj) { const u32x2 gw = *(const u32x2*)(G8 + r * 2048 + col0 + bj * HALF);
                    u32x2 pw = {0u, 0u}; if (ADD) pw = *(const u32x2*)(PART8 + r * D + col0 + bj * HALF);
                    const f32x2 g0 = __builtin_amdgcn_cvt_pk_f32_fp8((int)gw.x, false), g1 = __builtin_amdgcn_cvt_pk_f32_fp8((int)gw.x, true), g2 = __builtin_amdgcn_cvt_pk_f32_fp8((int)gw.y, false), g3 = __builtin_amdgcn_cvt_pk_f32_fp8((int)gw.y, true);
                    f32x2 p0 = {0.f, 0.f}, p1 = {0.f, 0.f}, p2 = {0.f, 0.f}, p3 = {0.f, 0.f};
                    if (ADD) { p0 = __builtin_amdgcn_cvt_pk_f32_fp8((int)pw.x, false); p1 = __builtin_amdgcn_cvt_pk_f32_fp8((int)pw.x, true); p2 = __builtin_amdgcn_cvt_pk_f32_fp8((int)pw.y, false); p3 = __builtin_amdgcn_cvt_pk_f32_fp8((int)pw.y, true); }
                    const f32x4 v0 = acc[ai][bj][m][0], v1 = acc[ai][bj][m][1];
                    const float r0 = p0.x + sigmoidf_fast(g0.x) * v0[0], r1 = p0.y + sigmoidf_fast(g0.y) * v0[1], r2 = p1.x + sigmoidf_fast(g1.x) * v0[2], r3 = p1.y + sigmoidf_fast(g1.y) * v0[3];
                    const float r4 = p2.x + sigmoidf_fast(g2.x) * v1[0], r5 = p2.y + sigmoidf_fast(g2.y) * v1[1], r6 = p3.x + sigmoidf_fast(g3.x) * v1[2], r7 = p3.y + sigmoidf_fast(g3.y) * v1[3];
                    if (ADD) { u32x4 w; w.x = pk2(r0, r1); w.y = pk2(r2, r3); w.z = pk2(r4, r5); w.w = pk2(r6, r7); *(u32x4*)(O + r * D + col0 + bj * HALF) = w; }
                    else { int w0 = 0, w1 = 0; w0 = __builtin_amdgcn_cvt_pk_fp8_f32(r0, r1, w0, false); w0 = __builtin_amdgcn_cvt_pk_fp8_f32(r2, r3, w0, true); w1 = __builtin_amdgcn_cvt_pk_fp8_f32(r4, r5, w1, false); w1 = __builtin_amdgcn_cvt_pk_fp8_f32(r6, r7, w1, true);
                        u32x2 w; w.x = (unsigned)w0; w.y = (unsigned)w1; *(u32x2*)(PART8 + r * D + col0 + bj * HALF) = w; } } }
    }
};
struct EpiResBf16 {
    static constexpr bool PERM = true, HAS_VEC = false; static constexpr int NSTORE = 16;
    const float* base; bf16_t* O; float* PS;
    __device__ __forceinline__ void operator()(const f32x4 (&acc)[2][2][4][2], const Unit& u, int wr, int wc, int fr, int fq, const PG8_LAS float* vec) const {
        const int row0 = u.pm * BM + wr * 64 + fr, col0 = u.pn * BM + wc * 32 + 8 * fq;
#pragma unroll
        for (int ai = 0; ai < 2; ++ai)
#pragma unroll
            for (int m = 0; m < 4; ++m) { const size_t off = (size_t)(row0 + ai * HALF + m * 16) * D + col0; float ss = 0.f;
#pragma unroll
                for (int bj = 0; bj < 2; ++bj) { const f32x4 v0 = *(const f32x4*)(base + off + bj * HALF) + acc[ai][bj][m][0], v1 = *(const f32x4*)(base + off + bj * HALF + 4) + acc[ai][bj][m][1];
                    ss += (v0[0] * v0[0] + v0[1] * v0[1]) + (v0[2] * v0[2] + v0[3] * v0[3]) + (v1[0] * v1[0] + v1[1] * v1[1]) + (v1[2] * v1[2] + v1[3] * v1[3]);
                    u32x4 w; w.x = pk2(v0[0], v0[1]); w.y = pk2(v0[2], v0[3]); w.z = pk2(v1[0], v1[1]); w.w = pk2(v1[2], v1[3]);
                    *(u32x4*)(O + off + bj * HALF) = w; }
                ss += __shfl_xor(ss, 16); ss += __shfl_xor(ss, 32);
                if (fq == 0) PS[(size_t)(u.pn * 4 + wc) * T + row0 + ai * HALF + m * 16] = ss; }
    }
};
struct EpiSwiGLU8 {
    static constexpr bool PERM = true, HAS_VEC = true;
    unsigned char* O; const float* bup; const float* cs;
    __device__ __forceinline__ const float* vec_src(const Unit& u, int L) const { const int seg = L >> 5, o = (L & 31) * 4;
        return seg == 0 ? bup + (size_t)u.e * 2048 + u.pn * 128 + o : seg == 1 ? bup + (size_t)u.e * 2048 + 1024 + u.pn * 128 + o : seg == 2 ? cs + (size_t)u.e * 2048 + u.pn * 256 + o : cs + (size_t)u.e * 2048 + u.pn * 256 + 128 + o; }
    __device__ __forceinline__ void operator()(const f32x4 (&acc)[2][2][4][2], const Unit& u, int wr, int wc, int fr, int fq, const PG8_LAS float* vec) const {
        const int row0 = u.pm * BM + wr * 64 + fr, x0 = wc * 32 + 8 * fq;
        const f32x4 bgv[2] = {*(const PG8_LAS f32x4*)(vec + x0), *(const PG8_LAS f32x4*)(vec + x0 + 4)}, blv[2] = {*(const PG8_LAS f32x4*)(vec + 128 + x0), *(const PG8_LAS f32x4*)(vec + 128 + x0 + 4)};
        const f32x4 sgv[2] = {*(const PG8_LAS f32x4*)(vec + 256 + x0), *(const PG8_LAS f32x4*)(vec + 256 + x0 + 4)}, slv[2] = {*(const PG8_LAS f32x4*)(vec + 384 + x0), *(const PG8_LAS f32x4*)(vec + 384 + x0 + 4)};
#pragma unroll
        for (int ai = 0; ai < 2; ++ai)
#pragma unroll
            for (int m = 0; m < 4; ++m) { float r[8];
#pragma unroll
                for (int n = 0; n < 2; ++n) { const f32x4 gv = acc[ai][0][m][n] * sgv[n] + bgv[n], lv = acc[ai][1][m][n] * slv[n] + blv[n];
#pragma unroll
                    for (int j = 0; j < 4; ++j) { const float xg = fminf(gv[j], 7.0f), xl = fminf(fmaxf(lv[j], -7.0f), 7.0f); r[4 * n + j] = xg * sigmoidf_fast(1.702f * xg) * (xl + 1.0f); } }
                int w0 = 0, w1 = 0;
                w0 = __builtin_amdgcn_cvt_pk_fp8_f32(r[0], r[1], w0, false); w0 = __builtin_amdgcn_cvt_pk_fp8_f32(r[2], r[3], w0, true);
                w1 = __builtin_amdgcn_cvt_pk_fp8_f32(r[4], r[5], w1, false); w1 = __builtin_amdgcn_cvt_pk_fp8_f32(r[6], r[7], w1, true);
                u32x2 w; w.x = (unsigned)w0; w.y = (unsigned)w1;
                *(u32x2*)(O + (size_t)(row0 + ai * HALF + m * 16) * D + u.pn * 128 + x0) = w; }
    }
};
struct EpiDown8 {
    static constexpr bool PERM = true, HAS_VEC = true;
    unsigned char* O; const float* bias; const float* cs;
    __device__ __forceinline__ const float* vec_src(const Unit& u, int L) const { const int o = (L & 63) * 4; return (L < 64 ? bias : cs) + (size_t)u.e * D + u.pn * BM + o; }
    __device__ __forceinline__ void operator()(const f32x4 (&acc)[2][2][4][2], const Unit& u, int wr, int wc, int fr, int fq, const PG8_LAS float* vec) const {
        const int row0 = u.pm * BM + wr * 64 + fr, col0 = u.pn * BM + wc * 32 + 8 * fq;
        f32x4 bv[2][2], sv[2][2];
#pragma unroll
        for (int bj = 0; bj < 2; ++bj)
#pragma unroll
            for (int n = 0; n < 2; ++n) { bv[bj][n] = *(const PG8_LAS f32x4*)(vec + wc * 32 + 8 * fq + bj * HALF + 4 * n); sv[bj][n] = *(const PG8_LAS f32x4*)(vec + 256 + wc * 32 + 8 * fq + bj * HALF + 4 * n); }
#pragma unroll
        for (int ai = 0; ai < 2; ++ai)
#pragma unroll
            for (int m = 0; m < 4; ++m) { unsigned char* rowp = O + (size_t)(row0 + ai * HALF + m * 16) * D + col0;
#pragma unroll
                for (int bj = 0; bj < 2; ++bj) { const f32x4 v0 = acc[ai][bj][m][0] * sv[bj][0] + bv[bj][0], v1 = acc[ai][bj][m][1] * sv[bj][1] + bv[bj][1];
                    int w0 = 0, w1 = 0; w0 = __builtin_amdgcn_cvt_pk_fp8_f32(v0[0], v0[1], w0, false); w0 = __builtin_amdgcn_cvt_pk_fp8_f32(v0[2], v0[3], w0, true);
                    w1 = __builtin_amdgcn_cvt_pk_fp8_f32(v1[0], v1[1], w1, false); w1 = __builtin_amdgcn_cvt_pk_fp8_f32(v1[2], v1[3], w1, true);
                    u32x2 w; w.x = (unsigned)w0; w.y = (unsigned)w1; *(u32x2*)(rowp + bj * HALF) = w; } }
    }
};
constexpr int EPV_OFF = 131072 + 12288;
typedef int v8i_t __attribute__((ext_vector_type(8)));
typedef int v4i_t __attribute__((ext_vector_type(4)));
template <class Epi, class Sched, int DT = 0, bool GATHER = false, bool ALIGN_EPI = true, bool SP2 = true>
__device__ __forceinline__ void gemm_phase(PG8_LAS unsigned char* lds, const Gemm g, const Sched& S, const Epi& E, const int tid = threadIdx.x) {
    const int wid = __builtin_amdgcn_readfirstlane(tid >> 6), lane = tid & 63, wr = wid >> 2, wc = wid & 3, fr = lane & 15, fq = lane >> 4;
    const int K = g.K, nt = K / BK;
    unsigned voffA[2], voffB[2]; int gR[2], gC[2];
#pragma unroll
    for (int i = 0; i < 2; ++i) { int R, C; stage_rc(tid * 16 + i * 8192, R, C); const int Rb = Epi::PERM ? ((R & ~31) + perm32(R & 31)) : R;
        voffA[i] = (unsigned)(R * K + C) * 2u; voffB[i] = (unsigned)(Rb * K + C) * 2u; gR[i] = R; gC[i] = C * 2; }
    unsigned offC[2][2], offN[2][2];
#define PG8_GOFF(dst, uidx) do { _Pragma("unroll") for (int _h = 0; _h < 2; ++_h) _Pragma("unroll") for (int _i = 0; _i < 2; ++_i) \
        dst[_h][_i] = (unsigned)g.lt[(uidx) * 256 + _h * 128 + gR[_i]] * (unsigned)(K * 2) + (unsigned)gC[_i]; } while (0)
    const size_t kstep = (size_t)(BK * 2), hstep = (size_t)HALF * K * 2, tstep = 2 * hstep, estep = g.bstride * 2;
    const unsigned ldsw = (unsigned)wid * 1024u;
    const int aoff = lds_byte(wr * 64 + fr, fq * 8), boff = lds_byte(wc * 32 + fr, fq * 8);
#define PG8_SA(b, h) (((b) * 2 + (h)) * HTB)
#define PG8_SB(b, h) ((4 + (b) * 2 + (h)) * HTB)
#define PG8_STAGE(bufoff, gbase, voff) do { _Pragma("unroll") for (int _i = 0; _i < 2; ++_i) \
        __builtin_amdgcn_global_load_lds((const unsigned*)((const char*)(gbase) + (voff)[_i]), (PG8_LAS unsigned*)(lds + (bufoff) + ldsw + _i * 8192), 16, 0, 0); } while (0)
#define PG8_LDA(dst, b, h) do { if constexpr (DT == 1) { _Pragma("unroll") for (int m = 0; m < 4; ++m) dst##8[m] = __builtin_shufflevector(*(const PG8_LAS v4i_t*)(lds + PG8_SA(b, h) + aoff + m * 2048), *(const PG8_LAS v4i_t*)(lds + PG8_SA(b, h) + aoff + m * 2048 + 1024), 0, 1, 2, 3, 4, 5, 6, 7); } \
        else { _Pragma("unroll") for (int m = 0; m < 4; ++m) _Pragma("unroll") for (int k = 0; k < 2; ++k) dst[m][k] = *(const PG8_LAS bf16x8*)(lds + PG8_SA(b, h) + aoff + m * 2048 + k * 1024); } } while (0)
#define PG8_LDB(dst, b, h) do { if constexpr (DT == 1) { _Pragma("unroll") for (int n = 0; n < 2; ++n) dst##8[n] = __builtin_shufflevector(*(const PG8_LAS v4i_t*)(lds + PG8_SB(b, h) + boff + n * 2048), *(const PG8_LAS v4i_t*)(lds + PG8_SB(b, h) + boff + n * 2048 + 1024), 0, 1, 2, 3, 4, 5, 6, 7); } \
        else { _Pragma("unroll") for (int n = 0; n < 2; ++n) _Pragma("unroll") for (int k = 0; k < 2; ++k) dst[n][k] = *(const PG8_LAS bf16x8*)(lds + PG8_SB(b, h) + boff + n * 2048 + k * 1024); } } while (0)
#define PG8_MMA(ai, bj, At, Bt) do { __builtin_amdgcn_s_setprio(1); if constexpr (DT == 1) { _Pragma("unroll") for (int m = 0; m < 4; ++m) _Pragma("unroll") for (int n = 0; n < 2; ++n) \
        asm volatile("v_mfma_scale_f32_16x16x128_f8f6f4 %0, %1, %2, %0, %3, %3 op_sel_hi:[0,0,0]" : "+v"(acc[ai][bj][m][n]) : "v"(Bt##8[n]), "v"(At##8[m]), "v"(sc1)); } \
        else if constexpr (DT == 2) { _Pragma("unroll") for (int m = 0; m < 4; ++m) _Pragma("unroll") for (int n = 0; n < 2; ++n) _Pragma("unroll") for (int k = 0; k < 2; ++k) \
        asm volatile("v_mfma_i32_16x16x64_i8 %0, %1, %2, %0" : "+v"(acc[ai][bj][m][n]) : "v"(Bt[n][k]), "v"(At[m][k])); } \
        else { _Pragma("unroll") for (int m = 0; m < 4; ++m) _Pragma("unroll") for (int n = 0; n < 2; ++n) _Pragma("unroll") for (int k = 0; k < 2; ++k) \
        acc[ai][bj][m][n] = __builtin_amdgcn_mfma_f32_16x16x32_bf16(Bt[n][k], At[m][k], acc[ai][bj][m][n], 0, 0, 0); } __builtin_amdgcn_s_setprio(0); } while (0)
#define PG8_STAGE_A(bufoff, h, which) do { if constexpr (GATHER) { _Pragma("unroll") for (int _i = 0; _i < 2; ++_i) { \
            const unsigned _o = ((which) == 1) ? offC[h][_i] : (last ? offN[h][_i] : offC[h][_i]); const size_t _kb = ((which) == 1) ? (size_t)(t + 1) * kstep : ((last ? (size_t)0 : (size_t)(t + 2) * kstep) + ((which) == 3 ? kstep : 0)); \
            __builtin_amdgcn_global_load_lds((const unsigned*)((const char*)g.A + _kb + _o), (PG8_LAS unsigned*)(lds + (bufoff) + ldsw + _i * 8192), 16, 0, 0); } } \
        else { const char* _p = ((which) == 1 ? a1 : ((which) == 2 ? a2 : a3)) + (h) * hstep; PG8_STAGE(bufoff, _p, voffA); } } while (0)
#define PG8_WAIT_V(n) asm volatile("s_waitcnt vmcnt(" #n ")" ::: "memory")
#define PG8_WAIT_L(n) asm volatile("s_waitcnt lgkmcnt(" #n ")" ::: "memory")
#define PG8_BAR __builtin_amdgcn_s_barrier()
#define PG8_SCHED __builtin_amdgcn_sched_barrier(0)
    static_assert(!GATHER || SP2, "GATHER is written for the SP2 loop");
    Unit cur, nxt; int ui = 0;
    if (!S.next(0, cur)) return;
#define PG8_EPV(u, uidx) do { if constexpr (Epi::HAS_VEC) { int _te = tid; asm volatile("" : "+v"(_te)); if (wid < 2) __builtin_amdgcn_global_load_lds((const unsigned*)E.vec_src(u, _te), (PG8_LAS unsigned*)(lds + EPV_OFF + ((uidx) & 1) * 2048 + wid * 1024), 16, 0, 0); } } while (0)
    PG8_EPV(cur, 0);
    f32x4 acc[2][2][4][2];
#pragma unroll
    for (int a = 0; a < 2; ++a)
#pragma unroll
        for (int b = 0; b < 2; ++b)
#pragma unroll
            for (int m = 0; m < 4; ++m)
#pragma unroll
                for (int n = 0; n < 2; ++n) acc[a][b][m][n] = (f32x4){0.f, 0.f, 0.f, 0.f};
    bf16x8 At[4][2], B0[2][2], B1[2][2]; v8i_t At8[4], B08[2], B18[2];
    int sc1 = 0x7F7F7F7F; asm volatile("" : "+v"(sc1));
    const char* cA = GATHER ? (const char*)g.A : (const char*)g.A + (size_t)cur.pm * tstep; const char* cB = (const char*)g.Bt + (size_t)cur.e * estep + (size_t)cur.pn * tstep;
    if constexpr (GATHER) { PG8_GOFF(offC, 0); }
#define PG8_STAGE_A0(bufoff, h, kb) do { if constexpr (GATHER) { _Pragma("unroll") for (int _i = 0; _i < 2; ++_i) \
            __builtin_amdgcn_global_load_lds((const unsigned*)((const char*)g.A + (size_t)(kb) + offC[h][_i]), (PG8_LAS unsigned*)(lds + (bufoff) + ldsw + _i * 8192), 16, 0, 0); } \
        else PG8_STAGE(bufoff, cA + (h) * hstep + (kb), voffA); } while (0)
    if constexpr (SP2) {
        PG8_STAGE(PG8_SB(0, 0), cB, voffB); PG8_STAGE(PG8_SB(0, 1), cB + hstep, voffB); PG8_STAGE_A0(PG8_SA(0, 0), 0, 0); PG8_STAGE_A0(PG8_SA(0, 1), 1, 0);
        if (wr == 1) PG8_BAR;
        PG8_WAIT_V(2); PG8_BAR;
        PG8_STAGE(PG8_SB(1, 0), cB + kstep, voffB); PG8_STAGE_A0(PG8_SA(1, 0), 0, kstep); PG8_STAGE(PG8_SB(1, 1), cB + hstep + kstep, voffB);
        PG8_WAIT_V(6); PG8_BAR;
    } else {
        PG8_STAGE(PG8_SB(0, 0), cB, voffB); PG8_STAGE(PG8_SA(0, 0), cA, voffA); PG8_STAGE(PG8_SB(0, 1), cB + hstep, voffB); PG8_STAGE(PG8_SA(0, 1), cA + hstep, voffA);
        if (wr == 1) PG8_BAR;
        PG8_WAIT_V(4); PG8_BAR;
        PG8_STAGE(PG8_SB(1, 0), cB + kstep, voffB); PG8_STAGE(PG8_SA(1, 0), cA + kstep, voffA); PG8_STAGE(PG8_SB(1, 1), cB + hstep + kstep, voffB);
        PG8_WAIT_V(6); PG8_BAR;
    }
    for (;;) {
        const bool has_next = S.next(ui + 1, nxt);
        const char* nA = (has_next && !GATHER) ? (const char*)g.A + (size_t)nxt.pm * tstep : cA; const char* nB = has_next ? (const char*)g.Bt + (size_t)nxt.e * estep + (size_t)nxt.pn * tstep : cB;
        if constexpr (GATHER) { if (has_next) { PG8_GOFF(offN, ui + 1); } else {
#pragma unroll
            for (int _h = 0; _h < 2; ++_h) { offN[_h][0] = offC[_h][0]; offN[_h][1] = offC[_h][1]; } } }
#pragma unroll 1
        for (int t = 0; t < nt; t += 2) {
            const bool last = (t == nt - 2);
            const char* a1 = cA + (size_t)(t + 1) * kstep;
            const char* a2 = last ? nA : cA + (size_t)(t + 2) * kstep; const char* b2 = last ? nB : cB + (size_t)(t + 2) * kstep;
            const char* a3 = a2 + kstep; const char* b3 = b2 + kstep;
            if constexpr (SP2) {
            PG8_LDB(B0, 0, 0); PG8_LDB(B1, 0, 1); PG8_SCHED; PG8_LDA(At, 0, 0); PG8_STAGE_A(PG8_SA(1, 1), 1, 1);
            PG8_WAIT_V(8); PG8_WAIT_L(0); PG8_BAR; PG8_MMA(0, 0, At, B0); PG8_MMA(0, 1, At, B1); PG8_BAR; PG8_SCHED;
            PG8_LDA(At, 0, 1); PG8_STAGE(PG8_SB(0, 0), b2, voffB); PG8_STAGE(PG8_SB(0, 1), b2 + hstep, voffB); PG8_STAGE_A(PG8_SA(0, 0), 0, 2);
            PG8_WAIT_V(8); PG8_WAIT_L(0); PG8_BAR; PG8_MMA(1, 0, At, B0); PG8_MMA(1, 1, At, B1); PG8_BAR; PG8_SCHED;
            PG8_LDB(B0, 1, 0); PG8_LDB(B1, 1, 1); PG8_SCHED; PG8_LDA(At, 1, 0); PG8_STAGE_A(PG8_SA(0, 1), 1, 2);
            PG8_WAIT_V(8); PG8_WAIT_L(0); PG8_BAR; PG8_MMA(0, 0, At, B0); PG8_MMA(0, 1, At, B1); PG8_BAR; PG8_SCHED;
            PG8_LDA(At, 1, 1); PG8_STAGE(PG8_SB(1, 0), b3, voffB); PG8_STAGE(PG8_SB(1, 1), b3 + hstep, voffB); PG8_STAGE_A(PG8_SA(1, 0), 0, 3);
            PG8_WAIT_V(8); PG8_WAIT_L(0); PG8_BAR; PG8_MMA(1, 0, At, B0); PG8_MMA(1, 1, At, B1); PG8_BAR; PG8_SCHED;
            } else {
            PG8_LDB(B0, 0, 0); PG8_SCHED; PG8_LDA(At, 0, 0); PG8_STAGE(PG8_SA(1, 1), a1 + hstep, voffA);
            PG8_WAIT_L(8); PG8_BAR; PG8_WAIT_L(0); PG8_MMA(0, 0, At, B0); PG8_BAR; PG8_SCHED;
            PG8_LDB(B1, 0, 1); PG8_STAGE(PG8_SB(0, 0), b2, voffB);
            PG8_BAR; PG8_WAIT_L(0); PG8_MMA(0, 1, At, B1); PG8_BAR;
            PG8_LDA(At, 0, 1); PG8_STAGE(PG8_SA(0, 0), a2, voffA);
            PG8_BAR; PG8_WAIT_L(0); PG8_MMA(1, 0, At, B0); PG8_BAR; PG8_SCHED;
            PG8_STAGE(PG8_SB(0, 1), b2 + hstep, voffB);
            PG8_WAIT_V(6); PG8_BAR; PG8_MMA(1, 1, At, B1); PG8_BAR;
            PG8_LDB(B0, 1, 0); PG8_SCHED; PG8_LDA(At, 1, 0); PG8_STAGE(PG8_SA(0, 1), a2 + hstep, voffA);
            PG8_WAIT_L(8); PG8_BAR; PG8_WAIT_L(0); PG8_MMA(0, 0, At, B0); PG8_BAR; PG8_SCHED;
            PG8_LDB(B1, 1, 1); PG8_STAGE(PG8_SB(1, 0), b3, voffB);
            PG8_BAR; PG8_WAIT_L(0); PG8_MMA(0, 1, At, B1); PG8_BAR;
            PG8_LDA(At, 1, 1); PG8_STAGE(PG8_SA(1, 0), a3, voffA);
            PG8_BAR; PG8_WAIT_L(0); PG8_MMA(1, 0, At, B0); PG8_BAR; PG8_SCHED;
            PG8_STAGE(PG8_SB(1, 1), b3 + hstep, voffB);
            PG8_WAIT_V(6); PG8_BAR; PG8_MMA(1, 1, At, B1); PG8_BAR;
            }
        }
        if constexpr (DT != 0) asm volatile("s_nop 15\n\ts_nop 15\n\ts_nop 7" ::: "memory");
        if constexpr (ALIGN_EPI) { if (wr == 0) PG8_BAR; }
        E(acc, cur, wr, wc, fr, fq, (const PG8_LAS float*)(lds + EPV_OFF + (ui & 1) * 2048));
        if (!has_next) break;
#pragma unroll
        for (int a = 0; a < 2; ++a)
#pragma unroll
            for (int b = 0; b < 2; ++b)
#pragma unroll
                for (int m = 0; m < 4; ++m)
#pragma unroll
                    for (int n = 0; n < 2; ++n) acc[a][b][m][n] = (f32x4){0.f, 0.f, 0.f, 0.f};
        cur = nxt; cA = nA; cB = nB; ++ui;
        PG8_EPV(cur, ui);
        if constexpr (GATHER) {
#pragma unroll
            for (int _h = 0; _h < 2; ++_h) { offC[_h][0] = offN[_h][0]; offC[_h][1] = offN[_h][1]; } }
        if constexpr (ALIGN_EPI) { if (wr == 1) PG8_BAR; }
    }
    PG8_WAIT_V(0);
    if constexpr (!ALIGN_EPI) { if (wr == 0) PG8_BAR; }
    PG8_BAR;
#undef PG8_SA
#undef PG8_SB
#undef PG8_STAGE
#undef PG8_EPV
#undef PG8_STAGE_A
#undef PG8_STAGE_A0
#undef PG8_GOFF
#undef PG8_LDA
#undef PG8_LDB
#undef PG8_MMA
#undef PG8_WAIT_V
#undef PG8_WAIT_L
#undef PG8_BAR
#undef PG8_SCHED
}
}

constexpr size_t MiB = 1u << 20;
constexpr size_t WS_CTL = 0, CTL_ZERO_BYTES = 1 * MiB;
constexpr size_t WS_ASG_E = 1 * MiB, WS_ASG_SLOT = WS_ASG_E + (size_t)NASG * 4, WS_ASG_G = WS_ASG_SLOT + (size_t)NASG * 4, WS_ASG_ROW = WS_ASG_G + (size_t)NASG * 4;
constexpr size_t WS_WRT = 3 * MiB;
constexpr size_t WS_SUP = WS_WRT + 64 * 1024, WS_SDN = WS_SUP + 32 * 2048 * 4;
constexpr size_t WS_ROWTOK = WS_SDN + 32 * 1024 * 4;
constexpr size_t WS_WPA = 4 * MiB, WS_WPB = 5 * MiB, WS_WOUT = 7 * MiB, WS_WIN = 9 * MiB;
constexpr size_t WS_WUP = 29 * MiB, WS_WDN = 93 * MiB;
constexpr size_t WS_XN = 125 * MiB;
constexpr size_t WS_GSTATE = WS_XN, WS_GDEC = WS_XN + 32 * MiB;
constexpr size_t WS_SX = WS_XN + 40 * MiB, WS_SWIN = WS_XN + 41 * MiB;
constexpr size_t WS_OA = 189 * MiB, WS_OB = 221 * MiB;
constexpr size_t WS_H1 = WS_OA;
constexpr size_t WS_HN = WS_OB + 32 * MiB;
constexpr size_t WS_PROJ = 285 * MiB;
constexpr size_t WS_ACT = WS_PROJ, WS_YB = WS_PROJ + 136 * MiB;
constexpr size_t WS_PS = WS_PROJ + 300 * MiB;
constexpr size_t WS_END = 925 * MiB;
static_assert(WS_ROWTOK + (size_t)MAXTILES * 256 * 4 <= WS_WPA && WS_PROJ + (size_t)T * NP * 2 == WS_END && WS_YB + (size_t)MAXTILES * 256 * D * 2 <= WS_END && (size_t)MAXTILES * 256 * D <= 136 * MiB, "d_ws map");
constexpr size_t OUT_OG = 0, OUT_LSE = 96 * MiB;
constexpr int CW_BAR = 4096, CW_CNT = 32768;
constexpr int RING_BYTES = 131072, MISC_OFF = RING_BYTES, TBL_OFF = RING_BYTES + 512, LDS_BYTES = 147456;

#define XB_TMO      128
#define XB_XCNT(j)  (256  + 64 * (j))
#define XB_XSUB(j)  (1280 + 64 * (j))
#define XB_XGEN(j)  (2304 + 64 * (j))
#define XB_TOP      3328
#define XB_TOPGEN   3392
#define XCD_BAR_WORDS 3456
#define XB_SPIN_CAP (1u << 18)
__device__ __forceinline__ unsigned xb_ld(unsigned* p)              { return __hip_atomic_load(p, __ATOMIC_RELAXED, __HIP_MEMORY_SCOPE_AGENT); }
__device__ __forceinline__ unsigned xb_add(unsigned* p, unsigned v) { return __hip_atomic_fetch_add(p, v, __ATOMIC_RELAXED, __HIP_MEMORY_SCOPE_AGENT); }
__device__ __forceinline__ unsigned xb_xcc_id() { return (unsigned)__builtin_amdgcn_s_getreg((3 << 11) | 20) & 0xFu; }
#define XB_SPIN(cond, bar) do { unsigned _sp = 0; while (cond) { __builtin_amdgcn_s_sleep(1); \
    if ((++_sp & 255u) == 0u) { if (xb_ld(&(bar)[XB_TMO])) break; if (_sp > XB_SPIN_CAP) { atomicAdd(&(bar)[XB_TMO], 1u); break; } } } } while (0)
struct XcdBarrier { unsigned* bar; unsigned x; volatile LAS unsigned* st; };
__device__ __forceinline__ XcdBarrier xcd_barrier_post(unsigned* bar, volatile LAS unsigned* st) {
    XcdBarrier b; b.bar = bar; b.x = xb_xcc_id(); b.st = st;
    if (threadIdx.x == 0) (void)xb_add(&bar[XB_XCNT(b.x)], 1u);
    return b;
}
__device__ __forceinline__ void xcd_barrier_complete(unsigned* bar, unsigned x, unsigned& nloc, unsigned& nx) {
    const unsigned G = gridDim.x * gridDim.y * gridDim.z;
    unsigned sum, cnt, mine, sp = 0u;
    for (;;) {
        sum = 0u; cnt = 0u; mine = 0u;
#pragma unroll
        for (unsigned j = 0; j < 16; ++j) { const unsigned c = xb_ld(&bar[XB_XCNT(j)]); sum += c; cnt += (c > 0u) ? 1u : 0u; mine = (j == x) ? c : mine; }
        if (sum == G) break;
        __builtin_amdgcn_s_sleep(1);
        if ((++sp & 255u) == 0u) { if (xb_ld(&bar[XB_TMO])) break; if (sp > XB_SPIN_CAP) { atomicAdd(&bar[XB_TMO], 1u); break; } }
    }
    nloc = mine > 0u ? mine : 1u; nx = cnt > 0u ? cnt : 1u;
}
__device__ __forceinline__ void xcd_barrier(const XcdBarrier& b) {
    asm volatile("s_waitcnt vmcnt(0)" ::: "memory");
    __syncthreads();
    if (threadIdx.x == 0) {
        unsigned* bar = b.bar;
        __builtin_amdgcn_s_waitcnt(0);
        unsigned nloc = b.st[0], nx = b.st[1];
        if (nloc == 0u) { xcd_barrier_complete(bar, b.x, nloc, nx); b.st[0] = nloc; b.st[1] = nx; }
        const unsigned old = xb_add(&bar[XB_XSUB(b.x)], 1u);
        const unsigned gen = old / nloc;
        if (old + 1u == (gen + 1u) * nloc) {
            __builtin_amdgcn_fence(__ATOMIC_RELEASE, "agent");
            asm volatile("s_waitcnt vmcnt(0)" ::: "memory");
            const unsigned og = xb_add(&bar[XB_TOP], 1u);
            const unsigned tg = og / nx;
            if (og + 1u == (tg + 1u) * nx) xb_add(&bar[XB_TOPGEN], 1u);
            else XB_SPIN(xb_ld(&bar[XB_TOPGEN]) == tg, bar);
            __builtin_amdgcn_fence(__ATOMIC_ACQUIRE, "agent");
            xb_add(&bar[XB_XGEN(b.x)], 1u);
            asm volatile("s_waitcnt vmcnt(0)" ::: "memory");
        } else {
            XB_SPIN(xb_ld(&bar[XB_XGEN(b.x)]) == gen, bar);
            __builtin_amdgcn_fence(__ATOMIC_ACQUIRE, "agent");
            asm volatile("s_waitcnt vmcnt(0)" ::: "memory");
        }
    }
    __syncthreads();
}

DI float wave_sum(float v) {
#pragma unroll
    for (int o = 1; o < 64; o <<= 1) v += __shfl_xor(v, o);
    return v;
}
DI unsigned offb(unsigned row, unsigned ch) { return 256u * row + 16u * (ch ^ (((row & 3u) << 2) | ((row >> 2) & 3u))); }
DI s16x4 vtr(const LAS unsigned char* p) { return __builtin_bit_cast(s16x4, __builtin_amdgcn_ds_read_tr16_b64_v4i16((LAS v4i16_t*)p)); }
DI s16x4 tr4(const LAS unsigned char* img, int rowbase, int c, int lane) { const int q = (lane & 15) >> 2, p = lane & 3; return vtr(img + offb((unsigned)(rowbase + q), (unsigned)(2 * c + (p >> 1))) + 8 * (p & 1)); }

struct Ptrs {
    const float *x, *ln1, *w_in, *w_gk2, *b_gk2, *gnorm, *wpa, *wpb, *wout, *ln2, *wr, *br, *wup, *bup, *wdn, *bdn, *lnf;
    float* out; unsigned char* ws; gu32* ctl;
};

DI void p0_tile(const float* W, int ldw, int k0, int sc0, bf16* WT, int K, int dr0, LAS float* scr, int lane) {
#pragma unroll 8
    for (int i = 0; i < 32; ++i) { const int kk = 2 * i + (lane >> 5); scr[kk * 33 + (lane & 31)] = W[(size_t)(k0 + kk) * ldw + sc0 + (lane & 31)]; }
    LDS_WAIT(); asm volatile("" ::: "memory");
    const int c = lane & 7;
#pragma unroll
    for (int j = 0; j < 4; ++j) { const int n = (lane >> 3) + 8 * j; const LAS float* s = scr + (8 * c) * 33 + n;
        u32x4 o; o.x = pk2(s[0 * 33], s[1 * 33]); o.y = pk2(s[2 * 33], s[3 * 33]); o.z = pk2(s[4 * 33], s[5 * 33]); o.w = pk2(s[6 * 33], s[7 * 33]);
        *(u32x4*)(WT + (size_t)(dr0 + n) * K + k0 + 8 * c) = o; }
    LDS_WAIT(); asm volatile("" ::: "memory");
}
DI void rms_row_to_bf16(const float* xrow, const float* w, bf16* orow, int lane) {
    const f32x4* xr = (const f32x4*)xrow + lane; const f32x4* wr = (const f32x4*)w + lane;
    f32x4 v[4]; float s = 0.f;
#pragma unroll
    for (int j = 0; j < 4; ++j) { v[j] = xr[64 * j]; s += (v[j].x * v[j].x + v[j].y * v[j].y) + (v[j].z * v[j].z + v[j].w * v[j].w); }
    const float rstd = 1.f / sqrtf(wave_sum(s) * (1.f / D) + RMS_EPS);
    u32x2* o8 = (u32x2*)orow + lane;
#pragma unroll
    for (int j = 0; j < 4; ++j) { const f32x4 ww = wr[64 * j]; u32x2 o; o.x = pk2(v[j].x * rstd * ww.x, v[j].y * rstd * ww.y); o.y = pk2(v[j].z * rstd * ww.z, v[j].w * rstd * ww.w); o8[64 * j] = o; }
}
constexpr int PMAX_OFF = 131072 + 1024;
struct QItem { const float* W; int ldw, sc0, dr0; unsigned char* W8; float* sc; };
DI QItem p0_qitem(const Ptrs& P, int it) { QItem q;
    if (it < 32 * 64) { const int e = it >> 6, nb = it & 63, c0 = 32 * nb; q.W = P.wup + (size_t)e * 1024 * 2048; q.ldw = 2048; q.sc0 = c0;
        q.dr0 = (c0 < 1024) ? 256 * (c0 >> 7) + (c0 & 127) : 256 * ((c0 - 1024) >> 7) + 128 + (c0 & 127); q.W8 = P.ws + WS_WUP + (size_t)e * 2048 * 1024; q.sc = (float*)(P.ws + WS_SUP) + e * 2048; }
    else { const int r = it - 32 * 64, e = r >> 5, nb = r & 31; q.W = P.wdn + (size_t)e * 1024 * 1024; q.ldw = 1024; q.sc0 = 32 * nb; q.dr0 = 32 * nb; q.W8 = P.ws + WS_WDN + (size_t)e * 1024 * 1024; q.sc = (float*)(P.ws + WS_SDN) + e * 1024; }
    return q; }
DI void p0_qload(f32x4 (&v)[16], const QItem& q, int w, int lane) {
#pragma unroll
    for (int i = 0; i < 16; ++i) v[i] = *(const f32x4*)(q.W + (size_t)(128 * w + 8 * i + (lane >> 3)) * q.ldw + q.sc0 + 4 * (lane & 7));
}
DI void p0_quant_all(const Ptrs& P, LAS unsigned char* lds, int vcu, int G, int tid, int j0, int j1) {
    const int lane = tid & 63, w = tid >> 6; LAS float* scr = (LAS float*)(lds + w * 16384); LAS float* PM = (LAS float*)(lds + PMAX_OFF);
    constexpr int NQ = 32 * 64 + 32 * 32; const int NQE = (vcu + (long)j1 * G < NQ) ? vcu + j1 * G : NQ;
    f32x4 v[16]; int it = vcu + j0 * G;
    if (it < NQE) p0_qload(v, p0_qitem(P, it), w, lane);
#pragma unroll 1
    for (; it < NQE; it += G) { const QItem q = p0_qitem(P, it);
        { const int ng8 = lane & 7, rsub = lane >> 3; f32x4 mx = {0.f, 0.f, 0.f, 0.f};
#pragma unroll
          for (int i = 0; i < 16; ++i) { const int kk = 8 * i + rsub; *(LAS f32x4*)(scr + kk * 32 + 4 * ((ng8 + (kk >> 4)) & 7)) = v[i];
              mx.x = fmaxf(mx.x, fabsf(v[i].x)); mx.y = fmaxf(mx.y, fabsf(v[i].y)); mx.z = fmaxf(mx.z, fabsf(v[i].z)); mx.w = fmaxf(mx.w, fabsf(v[i].w)); }
#pragma unroll
          for (int o = 8; o < 64; o <<= 1) { mx.x = fmaxf(mx.x, __shfl_xor(mx.x, o)); mx.y = fmaxf(mx.y, __shfl_xor(mx.y, o)); mx.z = fmaxf(mx.z, __shfl_xor(mx.z, o)); mx.w = fmaxf(mx.w, __shfl_xor(mx.w, o)); }
          if (lane < 8) *(LAS f32x4*)(PM + w * 32 + 4 * lane) = mx; }
        __syncthreads();
        if (it + G < NQE) p0_qload(v, p0_qitem(P, it + G), w, lane);
        { const int c = lane & 7, ng = lane >> 3; f32x4 am = {0.f, 0.f, 0.f, 0.f};
#pragma unroll
          for (int w2 = 0; w2 < 8; ++w2) { const f32x4 t = *(const LAS f32x4*)(PM + w2 * 32 + 4 * ng); am.x = fmaxf(am.x, t.x); am.y = fmaxf(am.y, t.y); am.z = fmaxf(am.z, t.z); am.w = fmaxf(am.w, t.w); }
          float sc[4], inv[4];
#pragma unroll
          for (int j = 0; j < 4; ++j) { const float a = am[j]; const int ex = (int)((__float_as_uint(a) >> 23) & 0xffu) - 127;
              sc[j] = (a > 0.f) ? __uint_as_float((unsigned)(127 + 7 - ex) << 23) : 1.0f; inv[j] = (a > 0.f) ? __uint_as_float((unsigned)(127 - 7 + ex) << 23) : 1.0f; }
          if (w == 0 && c == 0) *(f32x4*)(q.sc + q.dr0 + 4 * ng) = (f32x4){inv[0], inv[1], inv[2], inv[3]};
          f32x4 x[16];
#pragma unroll
          for (int i = 0; i < 16; ++i) x[i] = *(const LAS f32x4*)(scr + (16 * c + i) * 32 + 4 * ((ng + c) & 7));
#pragma unroll
          for (int j = 0; j < 4; ++j) { int o[4];
#pragma unroll
              for (int qq = 0; qq < 4; ++qq) { int t = 0; t = __builtin_amdgcn_cvt_pk_fp8_f32(x[4 * qq][j] * sc[j], x[4 * qq + 1][j] * sc[j], t, false); t = __builtin_amdgcn_cvt_pk_fp8_f32(x[4 * qq + 2][j] * sc[j], x[4 * qq + 3][j] * sc[j], t, true); o[qq] = t; }
              u32x4 ov; ov.x = (unsigned)o[0]; ov.y = (unsigned)o[1]; ov.z = (unsigned)o[2]; ov.w = (unsigned)o[3];
              *(u32x4*)(q.W8 + (size_t)(q.dr0 + 4 * ng + j) * 1024 + 128 * w + 16 * c) = ov; } }
        __syncthreads(); }
}
DI void p0_quant_win(const Ptrs& P, LAS unsigned char* lds, int vcu, int G, int tid) {
    const int lane = tid & 63, w = tid >> 6; LAS float* scr = (LAS float*)(lds + w * 16384); LAS float* PM = (LAS float*)(lds + PMAX_OFF);
    signed char* W8 = (signed char*)(P.ws + WS_WIN); float* SW = (float*)(P.ws + WS_SWIN);
    constexpr int NQ = 320;
#pragma unroll 1
    for (int it = vcu; it < NQ; it += G) { const int dr0 = (it < 240) ? 32 * it : ((it < 304) ? C_MA + 32 * (it - 240) : C_GF + 32 * (it - 304));
        const int ng8 = lane & 7, rsub = lane >> 3; f32x4 mx = {0.f, 0.f, 0.f, 0.f};
        if (it < 304) { const int sc0 = (it < 240) ? 32 * it : 7696 + 32 * (it - 240); f32x4 v[16];
#pragma unroll
            for (int i = 0; i < 16; ++i) v[i] = *(const f32x4*)(P.w_in + (size_t)(128 * w + 8 * i + rsub) * IN_W + sc0 + 4 * ng8);
#pragma unroll
            for (int i = 0; i < 16; ++i) { const int kk = 8 * i + rsub; *(LAS f32x4*)(scr + kk * 32 + 4 * ((ng8 + (kk >> 4)) & 7)) = v[i];
                mx.x = fmaxf(mx.x, fabsf(v[i].x)); mx.y = fmaxf(mx.y, fabsf(v[i].y)); mx.z = fmaxf(mx.z, fabsf(v[i].z)); mx.w = fmaxf(mx.w, fabsf(v[i].w)); } }
        else { const int j0 = 32 * (it - 304) + 4 * ng8; f32x4 w2[16];
#pragma unroll
            for (int r = 0; r < 16; ++r) w2[r] = *(const f32x4*)(P.w_gk2 + r * 512 + j0);
#pragma unroll 2
            for (int i = 0; i < 16; ++i) { const int kk = 8 * i + rsub; const f32x4* src = (const f32x4*)(P.w_in + (size_t)(128 * w + kk) * IN_W + 7680); f32x4 a = {0.f, 0.f, 0.f, 0.f};
#pragma unroll
                for (int q = 0; q < 4; ++q) { const f32x4 t = src[q]; a = a + w2[4 * q] * t.x + w2[4 * q + 1] * t.y + w2[4 * q + 2] * t.z + w2[4 * q + 3] * t.w; }
                *(LAS f32x4*)(scr + kk * 32 + 4 * ((ng8 + (kk >> 4)) & 7)) = a;
                mx.x = fmaxf(mx.x, fabsf(a.x)); mx.y = fmaxf(mx.y, fabsf(a.y)); mx.z = fmaxf(mx.z, fabsf(a.z)); mx.w = fmaxf(mx.w, fabsf(a.w)); } }
#pragma unroll
        for (int o = 8; o < 64; o <<= 1) { mx.x = fmaxf(mx.x, __shfl_xor(mx.x, o)); mx.y = fmaxf(mx.y, __shfl_xor(mx.y, o)); mx.z = fmaxf(mx.z, __shfl_xor(mx.z, o)); mx.w = fmaxf(mx.w, __shfl_xor(mx.w, o)); }
        if (lane < 8) *(LAS f32x4*)(PM + w * 32 + 4 * lane) = mx;
        __syncthreads();
        { const int c = lane & 7, ng = lane >> 3; f32x4 am = {0.f, 0.f, 0.f, 0.f};
#pragma unroll
          for (int w2 = 0; w2 < 8; ++w2) { const f32x4 t = *(const LAS f32x4*)(PM + w2 * 32 + 4 * ng); am.x = fmaxf(am.x, t.x); am.y = fmaxf(am.y, t.y); am.z = fmaxf(am.z, t.z); am.w = fmaxf(am.w, t.w); }
          float sc[4], inv[4];
#pragma unroll
          for (int j = 0; j < 4; ++j) { sc[j] = (am[j] > 0.f) ? 127.0f / am[j] : 1.0f; inv[j] = (am[j] > 0.f) ? am[j] * (1.0f / 127.0f) : 1.0f; }
          if (w == 0 && c == 0) *(f32x4*)(SW + dr0 + 4 * ng) = (f32x4){inv[0], inv[1], inv[2], inv[3]};
          f32x4 x[16];
#pragma unroll
          for (int i = 0; i < 16; ++i) x[i] = *(const LAS f32x4*)(scr + (16 * c + i) * 32 + 4 * ((ng + c) & 7));
#pragma unroll
          for (int j = 0; j < 4; ++j) { unsigned o[4];
#pragma unroll
              for (int qq = 0; qq < 4; ++qq) { unsigned t = 0u;
#pragma unroll
                  for (int e = 0; e < 4; ++e) t |= ((unsigned)(int)rintf(x[4 * qq + e][j] * sc[j]) & 0xffu) << (8 * e);
                  o[qq] = t; }
              u32x4 ov; ov.x = o[0]; ov.y = o[1]; ov.z = o[2]; ov.w = o[3];
              *(u32x4*)(W8 + (size_t)(dr0 + 4 * ng + j) * 1024 + 128 * w + 16 * c) = ov; } }
        __syncthreads(); }
}
template <int NR> DI void rms_rows_to_i8(const float* x0, const float* w, signed char* o0, float* sx0, int lane) {
    const f32x4* xr = (const f32x4*)x0 + lane; const f32x4* wr = (const f32x4*)w + lane;
    f32x4 v[NR][4], wv[4]; float ss[NR], mx[NR];
#pragma unroll
    for (int j = 0; j < 4; ++j) wv[j] = wr[64 * j];
#pragma unroll
    for (int q = 0; q < NR; ++q)
#pragma unroll
        for (int j = 0; j < 4; ++j) v[q][j] = xr[256 * q + 64 * j];
#pragma unroll
    for (int q = 0; q < NR; ++q) { float s = 0.f;
#pragma unroll
        for (int j = 0; j < 4; ++j) s += (v[q][j].x * v[q][j].x + v[q][j].y * v[q][j].y) + (v[q][j].z * v[q][j].z + v[q][j].w * v[q][j].w);
        ss[q] = s; }
#pragma unroll
    for (int o = 1; o < 64; o <<= 1)
#pragma unroll
        for (int q = 0; q < NR; ++q) ss[q] += __shfl_xor(ss[q], o);
#pragma unroll
    for (int q = 0; q < NR; ++q) { const float r = 1.f / sqrtf(ss[q] * (1.f / D) + RMS_EPS); float m = 0.f;
#pragma unroll
        for (int j = 0; j < 4; ++j) { v[q][j] = v[q][j] * r * wv[j]; m = fmaxf(m, fmaxf(fmaxf(fabsf(v[q][j].x), fabsf(v[q][j].y)), fmaxf(fabsf(v[q][j].z), fabsf(v[q][j].w)))); }
        mx[q] = m; }
#pragma unroll
    for (int o = 1; o < 64; o <<= 1)
#pragma unroll
        for (int q = 0; q < NR; ++q) mx[q] = fmaxf(mx[q], __shfl_xor(mx[q], o));
#pragma unroll
    for (int q = 0; q < NR; ++q) { const float qa = (mx[q] > 0.f) ? 127.0f / mx[q] : 1.0f; if (lane == 0) sx0[q] = (mx[q] > 0.f) ? mx[q] * (1.0f / 127.0f) : 1.0f;
        unsigned* o4 = (unsigned*)o0 + 256 * q + lane;
#pragma unroll
        for (int j = 0; j < 4; ++j) o4[64 * j] = ((unsigned)(int)rintf(v[q][j].x * qa) & 0xffu) | (((unsigned)(int)rintf(v[q][j].y * qa) & 0xffu) << 8) | (((unsigned)(int)rintf(v[q][j].z * qa) & 0xffu) << 16) | (((unsigned)(int)rintf(v[q][j].w * qa) & 0xffu) << 24); }
}
DI void rms_rows2_to_bf16(const float* x0, const float* w, bf16* o0, int lane) {
    const f32x4* xr = (const f32x4*)x0 + lane; const f32x4* wr = (const f32x4*)w + lane;
    f32x4 va[4], vb[4], wv[4]; float sa = 0.f, sb = 0.f;
#pragma unroll
    for (int j = 0; j < 4; ++j) { va[j] = xr[64 * j]; vb[j] = xr[256 + 64 * j]; wv[j] = wr[64 * j]; }
#pragma unroll
    for (int j = 0; j < 4; ++j) { sa += (va[j].x * va[j].x + va[j].y * va[j].y) + (va[j].z * va[j].z + va[j].w * va[j].w); sb += (vb[j].x * vb[j].x + vb[j].y * vb[j].y) + (vb[j].z * vb[j].z + vb[j].w * vb[j].w); }
    const float ra = 1.f / sqrtf(wave_sum(sa) * (1.f / D) + RMS_EPS), rb = 1.f / sqrtf(wave_sum(sb) * (1.f / D) + RMS_EPS);
    u32x2* o8 = (u32x2*)o0 + lane;
#pragma unroll
    for (int j = 0; j < 4; ++j) { const f32x4 ww = wv[j]; u32x2 oa, ob; oa.x = pk2(va[j].x * ra * ww.x, va[j].y * ra * ww.y); oa.y = pk2(va[j].z * ra * ww.z, va[j].w * ra * ww.w);
        ob.x = pk2(vb[j].x * rb * ww.x, vb[j].y * rb * ww.y); ob.y = pk2(vb[j].z * rb * ww.z, vb[j].w * rb * ww.w); o8[64 * j] = oa; o8[256 + 64 * j] = ob; }
}
DI void p0_prologue(const Ptrs& P, LAS unsigned char* lds, int vcu, int G, int tid) {
    const int lane = tid & 63, wave = tid >> 6;
    LAS float* scr = (LAS float*)(lds + wave * 16384);
    const int gw = vcu * 8 + wave, NGW = G * 8;
    bf16* WIN_T = (bf16*)(P.ws + WS_WIN); bf16* WPA_T = (bf16*)(P.ws + WS_WPA); bf16* WPB_T = (bf16*)(P.ws + WS_WPB); bf16* WOUT_T = (bf16*)(P.ws + WS_WOUT);
    bf16* WRT = (bf16*)(P.ws + WS_WRT); unsigned char* WUP8 = P.ws + WS_WUP; unsigned char* WDN8 = P.ws + WS_WDN; bf16* XN = (bf16*)(P.ws + WS_XN);
#if BRINGUP != 1
    p0_quant_win(P, lds, vcu, G, tid);
    constexpr int I_PA = 8 * 32, I_PB = 16 * 32, I_OUT = 16 * 32, I_R = 16;
    constexpr int NITEMS = I_PA + I_PB + I_OUT + I_R;
    for (int it = gw; it < NITEMS; it += NGW) {
        int r = it;
        if (r < I_PA) { const int kb = r >> 5, nb = r & 31; p0_tile(P.wpa, 1024, 64 * kb, 32 * nb, WPA_T, 512, 32 * nb, scr, lane); continue; } r -= I_PA;
        if (r < I_PB) { const int kb = r >> 5, nb = r & 31; p0_tile(P.wpb, 1024, 64 * kb, 32 * nb, WPB_T, 1024, 32 * nb, scr, lane); continue; } r -= I_PB;
        if (r < I_OUT) { const int kb = r >> 5, nb = r & 31; p0_tile(P.wout, 1024, 64 * kb, 32 * nb, WOUT_T, 1024, 32 * nb, scr, lane); continue; } r -= I_OUT;
        p0_tile(P.wr, 32, 64 * r, 0, WRT, 1024, 0, scr, lane);
    }
    for (int m = gw * 4; m < T; m += NGW * 4) rms_rows_to_i8<4>(P.x + (size_t)m * D, P.ln1, (signed char*)(P.ws + WS_XN) + (size_t)m * D, (float*)(P.ws + WS_SX) + m, lane);
#endif
}

constexpr size_t PLANE = (size_t)T * 128;
DI bf16* proj_plane(unsigned char* ws, int cb) { return (bf16*)(ws + WS_PROJ) + (size_t)cb * PLANE; }

DI void attn_task(unsigned char* ws, bf16* OG, float* LSE, LAS unsigned char* lds, int task, int tid0) {
    int tid = tid0; const int w = __builtin_amdgcn_readfirstlane(tid0 >> 6); int lane = tid & 63, i = lane & 15, g4 = lane >> 4;
    const int grp = task >> 8, idx = task & 255, b = idx >> 7, h = (idx >> 5) & 3, q5 = idx & 31;
    const int dsh = 2 * grp, d = 1 << dsh, rsh = 5 - dsh, r = q5 >> rsh, n0 = 4 * (q5 & ((1 << rsh) - 1)), Lsub = SEQ >> dsh;
    const unsigned char* Qp = (const unsigned char*)ws + WS_PROJ + (size_t)(12 * grp + h) * PLANE * 2 + ((size_t)b * SEQ + (size_t)r * Lsub) * 128;
#define ATT_Q8(dst, ptr) do { const u32x2 _q = *(const u32x2*)(ptr); const f32x2 _a = __builtin_amdgcn_cvt_pk_f32_fp8((int)_q.x, false), _b = __builtin_amdgcn_cvt_pk_f32_fp8((int)_q.x, true), _c = __builtin_amdgcn_cvt_pk_f32_fp8((int)_q.y, false), _d = __builtin_amdgcn_cvt_pk_f32_fp8((int)_q.y, true); \
        u32x4 _w; _w.x = pk2(_a.x, _a.y); _w.y = pk2(_b.x, _b.y); _w.z = pk2(_c.x, _c.y); _w.w = pk2(_d.x, _d.y); dst = __builtin_bit_cast(bf16x8, _w); } while (0)
    const unsigned char* Kp = (const unsigned char*)ws + WS_PROJ + (size_t)(12 * grp + 4 + h) * PLANE * 2 + ((size_t)b * SEQ + (size_t)r * Lsub) * 128;
    const unsigned char* Vp = (const unsigned char*)ws + WS_PROJ + (size_t)(12 * grp + 8 + h) * PLANE * 2 + ((size_t)b * SEQ + (size_t)r * Lsub) * 128;
    LAS unsigned char* KL = lds; LAS unsigned char* VL = lds + 65536;
    u32x4 pk[2], pv[2]; bf16x8 qf[4], nq[4];
#define ATT_PUT8(img, v8, id_) do { const int _row = (id_) >> 3, _c = (id_) & 7; const unsigned _w[4] = {(v8).x, (v8).y, (v8).z, (v8).w}; unsigned _o[8]; \
        _Pragma("unroll") for (int _q = 0; _q < 4; ++_q) { const f32x2 _lo = __builtin_amdgcn_cvt_pk_f32_fp8((int)_w[_q], false), _hi = __builtin_amdgcn_cvt_pk_f32_fp8((int)_w[_q], true); _o[2 * _q] = pk2(_lo.x, _lo.y); _o[2 * _q + 1] = pk2(_hi.x, _hi.y); } \
        *(LAS u32x4*)((img) + offb(_row, 2 * _c)) = (u32x4){_o[0], _o[1], _o[2], _o[3]}; *(LAS u32x4*)((img) + offb(_row, 2 * _c + 1)) = (u32x4){_o[4], _o[5], _o[6], _o[7]}; } while (0)
#pragma unroll
    for (int ii = 0; ii < 2; ++ii) { const int id = tid + 512 * ii; const int s0 = (n0 - 1) & 1, s1 = n0 & 1;
        u32x4 k0 = {0u, 0u, 0u, 0u}, v0 = {0u, 0u, 0u, 0u};
        if (n0 > 0) { k0 = *(const u32x4*)(Kp + (size_t)(n0 - 1) * 16384 + id * 16); v0 = *(const u32x4*)(Vp + (size_t)(n0 - 1) * 16384 + id * 16); }
        const u32x4 k1 = *(const u32x4*)(Kp + (size_t)n0 * 16384 + id * 16), v1 = *(const u32x4*)(Vp + (size_t)n0 * 16384 + id * 16);
        ATT_PUT8(KL + s0 * 32768, k0, id); ATT_PUT8(VL + s0 * 32768, v0, id); ATT_PUT8(KL + s1 * 32768, k1, id); ATT_PUT8(VL + s1 * 32768, v1, id); }
#pragma unroll
    for (int ks = 0; ks < 4; ++ks) ATT_Q8(qf[ks], Qp + (size_t)(n0 * 128 + 16 * w + i) * 128 + 32 * ks + 8 * g4);
    __syncthreads();
    const int kt0 = (w == 0) ? 0 : w - 1;
#pragma unroll 1
    for (int u = 0; u < 4; ++u) { const int n = n0 + u;
        asm volatile("" : "+v"(tid)); lane = tid & 63; i = lane & 15; g4 = lane >> 4;
        if (u < 3) {
#pragma unroll
            for (int ii = 0; ii < 2; ++ii) { const int id = tid + 512 * ii; pk[ii] = *(const u32x4*)(Kp + (size_t)(n + 1) * 16384 + id * 16); pv[ii] = *(const u32x4*)(Vp + (size_t)(n + 1) * 16384 + id * 16); }
        }
        f32x4 st[10];
#pragma unroll
        for (int tt = 0; tt < 10; ++tt) st[tt] = (f32x4){0.f, 0.f, 0.f, 0.f};
#pragma unroll
        for (int ks = 0; ks < 4; ++ks)
#pragma unroll
            for (int hb = 0; hb < 2; ++hb) { bf16x8 kf[5];
#pragma unroll
                for (int t5 = 0; t5 < 5; ++t5) { const int kt = kt0 + 5 * hb + t5; kf[t5] = *(const LAS bf16x8*)(KL + ((n - 1 + (kt >> 3)) & 1) * 32768 + offb(16 * (kt & 7) + i, 4 * ks + g4)); }
                __builtin_amdgcn_sched_barrier(0);
#pragma unroll
                for (int t5 = 0; t5 < 5; ++t5) st[5 * hb + t5] = MFMA16(kf[t5], qf[ks], st[5 * hb + t5]);
                __builtin_amdgcn_sched_barrier(0); }
        const int iq = 16 * w + i; float mx = -3.0e38f;
#pragma unroll
        for (int tt = 0; tt < 10; ++tt)
#pragma unroll
            for (int rg = 0; rg < 4; ++rg) { const int j = 16 * (kt0 + tt) + 4 * g4 + rg, dist = iq + 128 - j; const bool ok = ((unsigned)dist <= 128u) && (n > 0 || j >= 128);
                st[tt][rg] = ok ? st[tt][rg] : -__builtin_inff(); mx = fmaxf(mx, st[tt][rg]); }
        mx = fmaxf(mx, __shfl_xor(mx, 16)); mx = fmaxf(mx, __shfl_xor(mx, 32));
        float sum = 0.f;
#pragma unroll
        for (int tt = 0; tt < 10; ++tt)
#pragma unroll
            for (int rg = 0; rg < 4; ++rg) { const float p = __builtin_amdgcn_exp2f(st[tt][rg] - mx); st[tt][rg] = p; sum += p; }
        sum += __shfl_xor(sum, 16); sum += __shfl_xor(sum, 32);
        f32x4 o[8];
#pragma unroll
        for (int c = 0; c < 8; ++c) o[c] = (f32x4){0.f, 0.f, 0.f, 0.f};
#pragma unroll
        for (int kk = 0; kk < 5; ++kk) { u32x4 pw; pw.x = pk2(st[2 * kk][0], st[2 * kk][1]); pw.y = pk2(st[2 * kk][2], st[2 * kk][3]); pw.z = pk2(st[2 * kk + 1][0], st[2 * kk + 1][1]); pw.w = pk2(st[2 * kk + 1][2], st[2 * kk + 1][3]);
            const bf16x8 pa = __builtin_bit_cast(bf16x8, pw); const int ka = kt0 + 2 * kk, kb2 = ka + 1;
            const LAS unsigned char* va = VL + ((n - 1 + (ka >> 3)) & 1) * 32768; const LAS unsigned char* vb = VL + ((n - 1 + (kb2 >> 3)) & 1) * 32768;
            bf16x8 vf[8];
#pragma unroll
            for (int c = 0; c < 8; ++c) vf[c] = cat8(tr4(va, 16 * (ka & 7) + 4 * g4, c, lane), tr4(vb, 16 * (kb2 & 7) + 4 * g4, c, lane));
            __builtin_amdgcn_sched_barrier(0);
#pragma unroll
            for (int c = 0; c < 8; ++c) o[c] = MFMA16(pa, vf[c], o[c]);
            __builtin_amdgcn_sched_barrier(0); }
        if (u < 3) {
#pragma unroll
            for (int ks = 0; ks < 4; ++ks) ATT_Q8(nq[ks], Qp + (size_t)((n + 1) * 128 + 16 * w + i) * 128 + 32 * ks + 8 * g4); }
        const float linv = 1.0f / sum;
        const size_t mrow0 = (size_t)b * SEQ;
        if (lane < 16) { const size_t m = mrow0 + (size_t)((n * 128 + iq) * d + r); LSE[((size_t)grp * T + m) * 4 + h] = (mx + __log2f(sum)) * 0.6931471805599453f; }
        __syncthreads();
        { LAS unsigned char* ost = KL + ((n - 1) & 1) * 32768 + w * 4096;
#pragma unroll
          for (int rg = 0; rg < 4; ++rg) { const float li = __shfl(linv, 4 * g4 + rg);
#pragma unroll
              for (int c = 0; c < 8; ++c) *(LAS bf16*)(ost + (4 * g4 + rg) * 256 + (16 * c + i) * 2) = f2bf(o[c][rg] * li); }
          LDS_WAIT(); asm volatile("" ::: "memory");
#pragma unroll
          for (int k = 0; k < 2; ++k) { const int pid = lane + 64 * k, qr = pid >> 3, ch = pid & 7;
              const u32x4 va = *(const LAS u32x4*)(ost + qr * 256 + ch * 32), vb = *(const LAS u32x4*)(ost + qr * 256 + ch * 32 + 16);
              int w0 = 0, w1 = 0, w2 = 0, w3 = 0;
              w0 = __builtin_amdgcn_cvt_pk_fp8_f32(bflo(va.x), bfhi(va.x), w0, false); w0 = __builtin_amdgcn_cvt_pk_fp8_f32(bflo(va.y), bfhi(va.y), w0, true);
              w1 = __builtin_amdgcn_cvt_pk_fp8_f32(bflo(va.z), bfhi(va.z), w1, false); w1 = __builtin_amdgcn_cvt_pk_fp8_f32(bflo(va.w), bfhi(va.w), w1, true);
              w2 = __builtin_amdgcn_cvt_pk_fp8_f32(bflo(vb.x), bfhi(vb.x), w2, false); w2 = __builtin_amdgcn_cvt_pk_fp8_f32(bflo(vb.y), bfhi(vb.y), w2, true);
              w3 = __builtin_amdgcn_cvt_pk_fp8_f32(bflo(vb.z), bfhi(vb.z), w3, false); w3 = __builtin_amdgcn_cvt_pk_fp8_f32(bflo(vb.w), bfhi(vb.w), w3, true);
              u32x4 v; v.x = (unsigned)w0; v.y = (unsigned)w1; v.z = (unsigned)w2; v.w = (unsigned)w3;
              const size_t m = mrow0 + (size_t)((n * 128 + 16 * w + qr) * d + r); *(u32x4*)((unsigned char*)OG + ((size_t)grp * T + m) * 512 + h * 128 + 16 * ch) = v; } }
        if (u < 3) { __syncthreads(); const int s1 = (n + 1) & 1;
#pragma unroll
            for (int ii = 0; ii < 2; ++ii) { const int id = tid + 512 * ii; ATT_PUT8(KL + s1 * 32768, pk[ii], id); ATT_PUT8(VL + s1 * 32768, pv[ii], id); }
#pragma unroll
            for (int ks = 0; ks < 4; ++ks) qf[ks] = nq[ks];
            __syncthreads(); }
    }
    __syncthreads();
#undef ATT_PUT8
}

constexpr int GL_RK = 0, GL_RG = 16384, GL_RQ = 32768, GL_OST = 0, GL_QE = 49152, GL_KM = 65536, GL_KE = 81920, GL_V = 98304;
constexpr int GL_TOT = 131072 + 2048, GL_DEC = 131072 + 6144, GL_ATT = 131072 + 6656;
template <bool FULL> struct GlaPre { u32x4 k[2], g[2], q[FULL ? 2 : 1], v[4]; };
template <bool FULL> DI void gla_fetch_kgq(GlaPre<FULL>& R, const bf16* Kp, const bf16* Gp, const bf16* Qp, size_t mbase, int tid) {
#pragma unroll
    for (int ii = 0; ii < 2; ++ii) { const size_t o = mbase * 128 + (size_t)(tid + 512 * ii) * 8; R.k[ii] = *(const u32x4*)(Kp + o); R.g[ii] = *(const u32x4*)(Gp + o); if (FULL) R.q[ii] = *(const u32x4*)(Qp + o); }
}
template <bool FULL> DI void gla_fetch_v(GlaPre<FULL>& R, const bf16* Vp, size_t mbase, int tid) {
#pragma unroll
    for (int ii = 0; ii < 4; ++ii) R.v[ii] = *(const u32x4*)(Vp + mbase * 256 + (size_t)(tid + 512 * ii) * 8);
}
template <bool FULL> DI void gla_fetch(GlaPre<FULL>& R, const bf16* Kp, const bf16* Gp, const bf16* Qp, const bf16* Vp, size_t mbase, int tid) { gla_fetch_kgq<FULL>(R, Kp, Gp, Qp, mbase, tid); gla_fetch_v<FULL>(R, Vp, mbase, tid); }
template <bool FULL> DI void gla_put(const GlaPre<FULL>& R, LAS unsigned char* lds, int tid) {
#pragma unroll
    for (int ii = 0; ii < 2; ++ii) { const int o = (tid + 512 * ii) * 16; *(LAS u32x4*)(lds + GL_RK + o) = R.k[ii]; *(LAS u32x4*)(lds + GL_RG + o) = R.g[ii]; if (FULL) *(LAS u32x4*)(lds + GL_RQ + o) = R.q[ii]; }
#pragma unroll
    for (int ii = 0; ii < 4; ++ii) { const int id = tid + 512 * ii, row = id >> 5, c32 = id & 31; *(LAS u32x4*)(lds + GL_V + (c32 >> 4) * 16384 + offb(row, c32 & 15)) = R.v[ii]; }
}
template <bool FULL> DI f32x2 gla_prep(LAS unsigned char* lds, int tid) {
    const int jp = tid & 63, tg = tid >> 6;
    f32x2 c[8], kv[8], qv[8]; f32x2 run = {0.f, 0.f};
#pragma unroll
    for (int ii = 0; ii < 8; ++ii) { const int o = (8 * tg + ii) * 256 + jp * 4; const unsigned gw = *(const LAS unsigned*)(lds + GL_RG + o), kw = *(const LAS unsigned*)(lds + GL_RK + o);
        run.x += bflo(gw); run.y += bfhi(gw); c[ii] = run; kv[ii] = (f32x2){bflo(kw), bfhi(kw)};
        if (FULL) { const unsigned qw = *(const LAS unsigned*)(lds + GL_RQ + o); qv[ii] = (f32x2){bflo(qw), bfhi(qw)}; } }
    LAS f32x2* TOT = (LAS f32x2*)(lds + GL_TOT);
    TOT[tg * 64 + jp] = run;
    __syncthreads();
    f32x2 off = {0.f, 0.f}, blast = {0.f, 0.f};
#pragma unroll
    for (int t2 = 0; t2 < 8; ++t2) { const f32x2 v = TOT[t2 * 64 + jp]; blast = blast + v; if (t2 < tg) off = off + v; }
    const f32x2 eb = {__expf(blast.x), __expf(blast.y)};
#pragma unroll
    for (int ii = 0; ii < 8; ++ii) { const int s = 8 * tg + ii; const f32x2 bb = off + c[ii]; const f32x2 e = {__expf(bb.x), __expf(bb.y)}; const f32x2 km = {kv[ii].x * __builtin_amdgcn_rcpf(e.x), kv[ii].y * __builtin_amdgcn_rcpf(e.y)};
        const unsigned o = offb(s, jp >> 2) + (jp & 3) * 4; const f32x2 ke = km * eb;
        *(LAS unsigned*)(lds + GL_KE + o) = pk2(ke.x, ke.y);
        if (FULL) { const f32x2 qe = qv[ii] * e; *(LAS unsigned*)(lds + GL_QE + o) = pk2(qe.x, qe.y); *(LAS unsigned*)(lds + GL_KM + o) = pk2(km.x, km.y); } }
    if (tg == 0) ((LAS f32x2*)(lds + GL_DEC))[jp] = eb;
    __syncthreads();
    return blast;
}
DI void gla_state_update(f32x4 (&S)[8][2], const LAS unsigned char* lds, int w, int lane) {
    const int g4 = lane >> 4; const LAS unsigned char* Vimg = lds + GL_V + (w >> 2) * 16384; const int cv = 2 * (w & 3);
#pragma unroll
    for (int mt = 0; mt < 8; ++mt) { const f32x4 dc = *(const LAS f32x4*)(lds + GL_DEC + (16 * mt + 4 * g4) * 4); S[mt][0] = S[mt][0] * dc; S[mt][1] = S[mt][1] * dc; }
#pragma unroll
    for (int ks = 0; ks < 2; ++ks) { bf16x8 bfr[2];
#pragma unroll
        for (int nt = 0; nt < 2; ++nt) bfr[nt] = cat8(tr4(Vimg, 32 * ks + 8 * g4, cv + nt, lane), tr4(Vimg, 32 * ks + 8 * g4 + 4, cv + nt, lane));
#pragma unroll
        for (int mt = 0; mt < 8; ++mt) { const bf16x8 a = cat8(tr4(lds + GL_KE, 32 * ks + 8 * g4, mt, lane), tr4(lds + GL_KE, 32 * ks + 8 * g4 + 4, mt, lane));
            S[mt][0] = MFMA16(a, bfr[0], S[mt][0]); S[mt][1] = MFMA16(a, bfr[1], S[mt][1]); } }
}
DI void gla_pass1(const Ptrs& P, LAS unsigned char* lds, int unit, int tid0) {
    const int lane0 = tid0 & 63, w = __builtin_amdgcn_readfirstlane(tid0 >> 6); const int bh = unit >> 5, sc = unit & 31, b = bh >> 2, h = bh & 3;
    const bf16* Kp = proj_plane(P.ws, 40 + h); const bf16* Gp = proj_plane(P.ws, 60 + h); const bf16* Vp = proj_plane(P.ws, 44) + (size_t)h * T * 256;
    f32x4 S[8][2];
#pragma unroll
    for (int mt = 0; mt < 8; ++mt) { S[mt][0] = (f32x4){0.f, 0.f, 0.f, 0.f}; S[mt][1] = (f32x4){0.f, 0.f, 0.f, 0.f}; }
    f32x2 logd = {0.f, 0.f}; const size_t m0 = (size_t)b * SEQ + (size_t)(8 * sc) * 64;
    GlaPre<false> R; gla_fetch<false>(R, Kp, Gp, nullptr, Vp, m0, tid0); gla_put<false>(R, lds, tid0);
    __syncthreads();
#pragma unroll 1
    for (int ci = 0; ci < 8; ++ci) {
        int tid = tid0; asm volatile("" : "+v"(tid));
        if (ci < 7) gla_fetch<false>(R, Kp, Gp, nullptr, Vp, m0 + (size_t)(ci + 1) * 64, tid);
        logd = logd + gla_prep<false>(lds, tid);
        const int lane = tid & 63;
        gla_state_update(S, lds, w, lane);
        __syncthreads();
        if (ci < 7) { gla_put<false>(R, lds, tid); __syncthreads(); } }
    float* GS = (float*)(P.ws + WS_GSTATE) + (size_t)unit * 32768;
#pragma unroll
    for (int mt = 0; mt < 8; ++mt)
#pragma unroll
        for (int nt = 0; nt < 2; ++nt)
#pragma unroll
            for (int rg = 0; rg < 4; ++rg) GS[((w * 16 + mt * 2 + nt) * 4 + rg) * 64 + lane0] = S[mt][nt][rg];
    if (tid0 < 64) ((f32x2*)(P.ws + WS_GDEC))[unit * 64 + tid0] = (f32x2){__expf(logd.x), __expf(logd.y)};
}
DI void gla_scan(const Ptrs& P, int vcu, int G, int tid) {
    float* GS = (float*)(P.ws + WS_GSTATE); const float* GD = (const float*)(P.ws + WS_GDEC);
    for (int cid = vcu * 512 + tid; cid < 8 * 32768; cid += G * 512) { const int bh = cid >> 15, e = cid & 32767, ln = e & 63, rg = (e >> 6) & 3, mt = ((e >> 8) & 15) >> 1, dk = 16 * mt + 4 * (ln >> 4) + rg;
        float ev[32], dv[32];
#pragma unroll
        for (int sc = 0; sc < 32; ++sc) { ev[sc] = GS[((size_t)(bh * 32 + sc) << 15) + e]; dv[sc] = GD[(bh * 32 + sc) * 128 + dk]; }
        float carry = 0.f;
#pragma unroll
        for (int sc = 0; sc < 32; ++sc) { GS[((size_t)(bh * 32 + sc) << 15) + e] = carry; carry = dv[sc] * carry + ev[sc]; } }
}
DI void gla_pass2(const Ptrs& P, LAS unsigned char* lds, int unit, int tid0) {
    const int lane0 = tid0 & 63, w = __builtin_amdgcn_readfirstlane(tid0 >> 6); const int bh = unit >> 5, sc = unit & 31, b = bh >> 2, h = bh & 3;
    const bf16* Qp = proj_plane(P.ws, 36 + h); const bf16* Kp = proj_plane(P.ws, 40 + h); const bf16* Gp = proj_plane(P.ws, 60 + h);
    const bf16* Vp = proj_plane(P.ws, 44) + (size_t)h * T * 256; const bf16* Op = proj_plane(P.ws, 52) + (size_t)h * T * 256; bf16* OB = (bf16*)(P.ws + WS_OB);
    f32x4 S[8][2];
    { const float* GS = (const float*)(P.ws + WS_GSTATE) + (size_t)unit * 32768;
#pragma unroll
      for (int mt = 0; mt < 8; ++mt)
#pragma unroll
          for (int nt = 0; nt < 2; ++nt)
#pragma unroll
              for (int rg = 0; rg < 4; ++rg) S[mt][nt][rg] = GS[((w * 16 + mt * 2 + nt) * 4 + rg) * 64 + lane0]; }
    const size_t m0 = (size_t)b * SEQ + (size_t)(8 * sc) * 64;
    GlaPre<true> R; gla_fetch<true>(R, Kp, Gp, Qp, Vp, m0, tid0); gla_put<true>(R, lds, tid0);
    __syncthreads();
#pragma unroll 1
    for (int ci = 0; ci < 8; ++ci) { const size_t mbase = m0 + (size_t)ci * 64;
        int tid = tid0; asm volatile("" : "+v"(tid));
        const int erow = tid >> 3, ep = tid & 7;
        if (ci < 7) gla_fetch_kgq<true>(R, Kp, Gp, Qp, mbase + 64, tid);
        (void)gla_prep<true>(lds, tid);
        if (ci < 7) gla_fetch_v<true>(R, Vp, mbase + 64, tid);
        u32x4 gog[4];
#pragma unroll
        for (int k = 0; k < 4; ++k) gog[k] = *(const u32x4*)(Op + (mbase + erow) * 256 + 8 * (ep + 8 * k));
        const int lane = tid & 63, i = lane & 15, g4 = lane >> 4;
        const LAS unsigned char* Vimg = lds + GL_V + (w >> 2) * 16384; const int cv = 2 * (w & 3);
        { const int mi = w >> 1;
#pragma unroll
          for (int nn = 0; nn < 2; ++nn) { const int nj = 2 * (w & 1) + nn; f32x4 a = {0.f, 0.f, 0.f, 0.f};
#pragma unroll
              for (int ks = 0; ks < 4; ++ks) { const bf16x8 af = *(const LAS bf16x8*)(lds + GL_QE + offb(16 * mi + i, 4 * ks + g4)), bfr = *(const LAS bf16x8*)(lds + GL_KM + offb(16 * nj + i, 4 * ks + g4)); a = MFMA16(af, bfr, a); }
#pragma unroll
              for (int rg = 0; rg < 4; ++rg) { const int sq = 16 * mi + 4 * g4 + rg, sk = 16 * nj + i; *(LAS bf16*)(lds + GL_ATT + sq * 144 + sk * 2) = f2bf(sk <= sq ? a[rg] : 0.f); } } }
        __syncthreads();
        f32x4 o[4][2];
#pragma unroll
        for (int mt = 0; mt < 4; ++mt) { o[mt][0] = (f32x4){0.f, 0.f, 0.f, 0.f}; o[mt][1] = (f32x4){0.f, 0.f, 0.f, 0.f}; }
#pragma unroll
        for (int ks = 0; ks < 2; ++ks) { bf16x8 bfr[2];
#pragma unroll
            for (int nt = 0; nt < 2; ++nt) bfr[nt] = cat8(tr4(Vimg, 32 * ks + 8 * g4, cv + nt, lane), tr4(Vimg, 32 * ks + 8 * g4 + 4, cv + nt, lane));
#pragma unroll
            for (int mt = 0; mt < 4; ++mt) { const bf16x8 a = *(const LAS bf16x8*)(lds + GL_ATT + (16 * mt + i) * 144 + 64 * ks + 16 * g4); o[mt][0] = MFMA16(a, bfr[0], o[mt][0]); o[mt][1] = MFMA16(a, bfr[1], o[mt][1]); } }
#pragma unroll
        for (int ks = 0; ks < 4; ++ks) { bf16x8 sb[2];
#pragma unroll
            for (int nt = 0; nt < 2; ++nt) { u32x4 pw; pw.x = pk2(S[2 * ks][nt][0], S[2 * ks][nt][1]); pw.y = pk2(S[2 * ks][nt][2], S[2 * ks][nt][3]); pw.z = pk2(S[2 * ks + 1][nt][0], S[2 * ks + 1][nt][1]); pw.w = pk2(S[2 * ks + 1][nt][2], S[2 * ks + 1][nt][3]); sb[nt] = __builtin_bit_cast(bf16x8, pw); }
#pragma unroll
            for (int mt = 0; mt < 4; ++mt) { const u32x2 lo = *(const LAS u32x2*)(lds + GL_QE + offb(16 * mt + i, 4 * ks + (g4 >> 1)) + (g4 & 1) * 8), hi = *(const LAS u32x2*)(lds + GL_QE + offb(16 * mt + i, 4 * ks + 2 + (g4 >> 1)) + (g4 & 1) * 8);
                u32x4 aw; aw.x = lo.x; aw.y = lo.y; aw.z = hi.x; aw.w = hi.y; const bf16x8 a = __builtin_bit_cast(bf16x8, aw);
                o[mt][0] = MFMA16(a, sb[0], o[mt][0]); o[mt][1] = MFMA16(a, sb[1], o[mt][1]); } }
#pragma unroll
        for (int mt = 0; mt < 4; ++mt)
#pragma unroll
            for (int rg = 0; rg < 4; ++rg) { const int sq = 16 * mt + 4 * g4 + rg; LAS bf16* op = (LAS bf16*)(lds + GL_OST + sq * 512 + (32 * w + i) * 2); op[0] = f2bf(o[mt][0][rg]); op[16] = f2bf(o[mt][1][rg]); }
        gla_state_update(S, lds, w, lane);
        __syncthreads();
        { u32x4 ov[4]; float ss = 0.f;
#pragma unroll
          for (int k = 0; k < 4; ++k) { ov[k] = *(const LAS u32x4*)(lds + GL_OST + erow * 512 + 16 * (ep + 8 * k));
              const float a0 = bflo(ov[k].x), a1 = bfhi(ov[k].x), a2 = bflo(ov[k].y), a3 = bfhi(ov[k].y), a4 = bflo(ov[k].z), a5 = bfhi(ov[k].z), a6 = bflo(ov[k].w), a7 = bfhi(ov[k].w);
              ss += (a0 * a0 + a1 * a1) + (a2 * a2 + a3 * a3) + (a4 * a4 + a5 * a5) + (a6 * a6 + a7 * a7); }
          ss += __shfl_xor(ss, 1); ss += __shfl_xor(ss, 2); ss += __shfl_xor(ss, 4);
          const float rstd = 1.0f / sqrtf(ss * (1.0f / 256.0f) + RMS_EPS);
#pragma unroll
          for (int k = 0; k < 4; ++k) { const int col = 8 * (ep + 8 * k); const f32x4 n0v = *(const f32x4*)(P.gnorm + col), n1v = *(const f32x4*)(P.gnorm + col + 4);
              const unsigned ow[4] = {ov[k].x, ov[k].y, ov[k].z, ov[k].w}, gw[4] = {gog[k].x, gog[k].y, gog[k].z, gog[k].w}; const float nw[8] = {n0v.x, n0v.y, n0v.z, n0v.w, n1v.x, n1v.y, n1v.z, n1v.w}; unsigned rw[4];
#pragma unroll
              for (int q = 0; q < 4; ++q) { const float ga = bflo(gw[q]), gb = bfhi(gw[q]); rw[q] = pk2(bflo(ow[q]) * rstd * nw[2 * q] * ga * sigmoidf_fast(ga), bfhi(ow[q]) * rstd * nw[2 * q + 1] * gb * sigmoidf_fast(gb)); }
              u32x4 res; res.x = rw[0]; res.y = rw[1]; res.z = rw[2]; res.w = rw[3];
              *(u32x4*)(OB + (mbase + erow) * D + h * 256 + col) = res; } }
        __syncthreads();
        if (ci < 7) { gla_put<true>(R, lds, tid); __syncthreads(); } }
}

DI void attn_merge(const Ptrs& P, int vcu, int G, int tid) {
    const int lane = tid & 63, wave = tid >> 6, gw = vcu * 8 + wave, NGW = G * 8, h = lane >> 4;
    const unsigned char* OG8 = (const unsigned char*)P.out + OUT_OG; const float* LSE = (const float*)((const unsigned char*)P.out + OUT_LSE); bf16* OA = (bf16*)(P.ws + WS_OA);
    for (int m0 = gw * 4; m0 < T; m0 += NGW * 4) {
        float l[4][3]; u32x2 v[4][3];
#pragma unroll
        for (int q = 0; q < 4; ++q)
#pragma unroll
            for (int g = 0; g < 3; ++g) { l[q][g] = LSE[((size_t)g * T + m0 + q) * 4 + h]; v[q][g] = *(const u32x2*)(OG8 + ((size_t)g * T + m0 + q) * 512 + 8 * lane); }
#pragma unroll
        for (int q = 0; q < 4; ++q) { const float mx = fmaxf(l[q][0], fmaxf(l[q][1], l[q][2])); float w0 = __expf(l[q][0] - mx), w1 = __expf(l[q][1] - mx), w2 = __expf(l[q][2] - mx); const float inv = 1.0f / (w0 + w1 + w2); w0 *= inv; w1 *= inv; w2 *= inv;
            const u32x2 a = v[q][0], bq = v[q][1], c = v[q][2];
            const f32x2 a0 = __builtin_amdgcn_cvt_pk_f32_fp8((int)a.x, false), a1 = __builtin_amdgcn_cvt_pk_f32_fp8((int)a.x, true), a2 = __builtin_amdgcn_cvt_pk_f32_fp8((int)a.y, false), a3 = __builtin_amdgcn_cvt_pk_f32_fp8((int)a.y, true);
            const f32x2 b0 = __builtin_amdgcn_cvt_pk_f32_fp8((int)bq.x, false), b1 = __builtin_amdgcn_cvt_pk_f32_fp8((int)bq.x, true), b2 = __builtin_amdgcn_cvt_pk_f32_fp8((int)bq.y, false), b3 = __builtin_amdgcn_cvt_pk_f32_fp8((int)bq.y, true);
            const f32x2 c0 = __builtin_amdgcn_cvt_pk_f32_fp8((int)c.x, false), c1 = __builtin_amdgcn_cvt_pk_f32_fp8((int)c.x, true), c2 = __builtin_amdgcn_cvt_pk_f32_fp8((int)c.y, false), c3 = __builtin_amdgcn_cvt_pk_f32_fp8((int)c.y, true);
            u32x4 o;
            o.x = pk2(w0 * a0.x + w1 * b0.x + w2 * c0.x, w0 * a0.y + w1 * b0.y + w2 * c0.y);
            o.y = pk2(w0 * a1.x + w1 * b1.x + w2 * c1.x, w0 * a1.y + w1 * b1.y + w2 * c1.y);
            o.z = pk2(w0 * a2.x + w1 * b2.x + w2 * c2.x, w0 * a2.y + w1 * b2.y + w2 * c2.y);
            o.w = pk2(w0 * a3.x + w1 * b3.x + w2 * c3.x, w0 * a3.y + w1 * b3.y + w2 * c3.y);
            *(u32x4*)(OA + (size_t)(m0 + q) * 512 + 8 * lane) = o; } }
}

DI void router_phase(const Ptrs& P, LAS unsigned char* lds, int G, int tid0) {
    int tid = tid0;
    const bf16* H1 = (const bf16*)(P.ws + WS_H1); unsigned char* HN8 = P.ws + WS_HN; const bf16* WRT = (const bf16*)(P.ws + WS_WRT);
    { int* RT = (int*)(P.ws + WS_ROWTOK); for (int idx = blockIdx.x * 512 + tid; idx < MAXTILES * 256; idx += G * 512) RT[idx] = 0; }
    int* ASG_E = (int*)(P.ws + WS_ASG_E); int* ASG_SLOT = (int*)(P.ws + WS_ASG_SLOT); float* ASG_G = (float*)(P.ws + WS_ASG_G);
    LAS float* LG = (LAS float*)lds; LAS int* lcnt = (LAS int*)(lds + 17408); LAS int* lbase = (LAS int*)(lds + 17536);
    unsigned* gcnt = (unsigned*)(P.ctl + CW_CNT);
    for (int tb = blockIdx.x; tb < T / 128; tb += G) {
        asm volatile("" : "+v"(tid));
        const int lane = tid & 63, w = tid >> 6, i = lane & 15, g4 = lane >> 4;
        if (tid < 32) lcnt[tid] = 0;
        __syncthreads();
        const int t = tb * 128 + 16 * w + i; const bf16* hrow = H1 + (size_t)t * D + 8 * g4;
        float ss = 0.f; { const float* ps = (const float*)(P.ws + WS_PS) + t;
#pragma unroll
            for (int j = 0; j < 16; ++j) ss += ps[(size_t)j * T]; }
        const float rstd = 1.0f / sqrtf(ss * (1.0f / D) + RMS_EPS);
        f32x4 a0 = {0.f, 0.f, 0.f, 0.f}, a1 = {0.f, 0.f, 0.f, 0.f};
#pragma unroll 1
        for (int cb = 0; cb < 32; cb += 8) {
            u32x4 hv[8]; f32x4 w0[8], w1[8]; bf16x8 b0[8], b1[8];
#pragma unroll
            for (int j = 0; j < 8; ++j) { const int c = cb + j; hv[j] = *(const u32x4*)(hrow + 32 * c); w0[j] = *(const f32x4*)(P.ln2 + 32 * c + 8 * g4); w1[j] = *(const f32x4*)(P.ln2 + 32 * c + 8 * g4 + 4);
                b0[j] = *(const bf16x8*)(WRT + (size_t)i * D + 32 * c + 8 * g4); b1[j] = *(const bf16x8*)(WRT + (size_t)(16 + i) * D + 32 * c + 8 * g4); }
            __builtin_amdgcn_sched_barrier(0);
#pragma unroll
            for (int j = 0; j < 8; ++j) { const int c = cb + j; const f32x4 u0 = w0[j] * rstd, u1 = w1[j] * rstd;
                const float y0 = bflo(hv[j].x) * u0.x, y1 = bfhi(hv[j].x) * u0.y, y2 = bflo(hv[j].y) * u0.z, y3 = bfhi(hv[j].y) * u0.w, y4 = bflo(hv[j].z) * u1.x, y5 = bfhi(hv[j].z) * u1.y, y6 = bflo(hv[j].w) * u1.z, y7 = bfhi(hv[j].w) * u1.w;
                int q0 = 0, q1 = 0; q0 = __builtin_amdgcn_cvt_pk_fp8_f32(y0, y1, q0, false); q0 = __builtin_amdgcn_cvt_pk_fp8_f32(y2, y3, q0, true); q1 = __builtin_amdgcn_cvt_pk_fp8_f32(y4, y5, q1, false); q1 = __builtin_amdgcn_cvt_pk_fp8_f32(y6, y7, q1, true);
                u32x2 q; q.x = (unsigned)q0; q.y = (unsigned)q1; *(u32x2*)(HN8 + (size_t)t * D + 32 * c + 8 * g4) = q;
                u32x4 y; y.x = pk2(y0, y1); y.y = pk2(y2, y3); y.z = pk2(y4, y5); y.w = pk2(y6, y7);
                const bf16x8 af = __builtin_bit_cast(bf16x8, y); a0 = MFMA16(af, b0[j], a0); a1 = MFMA16(af, b1[j], a1); } }
        const float br0 = P.br[i], br1 = P.br[16 + i];
#pragma unroll
        for (int rg = 0; rg < 4; ++rg) { LG[(w * 16 + 4 * g4 + rg) * 33 + i] = a0[rg] + br0; LG[(w * 16 + 4 * g4 + rg) * 33 + 16 + i] = a1[rg] + br1; }
        LDS_WAIT(); asm volatile("" ::: "memory");
        int es[4] = {0, 0, 0, 0}, ls[4] = {0, 0, 0, 0}; float gs[4] = {0.f, 0.f, 0.f, 0.f};
        if (lane < 16) { float lg[32];
#pragma unroll
            for (int e = 0; e < 32; ++e) lg[e] = LG[(w * 16 + lane) * 33 + e];
            unsigned taken = 0u; float tv[4];
#pragma unroll
            for (int k = 0; k < 4; ++k) { float best = -3.0e38f; int bi = 0;
#pragma unroll
                for (int e = 0; e < 32; ++e) { const bool ok = !((taken >> e) & 1u) && lg[e] > best; best = ok ? lg[e] : best; bi = ok ? e : bi; }
                taken |= 1u << bi; es[k] = bi; tv[k] = best; }
            const float e1 = __expf(tv[1] - tv[0]), e2 = __expf(tv[2] - tv[0]), e3 = __expf(tv[3] - tv[0]), inv = 1.0f / (1.0f + e1 + e2 + e3);
            gs[0] = inv; gs[1] = e1 * inv; gs[2] = e2 * inv; gs[3] = e3 * inv;
#pragma unroll
            for (int k = 0; k < 4; ++k) ls[k] = __hip_atomic_fetch_add(lcnt + es[k], 1, __ATOMIC_RELAXED, __HIP_MEMORY_SCOPE_WORKGROUP); }
        if (lane < 16) { const int tt = tb * 128 + 16 * w + lane;
#pragma unroll
            for (int k = 0; k < 4; ++k) { ASG_E[4 * tt + k] = es[k]; ASG_SLOT[4 * tt + k] = ls[k]; ASG_G[4 * tt + k] = gs[k]; } }
        __syncthreads();
        if (tid < 32) gcnt[tb * 32 + tid] = (unsigned)lcnt[tid];
        __syncthreads();
    }
}
DI void moe_colsum(const unsigned* cnt, int nrows, LAS int* red, int tid, int& out) {
    const int e = tid & 31, part = tid >> 5; unsigned c = 0;
#pragma unroll 4
    for (int r = part; r < nrows; r += 16) c += cnt[r * 32 + e];
    red[tid] = (int)c;
    __syncthreads();
    if (tid < 32) { int t = 0;
#pragma unroll
        for (int p = 0; p < 16; ++p) t += red[p * 32 + tid];
        out = t; }
}
DI void moe_tables(const Ptrs& P, LAS int* ts, int tid) {
    int c = 0; moe_colsum((const unsigned*)(P.ctl + CW_CNT), T / 128, ts + 128, tid, c);
    if (tid < 64) { int tiles = (tid < 32) ? ((c + 255) >> 8) : 0, inc = tiles;
#pragma unroll
        for (int o = 1; o < 32; o <<= 1) { const int v = __shfl_up(inc, o); if ((tid & 63) >= o) inc += v; }
        if (tid < 32) { ts[tid] = inc - tiles; ts[40 + tid] = c; } if (tid == 31) ts[32] = inc; }
    __syncthreads();
}
DI void moe_scatter(const Ptrs& P, LAS unsigned char* lds, int vcu, int G, int tid) {
    LAS int* ts = (LAS int*)(lds + TBL_OFF); moe_tables(P, ts, tid); LAS int* bs = ts + 80;
    const int* ASG_E = (const int*)(P.ws + WS_ASG_E); const int* ASG_SLOT = (const int*)(P.ws + WS_ASG_SLOT); int* ASG_ROW = (int*)(P.ws + WS_ASG_ROW); int* RT = (int*)(P.ws + WS_ROWTOK);
    const unsigned* cnt = (const unsigned*)(P.ctl + CW_CNT);
    for (int tb = blockIdx.x; tb < T / 128; tb += G) {
        { int c = 0; moe_colsum(cnt, tb, ts + 128, tid, c); if (tid < 32) bs[tid] = c; }
        __syncthreads();
        { const int a = tb * 512 + tid, e = ASG_E[a], row = ts[e] * 256 + bs[e] + ASG_SLOT[a]; ASG_ROW[a] = row; RT[row] = a >> 2; }
        __syncthreads(); }
}
constexpr int LT_OFF = 131072 + 2048;
template <class Sched> DI void moe_unit_tokens(const Ptrs& P, const Sched& S, LAS unsigned short* lt, int tid) {
    const int* RT = (const int*)(P.ws + WS_ROWTOK); int pmv[17];
#pragma unroll
    for (int i = 0; i < 17; ++i) { pg8::Unit u; pmv[i] = S.next(i, u) ? u.pm : -1; }
    if (tid < 256) { int tk[17];
#pragma unroll
        for (int i = 0; i < 17; ++i) tk[i] = (pmv[i] >= 0) ? RT[pmv[i] * 256 + tid] : 0;
#pragma unroll
        for (int i = 0; i < 17; ++i) if (pmv[i] >= 0) lt[i * 256 + tid] = (unsigned short)tk[i]; }
    __syncthreads();
}
DI void final_phase(const Ptrs& P, int vcu, int G, int tid) {
    const int lane = tid & 63, wave = tid >> 6, gw = vcu * 8 + wave, NGW = G * 8;
    const int* ASG_ROW = (const int*)(P.ws + WS_ASG_ROW); const float* ASG_G = (const float*)(P.ws + WS_ASG_G); const unsigned char* YB8 = P.ws + WS_YB;
#if BRINGUP == 1
    for (int t = gw; t < T; t += NGW) { const f32x4* hr = (const f32x4*)(P.x + (size_t)t * D) + lane; f32x4 v[4]; float s = 0.f;
#pragma unroll
        for (int j = 0; j < 4; ++j) { v[j] = hr[64 * j]; s += (v[j].x * v[j].x + v[j].y * v[j].y) + (v[j].z * v[j].z + v[j].w * v[j].w); }
        const float rstd = 1.f / sqrtf(wave_sum(s) * (1.f / D) + RMS_EPS); f32x4* orow = (f32x4*)(P.out + (size_t)t * D) + lane; const f32x4* wr = (const f32x4*)P.lnf + lane;
#pragma unroll
        for (int j = 0; j < 4; ++j) orow[64 * j] = v[j] * rstd * wr[64 * j]; }
#else
    const bf16* H1 = (const bf16*)(P.ws + WS_H1);
    f32x4 lw[4];
#pragma unroll
    for (int j = 0; j < 4; ++j) lw[j] = ((const f32x4*)P.lnf + lane)[64 * j];
    typedef int i32x4 __attribute__((ext_vector_type(4)));
    constexpr int TPI = 4;
    int t0 = gw * TPI;
    i32x4 rws[TPI]; f32x4 gts[TPI];
    if (t0 < T) {
#pragma unroll
        for (int q = 0; q < TPI; ++q) { rws[q] = *(const i32x4*)(ASG_ROW + 4 * (t0 + q)); gts[q] = *(const f32x4*)(ASG_G + 4 * (t0 + q)); } }
    for (; t0 < T; t0 += NGW * TPI) {
        u32x2 hq[TPI][4]; unsigned yq[TPI][4][4];
#pragma unroll
        for (int q = 0; q < TPI; ++q) { const u32x2* hr = (const u32x2*)(H1 + (size_t)(t0 + q) * D) + lane;
#pragma unroll
            for (int j = 0; j < 4; ++j) hq[q][j] = hr[64 * j];
#pragma unroll
            for (int k = 0; k < 4; ++k) { const unsigned* yr = (const unsigned*)(YB8 + (size_t)rws[q][k] * D) + lane;
#pragma unroll
                for (int j = 0; j < 4; ++j) yq[q][k][j] = yr[64 * j]; } }
        f32x4 gc[TPI];
#pragma unroll
        for (int q = 0; q < TPI; ++q) gc[q] = gts[q];
        const int tn = t0 + NGW * TPI;
        if (tn < T) {
#pragma unroll
            for (int q = 0; q < TPI; ++q) { rws[q] = *(const i32x4*)(ASG_ROW + 4 * (tn + q)); gts[q] = *(const f32x4*)(ASG_G + 4 * (tn + q)); } }
#pragma unroll
        for (int q = 0; q < TPI; ++q) { f32x4 v[4]; float s = 0.f;
#pragma unroll
            for (int j = 0; j < 4; ++j) { v[j].x = bflo(hq[q][j].x); v[j].y = bfhi(hq[q][j].x); v[j].z = bflo(hq[q][j].y); v[j].w = bfhi(hq[q][j].y);
#pragma unroll
                for (int k = 0; k < 4; ++k) { const float gk = gc[q][k]; const int y = (int)yq[q][k][j]; const f32x2 lo = __builtin_amdgcn_cvt_pk_f32_fp8(y, false), hi = __builtin_amdgcn_cvt_pk_f32_fp8(y, true);
                    v[j].x += gk * lo.x; v[j].y += gk * lo.y; v[j].z += gk * hi.x; v[j].w += gk * hi.y; }
                s += (v[j].x * v[j].x + v[j].y * v[j].y) + (v[j].z * v[j].z + v[j].w * v[j].w); }
            const float rstd = 1.f / sqrtf(wave_sum(s) * (1.f / D) + RMS_EPS);
            f32x4* orow = (f32x4*)(P.out + (size_t)(t0 + q) * D) + lane;
#pragma unroll
            for (int j = 0; j < 4; ++j) { f32x4 ov = v[j] * rstd * lw[j];
#if STAMP_PHASE >= 0
                if (t0 + q == 0 && lane == 0 && j == 0) { const unsigned long long* st = (const unsigned long long*)(P.ws + WS_CTL + 65536); ov.x += (float)(st[STAMP_PHASE + 1] - st[STAMP_PHASE]) * 0.0005f; }
#endif
                orow[64 * j] = ov; } }
    }
#endif
}

constexpr int N_PHASES = 12;
struct Args { const float* in[17]; float* out; unsigned char* ws; int ph_lo, ph_hi; };
__global__ void __launch_bounds__(512, 2) fwd(Args args) {
    extern __shared__ __attribute__((aligned(16))) unsigned char lds_raw[];
    LAS unsigned char* lds = (LAS unsigned char*)lds_raw;
    const int tid = threadIdx.x, G = gridDim.x; const int bx = blockIdx.x; const int vcu = (G % 8 == 0) ? (bx % 8) * (G / 8) + bx / 8 : bx;
    Ptrs P;
    P.x = args.in[0]; P.ln1 = args.in[1]; P.w_in = args.in[2]; P.w_gk2 = args.in[3]; P.b_gk2 = args.in[4]; P.gnorm = args.in[5]; P.wpa = args.in[6]; P.wpb = args.in[7]; P.wout = args.in[8];
    P.ln2 = args.in[9]; P.wr = args.in[10]; P.br = args.in[11]; P.wup = args.in[12]; P.bup = args.in[13]; P.wdn = args.in[14]; P.bdn = args.in[15]; P.lnf = args.in[16];
    P.out = args.out; P.ws = args.ws; P.ctl = (gu32*)(args.ws + WS_CTL);
    volatile LAS unsigned* MISC = (volatile LAS unsigned*)(lds + MISC_OFF);
    for (int u = tid; u < (LDS_BYTES - MISC_OFF) / 4; u += 512) ((LAS unsigned*)(lds + MISC_OFF))[u] = 0u;
    __syncthreads();
    XcdBarrier bar; bar.bar = (unsigned*)(P.ctl + CW_BAR); bar.x = 0; bar.st = nullptr;
    if (MK_N_LAUNCHES == 1) bar = xcd_barrier_post((unsigned*)(P.ctl + CW_BAR), MISC + 8);
    const int lo = args.ph_lo, hi = args.ph_hi;
#ifndef PH_MASK
#define PH_MASK 0xFFF
#endif
#define IN(k) (((PH_MASK >> (k)) & 1) && lo <= (k) && (k) < hi)
#define SEAM(k) do { if (IN(k) && IN((k) + 1)) xcd_barrier(bar); } while (0)
#define STAMP(k) do { if (STAMP_PHASE >= 0 && bx == 0 && tid == 0) ((unsigned long long*)(P.ws + WS_CTL + 65536))[k] = wall_clock64(); } while (0)
#define DUP(k, ...) do { __VA_ARGS__; if ((DUP_MASK >> (k)) & 1) { __syncthreads(); __VA_ARGS__; } } while (0)
    bf16* PROJ = (bf16*)(P.ws + WS_PROJ); bf16* XN = (bf16*)(P.ws + WS_XN); bf16* MIXED = XN;

    STAMP(0);
    if (IN(0)) { DUP(0, p0_prologue(P, lds, vcu, G, tid)); } SEAM(0);
#if BRINGUP == 0
    STAMP(1);
    if (IN(1)) { pg8::Gemm g{XN, (const bf16*)(P.ws + WS_WIN), T, NP, D / 2, 0}; pg8::StaticOrder S; S.init(T, NP, G, bx);
        pg8::EpiProj<true> E{PROJ, P.b_gk2, (const float*)(P.ws + WS_SX), (const float*)(P.ws + WS_SWIN)};
        const int nq_items = (32 * 64 + 32 * 32 + G - 1) / G, rounds = (S.nwg + G - 1) / G, phs = bx & 1;
        if (!phs) { p0_quant_all(P, lds, vcu, G, tid, 0, nq_items); __syncthreads(); }
        { int t_ = tid; asm volatile("" : "+v"(t_)); pg8::gemm_phase<pg8::EpiProj<true>, pg8::StaticOrder, 2>(lds, g, S, E, t_); }
        if (phs) { __syncthreads(); p0_quant_all(P, lds, vcu, G, tid, 0, nq_items); }
    } SEAM(1);
    STAMP(2);
    if (IN(2)) { bf16* OG = (bf16*)((unsigned char*)P.out + OUT_OG); float* LSE = (float*)((unsigned char*)P.out + OUT_LSE);
        DUP(12, for (int u = vcu; u < 768; u += G) attn_task(P.ws, OG, LSE, lds, u, tid));
        DUP(13, for (int u = bx; u < 256; u += G) gla_pass1(P, lds, u, tid)); } SEAM(2);
    STAMP(3);
    if (IN(3)) { gla_scan(P, vcu, G, tid); attn_merge(P, vcu, G, tid); } SEAM(3);
    STAMP(4);
    if (IN(4)) { DUP(4, for (int u = bx; u < 256; u += G) gla_pass2(P, lds, u, tid)); } SEAM(4);
    STAMP(5);
    if (IN(5)) { { pg8::Gemm g{(const bf16*)(P.ws + WS_OA), (const bf16*)(P.ws + WS_WPA), T, D, 512, 0}; pg8::StaticOrder S; S.init(T, D, G, bx); pg8::EpiGate<false> E{MIXED, (const unsigned char*)(PROJ + 64 * PLANE), (unsigned char*)P.out  }; pg8::gemm_phase(lds, g, S, E); }
                 { pg8::Gemm g{(const bf16*)(P.ws + WS_OB), (const bf16*)(P.ws + WS_WPB), T, D, D, 0}; pg8::StaticOrder S; S.init(T, D, G, bx); pg8::EpiGate<true> E{MIXED, (const unsigned char*)(PROJ + 64 * PLANE) + 1024, (unsigned char*)P.out}; pg8::gemm_phase(lds, g, S, E); } } SEAM(5);
    STAMP(6);
    if (IN(6)) { pg8::Gemm g{MIXED, (const bf16*)(P.ws + WS_WOUT), T, D, D, 0}; pg8::StaticOrder S; S.init(T, D, G, bx); pg8::EpiResBf16 E{P.x, (bf16*)(P.ws + WS_H1), (float*)(P.ws + WS_PS)}; pg8::gemm_phase(lds, g, S, E); } SEAM(6);
#elif BRINGUP == 2
    if (IN(6)) { for (size_t idx = (size_t)vcu * 512 + tid; idx < (size_t)T * D / 2; idx += (size_t)G * 512) ((unsigned*)(P.ws + WS_H1))[idx] = pk2(P.x[2 * idx], P.x[2 * idx + 1]); } SEAM(6);
#endif
#if BRINGUP != 1
    STAMP(7);
    if (IN(7)) { router_phase(P, lds, G, tid); } SEAM(7);
    STAMP(8);
    if (IN(8)) { moe_scatter(P, lds, vcu, G, tid); } SEAM(8);
    STAMP(9);
    if (IN(9)) { LAS int* ts = (LAS int*)(lds + TBL_OFF); moe_tables(P, ts, tid); LAS unsigned short* lt = (LAS unsigned short*)(lds + LT_OFF);
        pg8::MoeOrder S; S.init(ts[32] * 256, 2048, G, bx); S.ts = ts; moe_unit_tokens(P, S, lt, tid);
        pg8::Gemm g{(const bf16*)(P.ws + WS_HN), (const bf16*)(P.ws + WS_WUP), 0, 2048, D / 2, (size_t)2048 * 512, lt};
        pg8::EpiSwiGLU8 E{P.ws + WS_ACT, P.bup, (const float*)(P.ws + WS_SUP)}; DUP(9, pg8::gemm_phase<pg8::EpiSwiGLU8, pg8::MoeOrder, 1, true>(lds, g, S, E)); } SEAM(9);
    STAMP(10);
    if (IN(10)) { LAS int* ts = (LAS int*)(lds + TBL_OFF); moe_tables(P, ts, tid);
        pg8::Gemm g{(const bf16*)(P.ws + WS_ACT), (const bf16*)(P.ws + WS_WDN), 0, D, D / 2, (size_t)1024 * 512, nullptr}; pg8::MoeOrder S; S.init(ts[32] * 256, D, G, bx); S.ts = ts;
        pg8::EpiDown8 E{P.ws + WS_YB, P.bdn, (const float*)(P.ws + WS_SDN)}; DUP(10, pg8::gemm_phase<pg8::EpiDown8, pg8::MoeOrder, 1, false>(lds, g, S, E)); } SEAM(10);
#endif
    STAMP(11);
    if (IN(11)) { DUP(11, final_phase(P, vcu, G, tid)); }
#undef IN
#undef SEAM
}

extern "C" void kernel_launch(void* const* d_in, const int* in_sizes, int n_in, void* d_out, int out_size, void* d_ws, size_t ws_size, hipStream_t stream) {
    static int grid = 0;
    if (grid == 0) {
        if (n_in != 17 || out_size != T * D || ws_size < WS_END) { fprintf(stderr, "kernel_launch: unexpected shapes (n_in %d out %d ws %zu, need %zu)\n", n_in, out_size, ws_size, (size_t)WS_END); grid = -1; return; }
        int dev = 0, cus = 0;
        if (hipGetDevice(&dev) != hipSuccess || hipDeviceGetAttribute(&cus, hipDeviceAttributeMultiprocessorCount, dev) != hipSuccess) { grid = -1; return; }
        if (hipFuncSetAttribute((const void*)fwd, hipFuncAttributeMaxDynamicSharedMemorySize, LDS_BYTES) != hipSuccess) { grid = -1; return; }
        int per_cu = 0; (void)hipOccupancyMaxActiveBlocksPerMultiprocessor(&per_cu, (const void*)fwd, 512, LDS_BYTES); (void)hipGetLastError();
        grid = cus;
    }
    if (grid < 0) return;
    (void)hipMemsetAsync((char*)d_ws + WS_CTL, 0, CTL_ZERO_BYTES, stream);
    Args a{};
    for (int i = 0; i < 17; ++i) a.in[i] = (const float*)d_in[i];
    a.out = (float*)d_out; a.ws = (unsigned char*)d_ws;
    if (MK_N_LAUNCHES == 1) { a.ph_lo = 0; a.ph_hi = N_PHASES; hipLaunchKernelGGL(fwd, dim3(grid), dim3(512), LDS_BYTES, stream, a); }
    else { for (int p = 0; p < N_PHASES; ++p) { a.ph_lo = p; a.ph_hi = p + 1; hipLaunchKernelGGL(fwd, dim3(grid), dim3(512), LDS_BYTES, stream, a); } }
}
```

```cpp
#include <hip/hip_runtime.h>
#include <cstdio>
#include <cstdint>

#ifndef MK_N_LAUNCHES
#define MK_N_LAUNCHES 1
#endif
#ifndef DUP_MASK
#define DUP_MASK 0
#endif
#ifndef STAMP_PHASE
#define STAMP_PHASE -1
#endif
#ifndef BRINGUP
#define BRINGUP 0
#endif

#define DI __device__ __forceinline__
#define LAS __attribute__((address_space(3)))
#define GAS __attribute__((address_space(1)))
typedef unsigned short bf16;
typedef short bf16x8 __attribute__((ext_vector_type(8)));
typedef short s16x4 __attribute__((ext_vector_type(4)));
typedef short v4i16_t __attribute__((ext_vector_type(4)));
typedef float f32x4 __attribute__((ext_vector_type(4)));
typedef float f32x2 __attribute__((ext_vector_type(2)));
typedef unsigned u32x4 __attribute__((ext_vector_type(4)));
typedef unsigned u32x2 __attribute__((ext_vector_type(2)));
typedef __bf16 bf16v2 __attribute__((ext_vector_type(2)));
typedef GAS unsigned gu32;
#define RLX_AGENT __ATOMIC_RELAXED, __HIP_MEMORY_SCOPE_AGENT
#define LDS_WAIT() asm volatile("s_waitcnt lgkmcnt(0)" ::: "memory")
#define VM_WAIT() asm volatile("s_waitcnt vmcnt(0)" ::: "memory")

DI unsigned pk2(float a, float b) { bf16v2 v; v.x = (__bf16)a; v.y = (__bf16)b; return __builtin_bit_cast(unsigned, v); }
DI float bflo(unsigned w) { return __uint_as_float(w << 16); }
DI float bfhi(unsigned w) { return __uint_as_float(w & 0xffff0000u); }
DI float bf2f(bf16 b) { return __uint_as_float(((unsigned)b) << 16); }
DI bf16 f2bf(float f) { return (bf16)(pk2(f, 0.f) & 0xffffu); }
DI float sigmoidf_fast(float z) { return __builtin_amdgcn_rcpf(1.0f + __builtin_amdgcn_exp2f(-1.4426950408889634f * z)); }
DI f32x2 pk_fma(f32x2 a, f32x2 b, f32x2 c) { f32x2 d; asm volatile("v_pk_fma_f32 %0, %1, %2, %3" : "=v"(d) : "v"(a), "v"(b), "v"(c)); return d; }
DI f32x2 pk_mul(f32x2 a, f32x2 b) { f32x2 d; asm volatile("v_pk_mul_f32 %0, %1, %2" : "=v"(d) : "v"(a), "v"(b)); return d; }
DI f32x2 pk_add(f32x2 a, f32x2 b) { f32x2 d; asm volatile("v_pk_add_f32 %0, %1, %2" : "=v"(d) : "v"(a), "v"(b)); return d; }
DI f32x2 pk_mul_t(f32x2 a, f32x2 b) { f32x2 d; asm volatile("s_nop 0\n\tv_pk_mul_f32 %0, %1, %2" : "=v"(d) : "v"(a), "v"(b)); return d; }
DI f32x2 pk_add_t(f32x2 a, f32x2 b) { f32x2 d; asm volatile("s_nop 0\n\tv_pk_add_f32 %0, %1, %2" : "=v"(d) : "v"(a), "v"(b)); return d; }
DI f32x2 lo2(f32x4 v) { return __builtin_shufflevector(v, v, 0, 1); }
DI f32x2 hi2(f32x4 v) { return __builtin_shufflevector(v, v, 2, 3); }
DI bf16x8 cat8(s16x4 lo, s16x4 hi) { bf16x8 r; r[0] = lo[0]; r[1] = lo[1]; r[2] = lo[2]; r[3] = lo[3]; r[4] = hi[0]; r[5] = hi[1]; r[6] = hi[2]; r[7] = hi[3]; return r; }
#define MFMA16(a, b, c) __builtin_amdgcn_mfma_f32_16x16x32_bf16((a), (b), (c), 0, 0, 0)

constexpr int T = 32768, SEQ = 16384, D = 1024, NP = 10240, IN_W = 9744;
constexpr int C_GQ = 4608, C_GK = 5120, C_GV = 5632, C_GOG = 6656, C_GF = 7680, C_MA = 8192, C_MB = 9216;
constexpr int NEXP = 32, NASG = T * 4, MAXTILES = 544;
constexpr float RMS_EPS = 1e-5f;

namespace pg8 {
#define PG8_LAS __attribute__((address_space(3)))
typedef unsigned short bf16_t;
constexpr int BM = 256, BK = 64, HALF = 128, HTB = HALF * BK * 2, STAGE_BYTES = 8 * HTB, NXCD = 8, WGM = 8;
__host__ __device__ __forceinline__ int lds_byte(int r, int c) { const int st = (r >> 4) * 2 + (c >> 5), rr = r & 15, cc = c & 31, ob = rr * 64 + cc * 2; return st * 1024 + (ob ^ (((ob >> 9) & 1) << 5)); }
__host__ __device__ __forceinline__ void stage_rc(int b, int& R, int& C) { const int st = b / 1024, sb = b % 1024, swz = sb ^ (((sb >> 9) & 1) << 5); R = (st >> 1) * 16 + swz / 64; C = (st & 1) * 32 + (swz % 64) / 2; }
__host__ __device__ __forceinline__ int perm32(int rho) { const int n = rho >> 4, i = rho & 15; return 8 * (i >> 2) + 4 * n + (i & 3); }

struct Unit { int pm, pn, e; };
struct Gemm { const bf16_t* A; const bf16_t* Bt; int M, N, K; size_t bstride; const PG8_LAS unsigned short* lt; };

struct StaticOrder {
    int nM, nN, nwg, G, c, ibeg = 0, iend = 0x7fffffff;
    __host__ __device__ void init(int M, int N, int G_, int c_) { nM = M / BM; nN = N / BM; nwg = nM * nN; G = G_; c = c_; ibeg = 0; iend = 0x7fffffff; }
    __host__ __device__ bool next(int i, Unit& u) const {
        i += ibeg; if (i >= iend) return false;
        const long L = (long)i * G + c; if (L >= nwg) return false;
        int wgid = (int)L; { const int q = nwg / NXCD, r = nwg % NXCD, xcd = wgid % NXCD, off = wgid / NXCD; wgid = (xcd < r ? xcd * (q + 1) : r * (q + 1) + (xcd - r) * q) + off; }
        const int nig = WGM * nN, gid = wgid / nig, fm = gid * WGM, gsz = (nM - fm) < WGM ? (nM - fm) : WGM;
        u.pm = fm + ((wgid % nig) % gsz); u.pn = (wgid % nig) / gsz; u.e = 0; return true;
    }
};
struct MoeOrder : StaticOrder {
    const PG8_LAS int* ts;
    __device__ __forceinline__ bool next(int i, Unit& u) const {
        if (!StaticOrder::next(i, u)) return false;
        int e = 0;
#pragma unroll 1
        while (e < 31 && u.pm >= ts[e + 1]) ++e;
        u.e = e; return true;
    }
};

struct EpiStoreBf16 {
    static constexpr int PERM = 1; static constexpr bool HAS_VEC = false;
    bf16_t* O; int ldc; const float* bias; int bias_estride;
    __device__ __forceinline__ void operator()(const f32x4 (&acc)[2][2][4][2], const Unit& u, int wr, int wc, int fr, int fq, const PG8_LAS float* vec) const {
        const int row0 = u.pm * BM + wr * 64 + fr, col0 = u.pn * BM + wc * 32 + 8 * fq;
        f32x4 bv[2][2];
#pragma unroll
        for (int bj = 0; bj < 2; ++bj)
#pragma unroll
            for (int n = 0; n < 2; ++n) bv[bj][n] = bias ? *(const f32x4*)(bias + (size_t)u.e * bias_estride + col0 + bj * HALF + 4 * n) : (f32x4){0.f, 0.f, 0.f, 0.f};
#pragma unroll
        for (int ai = 0; ai < 2; ++ai)
#pragma unroll
            for (int m = 0; m < 4; ++m) { bf16_t* rowp = O + (size_t)(row0 + ai * HALF + m * 16) * ldc + col0;
#pragma unroll
                for (int bj = 0; bj < 2; ++bj) { const f32x4 v0 = acc[ai][bj][m][0] + bv[bj][0], v1 = acc[ai][bj][m][1] + bv[bj][1];
                    u32x4 w; w.x = pk2(v0[0], v0[1]); w.y = pk2(v0[2], v0[3]); w.z = pk2(v1[0], v1[1]); w.w = pk2(v1[2], v1[3]);
                    *(u32x4*)(rowp + bj * HALF) = w; } }
    }
};
template <bool I8> struct EpiProj {
    static constexpr int PERM = 2; static constexpr bool HAS_VEC = I8; static constexpr int NSTORE = 8;
    bf16_t* P; const float* bgk2; const float* sx; const float* sw;
    __device__ __forceinline__ const float* vec_src(const Unit& u, int L) const { const int o = (L & 63) * 4; return L < 64 ? sw + u.pn * BM + o : sx + u.pm * BM + o; }
    template <bool ISG, bool F8, bool NT = false> __device__ __forceinline__ void block(const f32x4 (&acc)[2][2][4][2], int cb, size_t base, int pitch, int dsh, float sc, int row0, int x0, int colL, int wr, int fr, const PG8_LAS float* vec) const {
        f32x4 bb[2][2], cc[2][2];
#pragma unroll
        for (int bj = 0; bj < 2; ++bj)
#pragma unroll
            for (int n = 0; n < 2; ++n) { bb[bj][n] = ISG ? *(const f32x4*)(bgk2 + (cb - 60) * 128 + x0 + 8 * bj + 4 * n) : (f32x4){0.f, 0.f, 0.f, 0.f};
                cc[bj][n] = I8 ? *(const PG8_LAS f32x4*)(vec + colL + 8 * bj + 4 * n) * sc : (f32x4){sc, sc, sc, sc}; }
#pragma unroll
        for (int ai = 0; ai < 2; ++ai)
#pragma unroll
            for (int m = 0; m < 4; ++m) { const int r = row0 + ai * HALF + m * 16, s = r & (SEQ - 1); const size_t rp = (size_t)(r & ~(SEQ - 1)) + (size_t)((s & ((1 << dsh) - 1)) << (14 - dsh)) + (size_t)(s >> dsh);
                const float rs = I8 ? vec[256 + wr * 64 + fr + ai * HALF + m * 16] : 1.0f; f32x4 v[2][2];
#pragma unroll
                for (int bj = 0; bj < 2; ++bj)
#pragma unroll
                    for (int n = 0; n < 2; ++n) { f32x4 t = acc[ai][bj][m][n];
                        if (I8) { typedef int i4_t_ __attribute__((ext_vector_type(4))); const i4_t_ ti = {__float_as_int(t[0]), __float_as_int(t[1]), __float_as_int(t[2]), __float_as_int(t[3])};
                            t = __builtin_convertvector(ti, f32x4) * (cc[bj][n] * rs); }
                        else t = t * cc[bj][n];
                        if (ISG) {
#pragma unroll
                            for (int j = 0; j < 4; ++j) { const float xa = t[j] + bb[bj][n][j];
                                t[j] = fminf(xa, 0.f) * (1.0f / 16.0f) - (0.6931471805599453f / 16.0f) * __builtin_amdgcn_logf(1.0f + __builtin_amdgcn_exp2f(-1.4426950408889634f * fabsf(xa))); } }
                        v[bj][n] = t; }
                if (F8) { u32x4 w;
#pragma unroll
                    for (int bj = 0; bj < 2; ++bj)
#pragma unroll
                        for (int n = 0; n < 2; ++n) { int t = 0; t = __builtin_amdgcn_cvt_pk_fp8_f32(v[bj][n][0], v[bj][n][1], t, false); t = __builtin_amdgcn_cvt_pk_fp8_f32(v[bj][n][2], v[bj][n][3], t, true); w[2 * bj + n] = (unsigned)t; }
                    if (NT) __builtin_nontemporal_store(w, (u32x4*)((unsigned char*)P + 2 * base + rp * pitch + x0)); else *(u32x4*)((unsigned char*)P + 2 * base + rp * pitch + x0) = w; }
                else {
#pragma unroll
                    for (int bj = 0; bj < 2; ++bj) { u32x4 w; w.x = pk2(v[bj][0][0], v[bj][0][1]); w.y = pk2(v[bj][0][2], v[bj][0][3]); w.z = pk2(v[bj][1][0], v[bj][1][1]); w.w = pk2(v[bj][1][2], v[bj][1][3]);
                        if (NT) __builtin_nontemporal_store(w, (u32x4*)(P + base + rp * pitch + x0 + 8 * bj)); else *(u32x4*)(P + base + rp * pitch + x0 + 8 * bj) = w; } } }
    }
    __device__ __forceinline__ void operator()(const f32x4 (&acc)[2][2][4][2], const Unit& u, int wr, int wc, int fr, int fq, const PG8_LAS float* vec) const {
        const int row0 = u.pm * BM + wr * 64 + fr, colL = 64 * wc + 16 * fq, x0 = colL & 127;
        const int cb = __builtin_amdgcn_readfirstlane(2 * u.pn + (wc >> 1));
        size_t base; int pitch = 128, dsh = 0; float sc = 1.0f;
        if (cb < 36) { base = (size_t)cb * T * 128; dsh = 2 * (cb / 12); if ((cb % 12) < 4) sc = 0.08838834764831845f * 1.4426950408889634f; }
        else if (cb < 44) { base = (size_t)cb * T * 128; if (cb < 40) sc = 0.08838834764831845f; }
        else if (cb < 60) { const int gb = (cb < 52) ? 44 : 52; base = (size_t)gb * T * 128 + (size_t)((cb - gb) >> 1) * T * 256 + ((cb - gb) & 1) * 128; pitch = 256; }
        else if (cb < 64) { base = (size_t)cb * T * 128; }
        else { base = (size_t)64 * T * 128 + (size_t)(cb - 64) * 64; pitch = 2048; }
        if (cb >= 60 && cb < 64) block<true, false>(acc, cb, base, pitch, dsh, sc, row0, x0, colL, wr, fr, vec);
        else if (cb >= 64) block<false, true, true>(acc, cb, base, pitch, dsh, sc, row0, x0, colL, wr, fr, vec);
        else if (cb < 36) block<false, true>(acc, cb, base, pitch, dsh, sc, row0, x0, colL, wr, fr, vec);
        else if (cb < 40 || cb >= 52) block<false, false, true>(acc, cb, base, pitch, dsh, sc, row0, x0, colL, wr, fr, vec);
        else block<false, false>(acc, cb, base, pitch, dsh, sc, row0, x0, colL, wr, fr, vec);
    }
};
template <bool ADD> struct EpiGate {
    static constexpr int PERM = 2; static constexpr bool HAS_VEC = false; static constexpr int NSTORE = 8;
    bf16_t* O; const unsigned char* G8; unsigned char* PART8;
    __device__ __forceinline__ void operator()(const f32x4 (&acc)[2][2][4][2], const Unit& u, int wr, int wc, int fr, int fq, const PG8_LAS float* vec) const {
        const int row0 = u.pm * BM + wr * 64 + fr, col0 = u.pn * BM + 64 * wc + 16 * fq;
        u32x4 gw[2][4], pw[2][4];
#pragma unroll
        for (int ai = 0; ai < 2; ++ai)
#pragma unroll
            for (int m = 0; m < 4; ++m) { const size_t r = (size_t)(row0 + ai * HALF + m * 16); gw[ai][m] = __builtin_nontemporal_load((const u32x4*)(G8 + r * 2048 + col0)); pw[ai][m] = ADD ? *(const u32x4*)(PART8 + r * D + col0) : (u32x4){0u, 0u, 0u, 0u}; }
        __builtin_amdgcn_sched_barrier(0);
#pragma unroll
        for (int ai = 0; ai < 2; ++ai)
#pragma unroll
            for (int m = 0; m < 4; ++m) { const size_t r = (size_t)(row0 + ai * HALF + m * 16); u32x4 w8; u32x4 wb[2];
#pragma unroll
                for (int bj = 0; bj < 2; ++bj)
#pragma unroll
                    for (int n = 0; n < 2; ++n) { const int gd = (int)gw[ai][m][2 * bj + n], pd = (int)pw[ai][m][2 * bj + n];
                        const f32x2 g0 = __builtin_amdgcn_cvt_pk_f32_fp8(gd, false), g1 = __builtin_amdgcn_cvt_pk_f32_fp8(gd, true);
                        f32x2 p0 = {0.f, 0.f}, p1 = {0.f, 0.f}; if (ADD) { p0 = __builtin_amdgcn_cvt_pk_f32_fp8(pd, false); p1 = __builtin_amdgcn_cvt_pk_f32_fp8(pd, true); }
                        const f32x4 v = acc[ai][bj][m][n];
                        const float r0 = p0.x + sigmoidf_fast(g0.x) * v[0], r1 = p0.y + sigmoidf_fast(g0.y) * v[1], r2 = p1.x + sigmoidf_fast(g1.x) * v[2], r3 = p1.y + sigmoidf_fast(g1.y) * v[3];
                        if (ADD) { wb[bj][2 * n] = pk2(r0, r1); wb[bj][2 * n + 1] = pk2(r2, r3); }
                        else { int t = 0; t = __builtin_amdgcn_cvt_pk_fp8_f32(r0, r1, t, false); t = __builtin_amdgcn_cvt_pk_fp8_f32(r2, r3, t, true); w8[2 * bj + n] = (unsigned)t; } }
                if (ADD) { *(u32x4*)(O + r * D + col0) = wb[0]; *(u32x4*)(O + r * D + col0 + 8) = wb[1]; }
                else *(u32x4*)(PART8 + r * D + col0) = w8; }
    }
};
struct EpiResBf16 {
    static constexpr int PERM = 1; static constexpr bool HAS_VEC = false; static constexpr int NSTORE = 16;
    const float* base; bf16_t* O; float* PS;
    __device__ __forceinline__ void operator()(const f32x4 (&acc)[2][2][4][2], const Unit& u, int wr, int wc, int fr, int fq, const PG8_LAS float* vec) const {
        const int row0 = u.pm * BM + wr * 64 + fr, col0 = u.pn * BM + wc * 32 + 8 * fq; float ssv[2][4];
#pragma unroll
        for (int ai = 0; ai < 2; ++ai) {
            f32x4 bv[4][2][2];
#pragma unroll
            for (int m = 0; m < 4; ++m) { const size_t off = (size_t)(row0 + ai * HALF + m * 16) * D + col0;
#pragma unroll
                for (int bj = 0; bj < 2; ++bj) { bv[m][bj][0] = __builtin_nontemporal_load((const f32x4*)(base + off + bj * HALF)); bv[m][bj][1] = __builtin_nontemporal_load((const f32x4*)(base + off + bj * HALF + 4)); } }
            __builtin_amdgcn_sched_barrier(0);
#pragma unroll
            for (int m = 0; m < 4; ++m) { const size_t off = (size_t)(row0 + ai * HALF + m * 16) * D + col0; float ss = 0.f;
#pragma unroll
                for (int bj = 0; bj < 2; ++bj) { const f32x4 v0 = bv[m][bj][0] + acc[ai][bj][m][0], v1 = bv[m][bj][1] + acc[ai][bj][m][1];
                    ss += (v0[0] * v0[0] + v0[1] * v0[1]) + (v0[2] * v0[2] + v0[3] * v0[3]) + (v1[0] * v1[0] + v1[1] * v1[1]) + (v1[2] * v1[2] + v1[3] * v1[3]);
                    u32x4 w; w.x = pk2(v0[0], v0[1]); w.y = pk2(v0[2], v0[3]); w.z = pk2(v1[0], v1[1]); w.w = pk2(v1[2], v1[3]);
                    *(u32x4*)(O + off + bj * HALF) = w; }
                ss += __shfl_xor(ss, 16); ss += __shfl_xor(ss, 32); ssv[ai][m] = ss; } }
        if (fq == 0) {
#pragma unroll
            for (int ai = 0; ai < 2; ++ai)
#pragma unroll
                for (int m = 0; m < 4; ++m) PS[(size_t)(u.pn * 4 + wc) * T + row0 + ai * HALF + m * 16] = ssv[ai][m]; }
    }
};
struct EpiSwiGLU8 {
    static constexpr int PERM = 3; static constexpr bool HAS_VEC = true; static constexpr int NSTORE = 4;
    unsigned char* O; const float* bup; const float* cs;
    __device__ __forceinline__ const float* vec_src(const Unit& u, int L) const { const int seg = L >> 5, o = (L & 31) * 4;
        return seg == 0 ? bup + (size_t)u.e * 2048 + u.pn * 128 + o : seg == 1 ? bup + (size_t)u.e * 2048 + 1024 + u.pn * 128 + o : seg == 2 ? cs + (size_t)u.e * 2048 + u.pn * 256 + o : cs + (size_t)u.e * 2048 + u.pn * 256 + 128 + o; }
    __device__ __forceinline__ void operator()(const f32x4 (&acc)[2][2][4][2], const Unit& u, int wr, int wc, int fr, int fq, const PG8_LAS float* vec) const {
        const int row0 = u.pm * BM + wr * 64 + fr, x0 = wc * 32 + 16 * (fq & 1) + 8 * (fq >> 1), xs = wc * 32 + 16 * (fq & 1), hi = fq >> 1;
        const f32x4 bgv[2] = {*(const PG8_LAS f32x4*)(vec + x0), *(const PG8_LAS f32x4*)(vec + x0 + 4)}, blv[2] = {*(const PG8_LAS f32x4*)(vec + 128 + x0), *(const PG8_LAS f32x4*)(vec + 128 + x0 + 4)};
        const f32x4 sgv[2] = {*(const PG8_LAS f32x4*)(vec + 256 + x0), *(const PG8_LAS f32x4*)(vec + 256 + x0 + 4)}, slv[2] = {*(const PG8_LAS f32x4*)(vec + 384 + x0), *(const PG8_LAS f32x4*)(vec + 384 + x0 + 4)};
        f32x2 kc2 = {-1.702f * 1.4426950408889634f, -1.702f * 1.4426950408889634f}, one2 = {1.0f, 1.0f};
#pragma unroll
        for (int ai = 0; ai < 2; ++ai) { u32x2 pkd[4];
#pragma unroll
            for (int m = 0; m < 4; ++m) { float r[8];
#pragma unroll
                for (int n = 0; n < 2; ++n)
#pragma unroll
                    for (int hh = 0; hh < 2; ++hh) {
                        const f32x2 ag = hh ? hi2(acc[ai][0][m][n]) : lo2(acc[ai][0][m][n]), al = hh ? hi2(acc[ai][1][m][n]) : lo2(acc[ai][1][m][n]);
                        const f32x2 gv = pk_fma(ag, hh ? hi2(sgv[n]) : lo2(sgv[n]), hh ? hi2(bgv[n]) : lo2(bgv[n])), lv = pk_fma(al, hh ? hi2(slv[n]) : lo2(slv[n]), hh ? hi2(blv[n]) : lo2(blv[n]));
                        const f32x2 xg = {__builtin_amdgcn_fmed3f(gv.x, -3.0e38f, 7.0f), __builtin_amdgcn_fmed3f(gv.y, -3.0e38f, 7.0f)}, xl = {__builtin_amdgcn_fmed3f(lv.x, -7.0f, 7.0f), __builtin_amdgcn_fmed3f(lv.y, -7.0f, 7.0f)};
                        const f32x2 za = pk_mul(xg, kc2), ex = {__builtin_amdgcn_exp2f(za.x), __builtin_amdgcn_exp2f(za.y)}, dn = pk_add_t(ex, one2);
                        const f32x2 rc = {__builtin_amdgcn_rcpf(dn.x), __builtin_amdgcn_rcpf(dn.y)}, tt = pk_mul_t(xg, rc), rr = pk_fma(xl, tt, tt);
                        r[4 * n + 2 * hh] = rr.x; r[4 * n + 2 * hh + 1] = rr.y; }
                int w0 = 0, w1 = 0;
                w0 = __builtin_amdgcn_cvt_pk_fp8_f32(r[0], r[1], w0, false); w0 = __builtin_amdgcn_cvt_pk_fp8_f32(r[2], r[3], w0, true);
                w1 = __builtin_amdgcn_cvt_pk_fp8_f32(r[4], r[5], w1, false); w1 = __builtin_amdgcn_cvt_pk_fp8_f32(r[6], r[7], w1, true);
                pkd[m].x = (unsigned)w0; pkd[m].y = (unsigned)w1; }
#pragma unroll
            for (int m = 0; m < 4; m += 2) { u32x2 a = pkd[m], bq = pkd[m + 1];
                { auto t = __builtin_amdgcn_permlane32_swap(a.x, bq.x, false, false); a.x = t[0]; bq.x = t[1]; }
                { auto t = __builtin_amdgcn_permlane32_swap(a.y, bq.y, false, false); a.y = t[0]; bq.y = t[1]; }
                u32x4 w; w.x = a.x; w.y = a.y; w.z = bq.x; w.w = bq.y;
                *(u32x4*)(O + (size_t)(row0 + ai * HALF + (m + hi) * 16) * D + u.pn * 128 + xs) = w; } }
    }
};
struct EpiDown8 {
    static constexpr int PERM = 2; static constexpr bool HAS_VEC = true; static constexpr int NSTORE = 8;
    unsigned char* O; const float* bias; const float* cs;
    __device__ __forceinline__ const float* vec_src(const Unit& u, int L) const { const int o = (L & 63) * 4; return (L < 64 ? bias : cs) + (size_t)u.e * D + u.pn * BM + o; }
    __device__ __forceinline__ void operator()(const f32x4 (&acc)[2][2][4][2], const Unit& u, int wr, int wc, int fr, int fq, const PG8_LAS float* vec) const {
        const int row0 = u.pm * BM + wr * 64 + fr, colL = 64 * wc + 16 * fq;
        f32x4 bv[2][2], sv[2][2];
#pragma unroll
        for (int bj = 0; bj < 2; ++bj)
#pragma unroll
            for (int n = 0; n < 2; ++n) { bv[bj][n] = *(const PG8_LAS f32x4*)(vec + colL + 8 * bj + 4 * n); sv[bj][n] = *(const PG8_LAS f32x4*)(vec + 256 + colL + 8 * bj + 4 * n); }
#pragma unroll
        for (int ai = 0; ai < 2; ++ai)
#pragma unroll
            for (int m = 0; m < 4; ++m) { u32x4 w;
#pragma unroll
                for (int bj = 0; bj < 2; ++bj)
#pragma unroll
                    for (int n = 0; n < 2; ++n) { const f32x4 v = acc[ai][bj][m][n] * sv[bj][n] + bv[bj][n]; int t = 0; t = __builtin_amdgcn_cvt_pk_fp8_f32(v[0], v[1], t, false); t = __builtin_amdgcn_cvt_pk_fp8_f32(v[2], v[3], t, true); w[2 * bj + n] = (unsigned)t; }
                *(u32x4*)(O + (size_t)(row0 + ai * HALF + m * 16) * D + u.pn * BM + colL) = w; }
    }
};
constexpr int EPV_OFF = 131072 + 12288;
typedef int v8i_t __attribute__((ext_vector_type(8)));
typedef int v4i_t __attribute__((ext_vector_type(4)));
template <class Epi, class Sched, int DT = 0, bool GATHER = false, bool ALIGN_EPI = true, bool SP2 = true>
__device__ __forceinline__ void gemm_phase(PG8_LAS unsigned char* lds, const Gemm g, const Sched& S, const Epi& E, const int tid = threadIdx.x) {
    const int wid = __builtin_amdgcn_readfirstlane(tid >> 6), lane = tid & 63, wr = wid >> 2, wc = wid & 3, fr = lane & 15, fq = lane >> 4;
    const int K = g.K, nt = K / BK;
    unsigned voffA[2], voffB0[2], voffB1[2]; int gR[2], gC[2];
#pragma unroll
    for (int i = 0; i < 2; ++i) { int R, C; stage_rc(tid * 16 + i * 8192, R, C);
        voffA[i] = (unsigned)(R * K + C) * 2u; gR[i] = R; gC[i] = C * 2;
        if constexpr (Epi::PERM == 2) { const int c0 = 64 * (R >> 5) + 16 * ((R >> 2) & 3) + 4 * ((R >> 4) & 1) + (R & 3); voffB0[i] = (unsigned)(c0 * K + C) * 2u; voffB1[i] = (unsigned)((c0 + 8) * K + C) * 2u; }
        else if constexpr (Epi::PERM == 3) { const int fqv = (R >> 2) & 3, c0 = 32 * (R >> 5) + 16 * (fqv & 1) + 8 * (fqv >> 1) + 4 * ((R >> 4) & 1) + (R & 3);
            voffB0[i] = (unsigned)(c0 * K + C) * 2u; voffB1[i] = voffB0[i] + (unsigned)(HALF * K) * 2u; }
        else { const int Rb = Epi::PERM ? ((R & ~31) + perm32(R & 31)) : R; voffB0[i] = (unsigned)(Rb * K + C) * 2u; voffB1[i] = voffB0[i] + (unsigned)(HALF * K) * 2u; } }
    unsigned offC[2][2], offN[2][2];
#define PG8_GOFF(dst, uidx) do { _Pragma("unroll") for (int _h = 0; _h < 2; ++_h) _Pragma("unroll") for (int _i = 0; _i < 2; ++_i) \
        dst[_h][_i] = (unsigned)g.lt[(uidx) * 256 + _h * 128 + gR[_i]] * (unsigned)(K * 2) + (unsigned)gC[_i]; } while (0)
    const size_t kstep = (size_t)(BK * 2), hstep = (size_t)HALF * K * 2, tstep = 2 * hstep, estep = g.bstride * 2;
    const unsigned ldsw = (unsigned)wid * 1024u;
    const int aoff = lds_byte(wr * 64 + fr, fq * 8), boff = lds_byte(wc * 32 + fr, fq * 8);
#define PG8_SA(b, h) (((b) * 2 + (h)) * HTB)
#define PG8_SB(b, h) ((4 + (b) * 2 + (h)) * HTB)
#define PG8_STAGE(bufoff, gbase, voff) do { _Pragma("unroll") for (int _i = 0; _i < 2; ++_i) \
        __builtin_amdgcn_global_load_lds((const unsigned*)((const char*)(gbase) + (voff)[_i]), (PG8_LAS unsigned*)(lds + (bufoff) + ldsw + _i * 8192), 16, 0, 0); } while (0)
#define PG8_LDA(dst, b, h) do { if constexpr (DT == 1) { _Pragma("unroll") for (int m = 0; m < 4; ++m) dst##8[m] = __builtin_shufflevector(*(const PG8_LAS v4i_t*)(lds + PG8_SA(b, h) + aoff + m * 2048), *(const PG8_LAS v4i_t*)(lds + PG8_SA(b, h) + aoff + m * 2048 + 1024), 0, 1, 2, 3, 4, 5, 6, 7); } \
        else { _Pragma("unroll") for (int m = 0; m < 4; ++m) _Pragma("unroll") for (int k = 0; k < 2; ++k) dst[m][k] = *(const PG8_LAS bf16x8*)(lds + PG8_SA(b, h) + aoff + m * 2048 + k * 1024); } } while (0)
#define PG8_LDB(dst, b, h) do { if constexpr (DT == 1) { _Pragma("unroll") for (int n = 0; n < 2; ++n) dst##8[n] = __builtin_shufflevector(*(const PG8_LAS v4i_t*)(lds + PG8_SB(b, h) + boff + n * 2048), *(const PG8_LAS v4i_t*)(lds + PG8_SB(b, h) + boff + n * 2048 + 1024), 0, 1, 2, 3, 4, 5, 6, 7); } \
        else { _Pragma("unroll") for (int n = 0; n < 2; ++n) _Pragma("unroll") for (int k = 0; k < 2; ++k) dst[n][k] = *(const PG8_LAS bf16x8*)(lds + PG8_SB(b, h) + boff + n * 2048 + k * 1024); } } while (0)
#define PG8_MMA(ai, bj, At, Bt) do { __builtin_amdgcn_s_setprio(1); if constexpr (DT == 1) { _Pragma("unroll") for (int m = 0; m < 4; ++m) _Pragma("unroll") for (int n = 0; n < 2; ++n) \
        asm volatile("v_mfma_scale_f32_16x16x128_f8f6f4 %0, %1, %2, %0, %3, %3 op_sel_hi:[0,0,0]" : "+v"(acc[ai][bj][m][n]) : "v"(Bt##8[n]), "v"(At##8[m]), "v"(sc1)); } \
        else if constexpr (DT == 2) { _Pragma("unroll") for (int m = 0; m < 4; ++m) _Pragma("unroll") for (int n = 0; n < 2; ++n) _Pragma("unroll") for (int k = 0; k < 2; ++k) \
        asm volatile("v_mfma_i32_16x16x64_i8 %0, %1, %2, %0" : "+v"(acc[ai][bj][m][n]) : "v"(Bt[n][k]), "v"(At[m][k])); } \
        else { _Pragma("unroll") for (int m = 0; m < 4; ++m) _Pragma("unroll") for (int n = 0; n < 2; ++n) _Pragma("unroll") for (int k = 0; k < 2; ++k) \
        acc[ai][bj][m][n] = __builtin_amdgcn_mfma_f32_16x16x32_bf16(Bt[n][k], At[m][k], acc[ai][bj][m][n], 0, 0, 0); } __builtin_amdgcn_s_setprio(0); } while (0)
#define PG8_STAGE_A(bufoff, h, which) do { if constexpr (GATHER) { _Pragma("unroll") for (int _i = 0; _i < 2; ++_i) { \
            const unsigned _o = ((which) == 1) ? offC[h][_i] : (last ? offN[h][_i] : offC[h][_i]); const size_t _kb = ((which) == 1) ? (size_t)(t + 1) * kstep : ((last ? (size_t)0 : (size_t)(t + 2) * kstep) + ((which) == 3 ? kstep : 0)); \
            __builtin_amdgcn_global_load_lds((const unsigned*)((const char*)g.A + _kb + _o), (PG8_LAS unsigned*)(lds + (bufoff) + ldsw + _i * 8192), 16, 0, 0); } } \
        else { const char* _p = ((which) == 1 ? a1 : ((which) == 2 ? a2 : a3)) + (h) * hstep; PG8_STAGE(bufoff, _p, voffA); } } while (0)
#define PG8_WAIT_V(n) asm volatile("s_waitcnt vmcnt(" #n ")" ::: "memory")
#define PG8_WAIT_L(n) asm volatile("s_waitcnt lgkmcnt(" #n ")" ::: "memory")
#define PG8_BAR __builtin_amdgcn_s_barrier()
#define PG8_SCHED __builtin_amdgcn_sched_barrier(0)
    static_assert(!GATHER || SP2, "GATHER is written for the SP2 loop");
    Unit cur, nxt; int ui = 0;
    if (!S.next(0, cur)) return;
#define PG8_EPV(u, uidx) do { if constexpr (Epi::HAS_VEC) { int _te = tid; asm volatile("" : "+v"(_te)); if (wid < 2) __builtin_amdgcn_global_load_lds((const unsigned*)E.vec_src(u, _te), (PG8_LAS unsigned*)(lds + EPV_OFF + ((uidx) & 1) * 2048 + wid * 1024), 16, 0, 0); } } while (0)
    PG8_EPV(cur, 0);
    f32x4 acc[2][2][4][2];
#pragma unroll
    for (int a = 0; a < 2; ++a)
#pragma unroll
        for (int b = 0; b < 2; ++b)
#pragma unroll
            for (int m = 0; m < 4; ++m)
#pragma unroll
                for (int n = 0; n < 2; ++n) acc[a][b][m][n] = (f32x4){0.f, 0.f, 0.f, 0.f};
    bf16x8 At[4][2], B0[2][2], B1[2][2]; v8i_t At8[4], B08[2], B18[2];
    int sc1 = 0x7F7F7F7F; asm volatile("" : "+v"(sc1));
    const char* cA = GATHER ? (const char*)g.A : (const char*)g.A + (size_t)cur.pm * tstep; const char* cB = (const char*)g.Bt + (size_t)cur.e * estep + (size_t)cur.pn * tstep;
    if constexpr (GATHER) { PG8_GOFF(offC, 0); }
#define PG8_STAGE_A0(bufoff, h, kb) do { if constexpr (GATHER) { _Pragma("unroll") for (int _i = 0; _i < 2; ++_i) \
            __builtin_amdgcn_global_load_lds((const unsigned*)((const char*)g.A + (size_t)(kb) + offC[h][_i]), (PG8_LAS unsigned*)(lds + (bufoff) + ldsw + _i * 8192), 16, 0, 0); } \
        else PG8_STAGE(bufoff, cA + (h) * hstep + (kb), voffA); } while (0)
    if constexpr (SP2) {
        PG8_STAGE(PG8_SB(0, 0), cB, voffB0); PG8_STAGE(PG8_SB(0, 1), cB, voffB1); PG8_STAGE_A0(PG8_SA(0, 0), 0, 0); PG8_STAGE_A0(PG8_SA(0, 1), 1, 0);
        if (wr == 1) PG8_BAR;
        PG8_WAIT_V(2); PG8_BAR;
        PG8_STAGE(PG8_SB(1, 0), cB + kstep, voffB0); PG8_STAGE_A0(PG8_SA(1, 0), 0, kstep); PG8_STAGE(PG8_SB(1, 1), cB + kstep, voffB1);
        PG8_WAIT_V(6); PG8_BAR;
    } else {
        PG8_STAGE(PG8_SB(0, 0), cB, voffB0); PG8_STAGE(PG8_SA(0, 0), cA, voffA); PG8_STAGE(PG8_SB(0, 1), cB, voffB1); PG8_STAGE(PG8_SA(0, 1), cA + hstep, voffA);
        if (wr == 1) PG8_BAR;
        PG8_WAIT_V(4); PG8_BAR;
        PG8_STAGE(PG8_SB(1, 0), cB + kstep, voffB0); PG8_STAGE(PG8_SA(1, 0), cA + kstep, voffA); PG8_STAGE(PG8_SB(1, 1), cB + kstep, voffB1);
        PG8_WAIT_V(6); PG8_BAR;
    }
    for (;;) {
        const bool has_next = S.next(ui + 1, nxt);
        const char* nA = (has_next && !GATHER) ? (const char*)g.A + (size_t)nxt.pm * tstep : cA; const char* nB = has_next ? (const char*)g.Bt + (size_t)nxt.e * estep + (size_t)nxt.pn * tstep : cB;
        if constexpr (GATHER) { if (has_next) { PG8_GOFF(offN, ui + 1); } else {
#pragma unroll
            for (int _h = 0; _h < 2; ++_h) { offN[_h][0] = offC[_h][0]; offN[_h][1] = offC[_h][1]; } } }
#pragma unroll 1
        for (int t = 0; t < nt; t += 2) {
            const bool last = (t == nt - 2);
            const char* a1 = cA + (size_t)(t + 1) * kstep;
            const char* a2 = last ? nA : cA + (size_t)(t + 2) * kstep; const char* b2 = last ? nB : cB + (size_t)(t + 2) * kstep;
            const char* a3 = a2 + kstep; const char* b3 = b2 + kstep;
            if constexpr (SP2) {
            PG8_LDB(B0, 0, 0); PG8_LDB(B1, 0, 1); PG8_SCHED; PG8_LDA(At, 0, 0); PG8_STAGE_A(PG8_SA(1, 1), 1, 1);
            PG8_WAIT_V(8); PG8_WAIT_L(0); PG8_BAR; PG8_MMA(0, 0, At, B0); PG8_MMA(0, 1, At, B1); PG8_BAR; PG8_SCHED;
            PG8_LDA(At, 0, 1); PG8_STAGE(PG8_SB(0, 0), b2, voffB0); PG8_STAGE(PG8_SB(0, 1), b2, voffB1); PG8_STAGE_A(PG8_SA(0, 0), 0, 2);
            PG8_WAIT_V(8); PG8_WAIT_L(0); PG8_BAR; PG8_MMA(1, 0, At, B0); PG8_MMA(1, 1, At, B1); PG8_BAR; PG8_SCHED;
            PG8_LDB(B0, 1, 0); PG8_LDB(B1, 1, 1); PG8_SCHED; PG8_LDA(At, 1, 0); PG8_STAGE_A(PG8_SA(0, 1), 1, 2);
            PG8_WAIT_V(8); PG8_WAIT_L(0); PG8_BAR; PG8_MMA(0, 0, At, B0); PG8_MMA(0, 1, At, B1); PG8_BAR; PG8_SCHED;
            PG8_LDA(At, 1, 1); PG8_STAGE(PG8_SB(1, 0), b3, voffB0); PG8_STAGE(PG8_SB(1, 1), b3, voffB1); PG8_STAGE_A(PG8_SA(1, 0), 0, 3);
            PG8_WAIT_V(8); PG8_WAIT_L(0); PG8_BAR; PG8_MMA(1, 0, At, B0); PG8_MMA(1, 1, At, B1); PG8_BAR; PG8_SCHED;
            } else {
            PG8_LDB(B0, 0, 0); PG8_SCHED; PG8_LDA(At, 0, 0); PG8_STAGE(PG8_SA(1, 1), a1 + hstep, voffA);
            PG8_WAIT_L(8); PG8_BAR; PG8_WAIT_L(0); PG8_MMA(0, 0, At, B0); PG8_BAR; PG8_SCHED;
            PG8_LDB(B1, 0, 1); PG8_STAGE(PG8_SB(0, 0), b2, voffB0);
            PG8_BAR; PG8_WAIT_L(0); PG8_MMA(0, 1, At, B1); PG8_BAR;
            PG8_LDA(At, 0, 1); PG8_STAGE(PG8_SA(0, 0), a2, voffA);
            PG8_BAR; PG8_WAIT_L(0); PG8_MMA(1, 0, At, B0); PG8_BAR; PG8_SCHED;
            PG8_STAGE(PG8_SB(0, 1), b2, voffB1);
            PG8_WAIT_V(6); PG8_BAR; PG8_MMA(1, 1, At, B1); PG8_BAR;
            PG8_LDB(B0, 1, 0); PG8_SCHED; PG8_LDA(At, 1, 0); PG8_STAGE(PG8_SA(0, 1), a2 + hstep, voffA);
            PG8_WAIT_L(8); PG8_BAR; PG8_WAIT_L(0); PG8_MMA(0, 0, At, B0); PG8_BAR; PG8_SCHED;
            PG8_LDB(B1, 1, 1); PG8_STAGE(PG8_SB(1, 0), b3, voffB0);
            PG8_BAR; PG8_WAIT_L(0); PG8_MMA(0, 1, At, B1); PG8_BAR;
            PG8_LDA(At, 1, 1); PG8_STAGE(PG8_SA(1, 0), a3, voffA);
            PG8_BAR; PG8_WAIT_L(0); PG8_MMA(1, 0, At, B0); PG8_BAR; PG8_SCHED;
            PG8_STAGE(PG8_SB(1, 1), b3, voffB1);
            PG8_WAIT_V(6); PG8_BAR; PG8_MMA(1, 1, At, B1); PG8_BAR;
            }
        }
        if constexpr (DT != 0) asm volatile("s_nop 15\n\ts_nop 15\n\ts_nop 7" ::: "memory");
        if constexpr (ALIGN_EPI) { if (wr == 0) PG8_BAR; }
        E(acc, cur, wr, wc, fr, fq, (const PG8_LAS float*)(lds + EPV_OFF + (ui & 1) * 2048));
        if (!has_next) break;
#pragma unroll
        for (int a = 0; a < 2; ++a)
#pragma unroll
            for (int b = 0; b < 2; ++b)
#pragma unroll
                for (int m = 0; m < 4; ++m)
#pragma unroll
                    for (int n = 0; n < 2; ++n) acc[a][b][m][n] = (f32x4){0.f, 0.f, 0.f, 0.f};
        cur = nxt; cA = nA; cB = nB; ++ui;
        PG8_EPV(cur, ui);
        if constexpr (GATHER) {
#pragma unroll
            for (int _h = 0; _h < 2; ++_h) { offC[_h][0] = offN[_h][0]; offC[_h][1] = offN[_h][1]; } }
        if constexpr (ALIGN_EPI) { if (wr == 1) PG8_BAR; }
    }
    PG8_WAIT_V(0);
    if constexpr (!ALIGN_EPI) { if (wr == 0) PG8_BAR; }
    PG8_BAR;
#undef PG8_SA
#undef PG8_SB
#undef PG8_STAGE
#undef PG8_EPV
#undef PG8_STAGE_A
#undef PG8_STAGE_A0
#undef PG8_GOFF
#undef PG8_LDA
#undef PG8_LDB
#undef PG8_MMA
#undef PG8_WAIT_V
#undef PG8_WAIT_L
#undef PG8_BAR
#undef PG8_SCHED
}
}

constexpr size_t MiB = 1u << 20;
constexpr size_t WS_CTL = 0, CTL_ZERO_BYTES = 1 * MiB;
constexpr size_t WS_ASG_E = 1 * MiB, WS_ASG_SLOT = WS_ASG_E + (size_t)NASG * 4, WS_ASG_G = WS_ASG_SLOT + (size_t)NASG * 4, WS_ASG_ROW = WS_ASG_G + (size_t)NASG * 4;
constexpr size_t WS_WRT = 3 * MiB;
constexpr size_t WS_SUP = WS_WRT + 64 * 1024, WS_SDN = WS_SUP + 32 * 2048 * 4;
constexpr size_t WS_ROWTOK = WS_SDN + 32 * 1024 * 4;
constexpr size_t WS_WPA = 4 * MiB, WS_WPB = 5 * MiB, WS_WOUT = 7 * MiB, WS_WIN = 9 * MiB;
constexpr size_t WS_WUP = 29 * MiB, WS_WDN = 93 * MiB;
constexpr size_t WS_XN = 125 * MiB;
constexpr size_t WS_GSTATE = WS_XN, WS_GDEC = WS_XN + 32 * MiB;
constexpr size_t WS_SX = WS_XN + 40 * MiB, WS_SWIN = WS_XN + 41 * MiB;
constexpr size_t WS_OA = 189 * MiB, WS_OB = 221 * MiB;
constexpr size_t WS_H1 = WS_OA;
constexpr size_t WS_HN = WS_OB + 32 * MiB;
constexpr size_t WS_PROJ = 285 * MiB;
constexpr size_t WS_ACT = WS_PROJ, WS_YB = WS_PROJ + 136 * MiB;
constexpr size_t WS_PS = WS_PROJ + 300 * MiB;
constexpr size_t WS_END = 925 * MiB;
static_assert(WS_ROWTOK + (size_t)MAXTILES * 256 * 4 <= WS_WPA && WS_PROJ + (size_t)T * NP * 2 == WS_END && WS_YB + (size_t)MAXTILES * 256 * D * 2 <= WS_END && (size_t)MAXTILES * 256 * D <= 136 * MiB, "d_ws map");
constexpr size_t OUT_OG = 0, OUT_LSE = 96 * MiB;
constexpr int CW_BAR = 4096, CW_CNT = 32768;
constexpr int RING_BYTES = 131072, MISC_OFF = RING_BYTES, TBL_OFF = RING_BYTES + 512, LDS_BYTES = 147456;

#define XB_TMO      128
#define XB_XCNT(j)  (256  + 64 * (j))
#define XB_XSUB(j)  (1280 + 64 * (j))
#define XB_XGEN(j)  (2304 + 64 * (j))
#define XB_TOP      3328
#define XB_TOPGEN   3392
#define XCD_BAR_WORDS 3456
#define XB_SPIN_CAP (1u << 18)
__device__ __forceinline__ unsigned xb_ld(unsigned* p)              { return __hip_atomic_load(p, __ATOMIC_RELAXED, __HIP_MEMORY_SCOPE_AGENT); }
__device__ __forceinline__ unsigned xb_add(unsigned* p, unsigned v) { return __hip_atomic_fetch_add(p, v, __ATOMIC_RELAXED, __HIP_MEMORY_SCOPE_AGENT); }
__device__ __forceinline__ unsigned xb_xcc_id() { return (unsigned)__builtin_amdgcn_s_getreg((3 << 11) | 20) & 0xFu; }
#define XB_SPIN(cond, bar) do { unsigned _sp = 0; while (cond) { __builtin_amdgcn_s_sleep(1); \
    if ((++_sp & 255u) == 0u) { if (xb_ld(&(bar)[XB_TMO])) break; if (_sp > XB_SPIN_CAP) { atomicAdd(&(bar)[XB_TMO], 1u); break; } } } } while (0)
struct XcdBarrier { unsigned* bar; unsigned x; volatile LAS unsigned* st; };
__device__ __forceinline__ XcdBarrier xcd_barrier_post(unsigned* bar, volatile LAS unsigned* st) {
    XcdBarrier b; b.bar = bar; b.x = xb_xcc_id(); b.st = st;
    if (threadIdx.x == 0) (void)xb_add(&bar[XB_XCNT(b.x)], 1u);
    return b;
}
__device__ __forceinline__ void xcd_barrier_complete(unsigned* bar, unsigned x, unsigned& nloc, unsigned& nx) {
    const unsigned G = gridDim.x * gridDim.y * gridDim.z;
    unsigned sum, cnt, mine, sp = 0u;
    for (;;) {
        sum = 0u; cnt = 0u; mine = 0u;
#pragma unroll
        for (unsigned j = 0; j < 16; ++j) { const unsigned c = xb_ld(&bar[XB_XCNT(j)]); sum += c; cnt += (c > 0u) ? 1u : 0u; mine = (j == x) ? c : mine; }
        if (sum == G) break;
        __builtin_amdgcn_s_sleep(1);
        if ((++sp & 255u) == 0u) { if (xb_ld(&bar[XB_TMO])) break; if (sp > XB_SPIN_CAP) { atomicAdd(&bar[XB_TMO], 1u); break; } }
    }
    nloc = mine > 0u ? mine : 1u; nx = cnt > 0u ? cnt : 1u;
}
__device__ __forceinline__ void xcd_barrier(const XcdBarrier& b) {
    asm volatile("s_waitcnt vmcnt(0)" ::: "memory");
    __syncthreads();
    if (threadIdx.x == 0) {
        unsigned* bar = b.bar;
        __builtin_amdgcn_s_waitcnt(0);
        unsigned nloc = b.st[0], nx = b.st[1];
        if (nloc == 0u) { xcd_barrier_complete(bar, b.x, nloc, nx); b.st[0] = nloc; b.st[1] = nx; }
        const unsigned old = xb_add(&bar[XB_XSUB(b.x)], 1u);
        const unsigned gen = old / nloc;
        if (old + 1u == (gen + 1u) * nloc) {
            __builtin_amdgcn_fence(__ATOMIC_RELEASE, "agent");
            asm volatile("s_waitcnt vmcnt(0)" ::: "memory");
            const unsigned og = xb_add(&bar[XB_TOP], 1u);
            const unsigned tg = og / nx;
            if (og + 1u == (tg + 1u) * nx) xb_add(&bar[XB_TOPGEN], 1u);
            else XB_SPIN(xb_ld(&bar[XB_TOPGEN]) == tg, bar);
            __builtin_amdgcn_fence(__ATOMIC_ACQUIRE, "agent");
            xb_add(&bar[XB_XGEN(b.x)], 1u);
            asm volatile("s_waitcnt vmcnt(0)" ::: "memory");
        } else {
            XB_SPIN(xb_ld(&bar[XB_XGEN(b.x)]) == gen, bar);
            __builtin_amdgcn_fence(__ATOMIC_ACQUIRE, "agent");
            asm volatile("s_waitcnt vmcnt(0)" ::: "memory");
        }
    }
    __syncthreads();
}

DI float wave_sum(float v) {
#pragma unroll
    for (int o = 1; o < 64; o <<= 1) v += __shfl_xor(v, o);
    return v;
}
DI unsigned offb(unsigned row, unsigned ch) { return 256u * row + 16u * (ch ^ (((row & 3u) << 2) | ((row >> 2) & 3u))); }
DI s16x4 vtr(const LAS unsigned char* p) { return __builtin_bit_cast(s16x4, __builtin_amdgcn_ds_read_tr16_b64_v4i16((LAS v4i16_t*)p)); }
DI s16x4 tr4(const LAS unsigned char* img, int rowbase, int c, int lane) { const int q = (lane & 15) >> 2, p = lane & 3; return vtr(img + offb((unsigned)(rowbase + q), (unsigned)(2 * c + (p >> 1))) + 8 * (p & 1)); }

struct Ptrs {
    const float *x, *ln1, *w_in, *w_gk2, *b_gk2, *gnorm, *wpa, *wpb, *wout, *ln2, *wr, *br, *wup, *bup, *wdn, *bdn, *lnf;
    float* out; unsigned char* ws; gu32* ctl;
};

DI void p0_tile(const float* W, int ldw, int k0, int sc0, bf16* WT, int K, int dr0, LAS float* scr, int lane) {
#pragma unroll 8
    for (int i = 0; i < 32; ++i) { const int kk = 2 * i + (lane >> 5); scr[kk * 33 + (lane & 31)] = W[(size_t)(k0 + kk) * ldw + sc0 + (lane & 31)]; }
    LDS_WAIT(); asm volatile("" ::: "memory");
    const int c = lane & 7;
#pragma unroll
    for (int j = 0; j < 4; ++j) { const int n = (lane >> 3) + 8 * j; const LAS float* s = scr + (8 * c) * 33 + n;
        u32x4 o; o.x = pk2(s[0 * 33], s[1 * 33]); o.y = pk2(s[2 * 33], s[3 * 33]); o.z = pk2(s[4 * 33], s[5 * 33]); o.w = pk2(s[6 * 33], s[7 * 33]);
        *(u32x4*)(WT + (size_t)(dr0 + n) * K + k0 + 8 * c) = o; }
    LDS_WAIT(); asm volatile("" ::: "memory");
}
DI void rms_row_to_bf16(const float* xrow, const float* w, bf16* orow, int lane) {
    const f32x4* xr = (const f32x4*)xrow + lane; const f32x4* wr = (const f32x4*)w + lane;
    f32x4 v[4]; float s = 0.f;
#pragma unroll
    for (int j = 0; j < 4; ++j) { v[j] = xr[64 * j]; s += (v[j].x * v[j].x + v[j].y * v[j].y) + (v[j].z * v[j].z + v[j].w * v[j].w); }
    const float rstd = 1.f / sqrtf(wave_sum(s) * (1.f / D) + RMS_EPS);
    u32x2* o8 = (u32x2*)orow + lane;
#pragma unroll
    for (int j = 0; j < 4; ++j) { const f32x4 ww = wr[64 * j]; u32x2 o; o.x = pk2(v[j].x * rstd * ww.x, v[j].y * rstd * ww.y); o.y = pk2(v[j].z * rstd * ww.z, v[j].w * rstd * ww.w); o8[64 * j] = o; }
}
constexpr int PMAX_OFF = 131072 + 1024;
struct QItem { const float* W; int ldw, sc0, dr0; unsigned char* W8; float* sc; };
DI QItem p0_qitem(const Ptrs& P, int it) { QItem q;
    if (it < 32 * 64) { const int e = it >> 6, nb = it & 63, c0 = 32 * nb; q.W = P.wup + (size_t)e * 1024 * 2048; q.ldw = 2048; q.sc0 = c0;
        q.dr0 = (c0 < 1024) ? 256 * (c0 >> 7) + (c0 & 127) : 256 * ((c0 - 1024) >> 7) + 128 + (c0 & 127); q.W8 = P.ws + WS_WUP + (size_t)e * 2048 * 1024; q.sc = (float*)(P.ws + WS_SUP) + e * 2048; }
    else { const int r = it - 32 * 64, e = r >> 5, nb = r & 31; q.W = P.wdn + (size_t)e * 1024 * 1024; q.ldw = 1024; q.sc0 = 32 * nb; q.dr0 = 32 * nb; q.W8 = P.ws + WS_WDN + (size_t)e * 1024 * 1024; q.sc = (float*)(P.ws + WS_SDN) + e * 1024; }
    return q; }
DI void p0_qload(f32x4 (&v)[16], const QItem& q, int w, int lane) {
#pragma unroll
    for (int i = 0; i < 16; ++i) v[i] = __builtin_nontemporal_load((const f32x4*)(q.W + (size_t)(128 * w + 8 * i + (lane >> 3)) * q.ldw + q.sc0 + 4 * (lane & 7)));
}
DI void p0_quant_all(const Ptrs& P, LAS unsigned char* lds, int vcu, int G, int tid, int j0, int j1) {
    const int lane = tid & 63, w = tid >> 6; LAS float* scr = (LAS float*)(lds + w * 16384); LAS float* PM = (LAS float*)(lds + PMAX_OFF);
    constexpr int NQ = 32 * 64 + 32 * 32; const int NQE = (vcu + (long)j1 * G < NQ) ? vcu + j1 * G : NQ;
    f32x4 v[16]; int it = vcu + j0 * G;
    if (it < NQE) p0_qload(v, p0_qitem(P, it), w, lane);
#pragma unroll 1
    for (; it < NQE; it += G) { const QItem q = p0_qitem(P, it);
        { const int ng8 = lane & 7, rsub = lane >> 3; f32x4 mx = {0.f, 0.f, 0.f, 0.f};
#pragma unroll
          for (int i = 0; i < 16; ++i) { const int kk = 8 * i + rsub; *(LAS f32x4*)(scr + kk * 32 + 4 * ((ng8 + (kk >> 4)) & 7)) = v[i];
              mx.x = fmaxf(mx.x, fabsf(v[i].x)); mx.y = fmaxf(mx.y, fabsf(v[i].y)); mx.z = fmaxf(mx.z, fabsf(v[i].z)); mx.w = fmaxf(mx.w, fabsf(v[i].w)); }
#pragma unroll
          for (int o = 8; o < 64; o <<= 1) { mx.x = fmaxf(mx.x, __shfl_xor(mx.x, o)); mx.y = fmaxf(mx.y, __shfl_xor(mx.y, o)); mx.z = fmaxf(mx.z, __shfl_xor(mx.z, o)); mx.w = fmaxf(mx.w, __shfl_xor(mx.w, o)); }
          if (lane < 8) *(LAS f32x4*)(PM + w * 32 + 4 * lane) = mx; }
        __syncthreads();
        if (it + G < NQE) p0_qload(v, p0_qitem(P, it + G), w, lane);
        { const int c = lane & 7, ng = lane >> 3; f32x4 am = {0.f, 0.f, 0.f, 0.f};
#pragma unroll
          for (int w2 = 0; w2 < 8; ++w2) { const f32x4 t = *(const LAS f32x4*)(PM + w2 * 32 + 4 * ng); am.x = fmaxf(am.x, t.x); am.y = fmaxf(am.y, t.y); am.z = fmaxf(am.z, t.z); am.w = fmaxf(am.w, t.w); }
          float sc[4], inv[4];
#pragma unroll
          for (int j = 0; j < 4; ++j) { const float a = am[j]; const int ex = (int)((__float_as_uint(a) >> 23) & 0xffu) - 127;
              sc[j] = (a > 0.f) ? __uint_as_float((unsigned)(127 + 7 - ex) << 23) : 1.0f; inv[j] = (a > 0.f) ? __uint_as_float((unsigned)(127 - 7 + ex) << 23) : 1.0f; }
          if (w == 0 && c == 0) *(f32x4*)(q.sc + q.dr0 + 4 * ng) = (f32x4){inv[0], inv[1], inv[2], inv[3]};
          f32x4 x[16];
#pragma unroll
          for (int i = 0; i < 16; ++i) x[i] = *(const LAS f32x4*)(scr + (16 * c + i) * 32 + 4 * ((ng + c) & 7));
#pragma unroll
          for (int j = 0; j < 4; ++j) { int o[4];
#pragma unroll
              for (int qq = 0; qq < 4; ++qq) { int t = 0; t = __builtin_amdgcn_cvt_pk_fp8_f32(x[4 * qq][j] * sc[j], x[4 * qq + 1][j] * sc[j], t, false); t = __builtin_amdgcn_cvt_pk_fp8_f32(x[4 * qq + 2][j] * sc[j], x[4 * qq + 3][j] * sc[j], t, true); o[qq] = t; }
              u32x4 ov; ov.x = (unsigned)o[0]; ov.y = (unsigned)o[1]; ov.z = (unsigned)o[2]; ov.w = (unsigned)o[3];
              __builtin_nontemporal_store(ov, (u32x4*)(q.W8 + (size_t)(q.dr0 + 4 * ng + j) * 1024 + 128 * w + 16 * c));   } }
        __syncthreads(); }
}
DI void p0_quant_win(const Ptrs& P, LAS unsigned char* lds, int vcu, int G, int tid) {
    const int lane = tid & 63, w = tid >> 6; LAS float* scr = (LAS float*)(lds + w * 16384); LAS float* PM = (LAS float*)(lds + PMAX_OFF);
    signed char* W8 = (signed char*)(P.ws + WS_WIN); float* SW = (float*)(P.ws + WS_SWIN);
    constexpr int NQ = 320;
#pragma unroll 1
    for (int it = vcu; it < NQ; it += G) { const int dr0 = (it < 240) ? 32 * it : ((it < 304) ? C_MA + 32 * (it - 240) : C_GF + 32 * (it - 304));
        const int ng8 = lane & 7, rsub = lane >> 3; f32x4 mx = {0.f, 0.f, 0.f, 0.f};
        if (it < 304) { const int sc0 = (it < 240) ? 32 * it : 7696 + 32 * (it - 240); f32x4 v[16];
#pragma unroll
            for (int i = 0; i < 16; ++i) v[i] = __builtin_nontemporal_load((const f32x4*)(P.w_in + (size_t)(128 * w + 8 * i + rsub) * IN_W + sc0 + 4 * ng8));
#pragma unroll
            for (int i = 0; i < 16; ++i) { const int kk = 8 * i + rsub; *(LAS f32x4*)(scr + kk * 32 + 4 * ((ng8 + (kk >> 4)) & 7)) = v[i];
                mx.x = fmaxf(mx.x, fabsf(v[i].x)); mx.y = fmaxf(mx.y, fabsf(v[i].y)); mx.z = fmaxf(mx.z, fabsf(v[i].z)); mx.w = fmaxf(mx.w, fabsf(v[i].w)); } }
        else { const int j0 = 32 * (it - 304) + 4 * ng8; f32x4 w2[16];
#pragma unroll
            for (int r = 0; r < 16; ++r) w2[r] = *(const f32x4*)(P.w_gk2 + r * 512 + j0);
#pragma unroll 2
            for (int i = 0; i < 16; ++i) { const int kk = 8 * i + rsub; const f32x4* src = (const f32x4*)(P.w_in + (size_t)(128 * w + kk) * IN_W + 7680); f32x4 a = {0.f, 0.f, 0.f, 0.f};
#pragma unroll
                for (int q = 0; q < 4; ++q) { const f32x4 t = src[q]; a = a + w2[4 * q] * t.x + w2[4 * q + 1] * t.y + w2[4 * q + 2] * t.z + w2[4 * q + 3] * t.w; }
                *(LAS f32x4*)(scr + kk * 32 + 4 * ((ng8 + (kk >> 4)) & 7)) = a;
                mx.x = fmaxf(mx.x, fabsf(a.x)); mx.y = fmaxf(mx.y, fabsf(a.y)); mx.z = fmaxf(mx.z, fabsf(a.z)); mx.w = fmaxf(mx.w, fabsf(a.w)); } }
#pragma unroll
        for (int o = 8; o < 64; o <<= 1) { mx.x = fmaxf(mx.x, __shfl_xor(mx.x, o)); mx.y = fmaxf(mx.y, __shfl_xor(mx.y, o)); mx.z = fmaxf(mx.z, __shfl_xor(mx.z, o)); mx.w = fmaxf(mx.w, __shfl_xor(mx.w, o)); }
        if (lane < 8) *(LAS f32x4*)(PM + w * 32 + 4 * lane) = mx;
        __syncthreads();
        { const int c = lane & 7, ng = lane >> 3; f32x4 am = {0.f, 0.f, 0.f, 0.f};
#pragma unroll
          for (int w2 = 0; w2 < 8; ++w2) { const f32x4 t = *(const LAS f32x4*)(PM + w2 * 32 + 4 * ng); am.x = fmaxf(am.x, t.x); am.y = fmaxf(am.y, t.y); am.z = fmaxf(am.z, t.z); am.w = fmaxf(am.w, t.w); }
          float sc[4], inv[4];
#pragma unroll
          for (int j = 0; j < 4; ++j) { sc[j] = (am[j] > 0.f) ? 127.0f / am[j] : 1.0f; inv[j] = (am[j] > 0.f) ? am[j] * (1.0f / 127.0f) : 1.0f; }
          if (w == 0 && c == 0) *(f32x4*)(SW + dr0 + 4 * ng) = (f32x4){inv[0], inv[1], inv[2], inv[3]};
          f32x4 x[16];
#pragma unroll
          for (int i = 0; i < 16; ++i) x[i] = *(const LAS f32x4*)(scr + (16 * c + i) * 32 + 4 * ((ng + c) & 7));
#pragma unroll
          for (int j = 0; j < 4; ++j) { unsigned o[4];
#pragma unroll
              for (int qq = 0; qq < 4; ++qq) { unsigned t = 0u;
#pragma unroll
                  for (int e = 0; e < 4; ++e) t |= ((unsigned)(int)rintf(x[4 * qq + e][j] * sc[j]) & 0xffu) << (8 * e);
                  o[qq] = t; }
              u32x4 ov; ov.x = o[0]; ov.y = o[1]; ov.z = o[2]; ov.w = o[3];
              *(u32x4*)(W8 + (size_t)(dr0 + 4 * ng + j) * 1024 + 128 * w + 16 * c) = ov; } }
        __syncthreads(); }
}
template <int NR> DI void rms_rows_to_i8(const float* x0, const float* w, signed char* o0, float* sx0, int lane) {
    const f32x4* xr = (const f32x4*)x0 + lane; const f32x4* wr = (const f32x4*)w + lane;
    f32x4 v[NR][4], wv[4]; float ss[NR], mx[NR];
#pragma unroll
    for (int j = 0; j < 4; ++j) wv[j] = wr[64 * j];
#pragma unroll
    for (int q = 0; q < NR; ++q)
#pragma unroll
        for (int j = 0; j < 4; ++j) v[q][j] = __builtin_nontemporal_load(xr + 256 * q + 64 * j);
#pragma unroll
    for (int q = 0; q < NR; ++q) { float s = 0.f;
#pragma unroll
        for (int j = 0; j < 4; ++j) s += (v[q][j].x * v[q][j].x + v[q][j].y * v[q][j].y) + (v[q][j].z * v[q][j].z + v[q][j].w * v[q][j].w);
        ss[q] = s; }
#pragma unroll
    for (int o = 1; o < 64; o <<= 1)
#pragma unroll
        for (int q = 0; q < NR; ++q) ss[q] += __shfl_xor(ss[q], o);
#pragma unroll
    for (int q = 0; q < NR; ++q) { const float r = 1.f / sqrtf(ss[q] * (1.f / D) + RMS_EPS); float m = 0.f;
#pragma unroll
        for (int j = 0; j < 4; ++j) { v[q][j] = v[q][j] * r * wv[j]; m = fmaxf(m, fmaxf(fmaxf(fabsf(v[q][j].x), fabsf(v[q][j].y)), fmaxf(fabsf(v[q][j].z), fabsf(v[q][j].w)))); }
        mx[q] = m; }
#pragma unroll
    for (int o = 1; o < 64; o <<= 1)
#pragma unroll
        for (int q = 0; q < NR; ++q) mx[q] = fmaxf(mx[q], __shfl_xor(mx[q], o));
#pragma unroll
    for (int q = 0; q < NR; ++q) { const float qa = (mx[q] > 0.f) ? 127.0f / mx[q] : 1.0f; if (lane == 0) sx0[q] = (mx[q] > 0.f) ? mx[q] * (1.0f / 127.0f) : 1.0f;
        unsigned* o4 = (unsigned*)o0 + 256 * q + lane;
#pragma unroll
        for (int j = 0; j < 4; ++j) o4[64 * j] = ((unsigned)(int)rintf(v[q][j].x * qa) & 0xffu) | (((unsigned)(int)rintf(v[q][j].y * qa) & 0xffu) << 8) | (((unsigned)(int)rintf(v[q][j].z * qa) & 0xffu) << 16) | (((unsigned)(int)rintf(v[q][j].w * qa) & 0xffu) << 24); }
}
DI void rms_rows2_to_bf16(const float* x0, const float* w, bf16* o0, int lane) {
    const f32x4* xr = (const f32x4*)x0 + lane; const f32x4* wr = (const f32x4*)w + lane;
    f32x4 va[4], vb[4], wv[4]; float sa = 0.f, sb = 0.f;
#pragma unroll
    for (int j = 0; j < 4; ++j) { va[j] = xr[64 * j]; vb[j] = xr[256 + 64 * j]; wv[j] = wr[64 * j]; }
#pragma unroll
    for (int j = 0; j < 4; ++j) { sa += (va[j].x * va[j].x + va[j].y * va[j].y) + (va[j].z * va[j].z + va[j].w * va[j].w); sb += (vb[j].x * vb[j].x + vb[j].y * vb[j].y) + (vb[j].z * vb[j].z + vb[j].w * vb[j].w); }
    const float ra = 1.f / sqrtf(wave_sum(sa) * (1.f / D) + RMS_EPS), rb = 1.f / sqrtf(wave_sum(sb) * (1.f / D) + RMS_EPS);
    u32x2* o8 = (u32x2*)o0 + lane;
#pragma unroll
    for (int j = 0; j < 4; ++j) { const f32x4 ww = wv[j]; u32x2 oa, ob; oa.x = pk2(va[j].x * ra * ww.x, va[j].y * ra * ww.y); oa.y = pk2(va[j].z * ra * ww.z, va[j].w * ra * ww.w);
        ob.x = pk2(vb[j].x * rb * ww.x, vb[j].y * rb * ww.y); ob.y = pk2(vb[j].z * rb * ww.z, vb[j].w * rb * ww.w); o8[64 * j] = oa; o8[256 + 64 * j] = ob; }
}
DI void p0_prologue(const Ptrs& P, LAS unsigned char* lds, int vcu, int G, int tid) {
    const int lane = tid & 63, wave = tid >> 6;
    LAS float* scr = (LAS float*)(lds + wave * 16384);
    const int gw = vcu * 8 + wave, NGW = G * 8;
    bf16* WIN_T = (bf16*)(P.ws + WS_WIN); bf16* WPA_T = (bf16*)(P.ws + WS_WPA); bf16* WPB_T = (bf16*)(P.ws + WS_WPB); bf16* WOUT_T = (bf16*)(P.ws + WS_WOUT);
    bf16* WRT = (bf16*)(P.ws + WS_WRT); unsigned char* WUP8 = P.ws + WS_WUP; unsigned char* WDN8 = P.ws + WS_WDN; bf16* XN = (bf16*)(P.ws + WS_XN);
#if BRINGUP != 1
    p0_quant_win(P, lds, vcu, G, tid);
    constexpr int I_PA = 8 * 32, I_PB = 16 * 32, I_OUT = 16 * 32, I_R = 16;
    constexpr int NITEMS = I_PA + I_PB + I_OUT + I_R;
    for (int it = gw; it < NITEMS; it += NGW) {
        int r = it;
        if (r < I_PA) { const int kb = r >> 5, nb = r & 31; p0_tile(P.wpa, 1024, 64 * kb, 32 * nb, WPA_T, 512, 32 * nb, scr, lane); continue; } r -= I_PA;
        if (r < I_PB) { const int kb = r >> 5, nb = r & 31; p0_tile(P.wpb, 1024, 64 * kb, 32 * nb, WPB_T, 1024, 32 * nb, scr, lane); continue; } r -= I_PB;
        if (r < I_OUT) { const int kb = r >> 5, nb = r & 31; p0_tile(P.wout, 1024, 64 * kb, 32 * nb, WOUT_T, 1024, 32 * nb, scr, lane); continue; } r -= I_OUT;
        p0_tile(P.wr, 32, 64 * r, 0, WRT, 1024, 0, scr, lane);
    }
    for (int m = gw * 4; m < T; m += NGW * 4) rms_rows_to_i8<4>(P.x + (size_t)m * D, P.ln1, (signed char*)(P.ws + WS_XN) + (size_t)m * D, (float*)(P.ws + WS_SX) + m, lane);
#endif
}

constexpr size_t PLANE = (size_t)T * 128;
DI bf16* proj_plane(unsigned char* ws, int cb) { return (bf16*)(ws + WS_PROJ) + (size_t)cb * PLANE; }

struct AttPre { u32x4 k0[2], v0[2], k1[2], v1[2]; u32x2 q[4]; };
DI void attn_task(unsigned char* ws, bf16* OG, float* LSE, LAS unsigned char* lds, int task, int tid0, int next_task, AttPre& pre, bool have_pre) {
    int tid = tid0; const int w = __builtin_amdgcn_readfirstlane(tid0 >> 6); int lane = tid & 63, i = lane & 15, g4 = lane >> 4;
    const int grp = task >> 8, idx = task & 255, b = idx >> 7, h = (idx >> 5) & 3, q5 = idx & 31;
    const int dsh = 2 * grp, d = 1 << dsh, rsh = 5 - dsh, r = q5 >> rsh, n0 = 4 * (q5 & ((1 << rsh) - 1)), Lsub = SEQ >> dsh;
    const unsigned char* Qp = (const unsigned char*)ws + WS_PROJ + (size_t)(12 * grp + h) * PLANE * 2 + ((size_t)b * SEQ + (size_t)r * Lsub) * 128;
#define ATT_Q8(dst, ptr) do { const u32x2 _q = *(const u32x2*)(ptr); const f32x2 _a = __builtin_amdgcn_cvt_pk_f32_fp8((int)_q.x, false), _b = __builtin_amdgcn_cvt_pk_f32_fp8((int)_q.x, true), _c = __builtin_amdgcn_cvt_pk_f32_fp8((int)_q.y, false), _d = __builtin_amdgcn_cvt_pk_f32_fp8((int)_q.y, true); \
        u32x4 _w; _w.x = pk2(_a.x, _a.y); _w.y = pk2(_b.x, _b.y); _w.z = pk2(_c.x, _c.y); _w.w = pk2(_d.x, _d.y); dst = __builtin_bit_cast(bf16x8, _w); } while (0)
#define ATT_Q8R(dst, raw) do { const u32x2 _q = (raw); const f32x2 _a = __builtin_amdgcn_cvt_pk_f32_fp8((int)_q.x, false), _b = __builtin_amdgcn_cvt_pk_f32_fp8((int)_q.x, true), _c = __builtin_amdgcn_cvt_pk_f32_fp8((int)_q.y, false), _d = __builtin_amdgcn_cvt_pk_f32_fp8((int)_q.y, true); \
        u32x4 _w; _w.x = pk2(_a.x, _a.y); _w.y = pk2(_b.x, _b.y); _w.z = pk2(_c.x, _c.y); _w.w = pk2(_d.x, _d.y); dst = __builtin_bit_cast(bf16x8, _w); } while (0)
    const unsigned char* Kp = (const unsigned char*)ws + WS_PROJ + (size_t)(12 * grp + 4 + h) * PLANE * 2 + ((size_t)b * SEQ + (size_t)r * Lsub) * 128;
    const unsigned char* Vp = (const unsigned char*)ws + WS_PROJ + (size_t)(12 * grp + 8 + h) * PLANE * 2 + ((size_t)b * SEQ + (size_t)r * Lsub) * 128;
    LAS unsigned char* KL = lds; LAS unsigned char* VL = lds + 65536;
    u32x4 pk[2], pv[2]; bf16x8 qf[4], nq[4];
#define ATT_PUT8(img, v8, id_) do { const int _row = (id_) >> 3, _c = (id_) & 7; const unsigned _w[4] = {(v8).x, (v8).y, (v8).z, (v8).w}; unsigned _o[8]; \
        _Pragma("unroll") for (int _q = 0; _q < 4; ++_q) { const f32x2 _lo = __builtin_amdgcn_cvt_pk_f32_fp8((int)_w[_q], false), _hi = __builtin_amdgcn_cvt_pk_f32_fp8((int)_w[_q], true); _o[2 * _q] = pk2(_lo.x, _lo.y); _o[2 * _q + 1] = pk2(_hi.x, _hi.y); } \
        *(LAS u32x4*)((img) + offb(_row, 2 * _c)) = (u32x4){_o[0], _o[1], _o[2], _o[3]}; *(LAS u32x4*)((img) + offb(_row, 2 * _c + 1)) = (u32x4){_o[4], _o[5], _o[6], _o[7]}; } while (0)
#pragma unroll
    for (int ii = 0; ii < 2; ++ii) { const int id = tid + 512 * ii; const int s0 = (n0 - 1) & 1, s1 = n0 & 1;
        u32x4 k0 = {0u, 0u, 0u, 0u}, v0 = {0u, 0u, 0u, 0u}, k1, v1;
        if (have_pre) { k0 = pre.k0[ii]; v0 = pre.v0[ii]; k1 = pre.k1[ii]; v1 = pre.v1[ii]; }
        else { if (n0 > 0) { k0 = *(const u32x4*)(Kp + (size_t)(n0 - 1) * 16384 + id * 16); v0 = *(const u32x4*)(Vp + (size_t)(n0 - 1) * 16384 + id * 16); }
               k1 = *(const u32x4*)(Kp + (size_t)n0 * 16384 + id * 16); v1 = *(const u32x4*)(Vp + (size_t)n0 * 16384 + id * 16); }
        ATT_PUT8(KL + s0 * 32768, k0, id); ATT_PUT8(VL + s0 * 32768, v0, id); ATT_PUT8(KL + s1 * 32768, k1, id); ATT_PUT8(VL + s1 * 32768, v1, id); }
#pragma unroll
    for (int ks = 0; ks < 4; ++ks) { u32x2 rq; if (have_pre) rq = pre.q[ks]; else rq = *(const u32x2*)(Qp + (size_t)(n0 * 128 + 16 * w + i) * 128 + 32 * ks + 8 * g4); ATT_Q8R(qf[ks], rq); }
    __syncthreads();
    const int kt0 = w;
#pragma unroll 1
    for (int u = 0; u < 4; ++u) { const int n = n0 + u;
        asm volatile("" : "+v"(tid)); lane = tid & 63; i = lane & 15; g4 = lane >> 4;
        if (u < 3) {
#pragma unroll
            for (int ii = 0; ii < 2; ++ii) { const int id = tid + 512 * ii; pk[ii] = *(const u32x4*)(Kp + (size_t)(n + 1) * 16384 + id * 16); pv[ii] = *(const u32x4*)(Vp + (size_t)(n + 1) * 16384 + id * 16); }
        } else if (next_task >= 0) {
            const int grp2 = next_task >> 8, idx2 = next_task & 255, b2 = idx2 >> 7, h2 = (idx2 >> 5) & 3, q52 = idx2 & 31, dsh2 = 2 * grp2, rsh2 = 5 - dsh2, r2 = q52 >> rsh2, n02 = 4 * (q52 & ((1 << rsh2) - 1)), Lsub2 = SEQ >> dsh2;
            const size_t ro2 = ((size_t)b2 * SEQ + (size_t)r2 * Lsub2) * 128;
            const unsigned char* Qp2 = (const unsigned char*)ws + WS_PROJ + (size_t)(12 * grp2 + h2) * PLANE * 2 + ro2;
            const unsigned char* Kp2 = (const unsigned char*)ws + WS_PROJ + (size_t)(12 * grp2 + 4 + h2) * PLANE * 2 + ro2;
            const unsigned char* Vp2 = (const unsigned char*)ws + WS_PROJ + (size_t)(12 * grp2 + 8 + h2) * PLANE * 2 + ro2;
#pragma unroll
            for (int ii = 0; ii < 2; ++ii) { const int id = tid + 512 * ii;
                pre.k0[ii] = (u32x4){0u, 0u, 0u, 0u}; pre.v0[ii] = (u32x4){0u, 0u, 0u, 0u};
                if (n02 > 0) { pre.k0[ii] = *(const u32x4*)(Kp2 + (size_t)(n02 - 1) * 16384 + id * 16); pre.v0[ii] = *(const u32x4*)(Vp2 + (size_t)(n02 - 1) * 16384 + id * 16); }
                pre.k1[ii] = *(const u32x4*)(Kp2 + (size_t)n02 * 16384 + id * 16); pre.v1[ii] = *(const u32x4*)(Vp2 + (size_t)n02 * 16384 + id * 16); }
#pragma unroll
            for (int ks = 0; ks < 4; ++ks) pre.q[ks] = *(const u32x2*)(Qp2 + (size_t)(n02 * 128 + 16 * w + i) * 128 + 32 * ks + 8 * g4);
        }
        f32x4 st[9];
#pragma unroll
        for (int tt = 0; tt < 9; ++tt) st[tt] = (f32x4){0.f, 0.f, 0.f, 0.f};
#pragma unroll
        for (int ks = 0; ks < 4; ++ks)
#pragma unroll
            for (int hb = 0; hb < 2; ++hb) { bf16x8 kf[5];
#pragma unroll
                for (int t5 = 0; t5 < 5 - hb; ++t5) { const int kt = kt0 + 5 * hb + t5; kf[t5] = *(const LAS bf16x8*)(KL + ((n - 1 + (kt >> 3)) & 1) * 32768 + offb(16 * (kt & 7) + i, 4 * ks + g4)); }
                __builtin_amdgcn_sched_barrier(0);
#pragma unroll
                for (int t5 = 0; t5 < 5 - hb; ++t5) st[5 * hb + t5] = MFMA16(kf[t5], qf[ks], st[5 * hb + t5]);
                __builtin_amdgcn_sched_barrier(0); }
        const int iq = 16 * w + i; float mx = -3.0e38f;
#pragma unroll
        for (int tt = 0; tt < 9; ++tt) {
            const bool tile_ok = (n > 0) || (w + tt >= 8);
#pragma unroll
            for (int rg = 0; rg < 4; ++rg) { const int ko = 4 * g4 + rg; const bool ok = tile_ok && (tt == 0 ? ko >= i : (tt == 8 ? ko <= i : true));
                st[tt][rg] = ok ? st[tt][rg] : -__builtin_inff(); mx = fmaxf(mx, st[tt][rg]); } }
        mx = fmaxf(mx, __shfl_xor(mx, 16)); mx = fmaxf(mx, __shfl_xor(mx, 32));
        float sum = 0.f;
#pragma unroll
        for (int tt = 0; tt < 9; ++tt)
#pragma unroll
            for (int rg = 0; rg < 4; ++rg) { const float p = __builtin_amdgcn_exp2f(st[tt][rg] - mx); st[tt][rg] = p; sum += p; }
        sum += __shfl_xor(sum, 16); sum += __shfl_xor(sum, 32);
        f32x4 o[8];
#pragma unroll
        for (int c = 0; c < 8; ++c) o[c] = (f32x4){0.f, 0.f, 0.f, 0.f};
#pragma unroll
        for (int kk = 0; kk < 4; ++kk) { u32x4 pw; pw.x = pk2(st[2 * kk][0], st[2 * kk][1]); pw.y = pk2(st[2 * kk][2], st[2 * kk][3]); pw.z = pk2(st[2 * kk + 1][0], st[2 * kk + 1][1]); pw.w = pk2(st[2 * kk + 1][2], st[2 * kk + 1][3]);
            const bf16x8 pa = __builtin_bit_cast(bf16x8, pw); const int ka = kt0 + 2 * kk, kb2 = ka + 1;
            const LAS unsigned char* va = VL + ((n - 1 + (ka >> 3)) & 1) * 32768; const LAS unsigned char* vb = VL + ((n - 1 + (kb2 >> 3)) & 1) * 32768;
            bf16x8 vf[8];
#pragma unroll
            for (int c = 0; c < 8; ++c) vf[c] = cat8(tr4(va, 16 * (ka & 7) + 4 * g4, c, lane), tr4(vb, 16 * (kb2 & 7) + 4 * g4, c, lane));
            __builtin_amdgcn_sched_barrier(0);
#pragma unroll
            for (int c = 0; c < 8; ++c) o[c] = MFMA16(pa, vf[c], o[c]);
            __builtin_amdgcn_sched_barrier(0); }
        { u32x2 pw4; pw4.x = pk2(st[8][0], st[8][1]); pw4.y = pk2(st[8][2], st[8][3]);
            const s16x4 pa4 = __builtin_bit_cast(s16x4, pw4); const int ka = kt0 + 8; const LAS unsigned char* va = VL + ((n - 1 + (ka >> 3)) & 1) * 32768;
            s16x4 vf4[8];
#pragma unroll
            for (int c = 0; c < 8; ++c) vf4[c] = tr4(va, 16 * (ka & 7) + 4 * g4, c, lane);
            __builtin_amdgcn_sched_barrier(0);
#pragma unroll
            for (int c = 0; c < 8; ++c) o[c] = __builtin_amdgcn_mfma_f32_16x16x16bf16_1k(pa4, vf4[c], o[c], 0, 0, 0);
            __builtin_amdgcn_sched_barrier(0); }
        if (u < 3) {
#pragma unroll
            for (int ks = 0; ks < 4; ++ks) ATT_Q8(nq[ks], Qp + (size_t)((n + 1) * 128 + 16 * w + i) * 128 + 32 * ks + 8 * g4); }
        const float linv = 1.0f / sum;
        const size_t mrow0 = (size_t)b * SEQ;
        if (lane < 16) { const size_t m = mrow0 + (size_t)((n * 128 + iq) * d + r); LSE[((size_t)grp * T + m) * 4 + h] = (mx + __log2f(sum)) * 0.6931471805599453f; }
        __syncthreads();
        { LAS unsigned char* ost = KL + ((n - 1) & 1) * 32768 + w * 4096;
#pragma unroll
          for (int rg = 0; rg < 4; ++rg) { const float li = __shfl(linv, 4 * g4 + rg);
#pragma unroll
              for (int c = 0; c < 8; ++c) *(LAS bf16*)(ost + (4 * g4 + rg) * 256 + (16 * c + i) * 2) = f2bf(o[c][rg] * li); }
          LDS_WAIT(); asm volatile("" ::: "memory");
#pragma unroll
          for (int k = 0; k < 2; ++k) { const int pid = lane + 64 * k, qr = pid >> 3, ch = pid & 7;
              const u32x4 va = *(const LAS u32x4*)(ost + qr * 256 + ch * 32), vb = *(const LAS u32x4*)(ost + qr * 256 + ch * 32 + 16);
              int w0 = 0, w1 = 0, w2 = 0, w3 = 0;
              w0 = __builtin_amdgcn_cvt_pk_fp8_f32(bflo(va.x), bfhi(va.x), w0, false); w0 = __builtin_amdgcn_cvt_pk_fp8_f32(bflo(va.y), bfhi(va.y), w0, true);
              w1 = __builtin_amdgcn_cvt_pk_fp8_f32(bflo(va.z), bfhi(va.z), w1, false); w1 = __builtin_amdgcn_cvt_pk_fp8_f32(bflo(va.w), bfhi(va.w), w1, true);
              w2 = __builtin_amdgcn_cvt_pk_fp8_f32(bflo(vb.x), bfhi(vb.x), w2, false); w2 = __builtin_amdgcn_cvt_pk_fp8_f32(bflo(vb.y), bfhi(vb.y), w2, true);
              w3 = __builtin_amdgcn_cvt_pk_fp8_f32(bflo(vb.z), bfhi(vb.z), w3, false); w3 = __builtin_amdgcn_cvt_pk_fp8_f32(bflo(vb.w), bfhi(vb.w), w3, true);
              u32x4 v; v.x = (unsigned)w0; v.y = (unsigned)w1; v.z = (unsigned)w2; v.w = (unsigned)w3;
              const size_t m = mrow0 + (size_t)((n * 128 + 16 * w + qr) * d + r); *(u32x4*)((unsigned char*)OG + ((size_t)grp * T + m) * 512 + h * 128 + 16 * ch) = v; } }
        if (u < 3) { __syncthreads(); const int s1 = (n + 1) & 1;
#pragma unroll
            for (int ii = 0; ii < 2; ++ii) { const int id = tid + 512 * ii; ATT_PUT8(KL + s1 * 32768, pk[ii], id); ATT_PUT8(VL + s1 * 32768, pv[ii], id); }
#pragma unroll
            for (int ks = 0; ks < 4; ++ks) qf[ks] = nq[ks];
            __syncthreads(); }
    }
    __syncthreads();
#undef ATT_PUT8
#undef ATT_Q8R
}

constexpr int GL_RK = 0, GL_RG = 16384, GL_RQ = 32768, GL_OST = 0, GL_QE = 49152, GL_KM = 65536, GL_KE = 81920, GL_V = 98304;
constexpr int GL_TOT = 131072 + 2048, GL_DEC = 131072 + 6144, GL_ATT = 131072 + 6656;
template <bool FULL> struct GlaPre { u32x4 k[2], g[2], q[FULL ? 2 : 1], v[4]; };
template <bool FULL> DI void gla_fetch_kgq(GlaPre<FULL>& R, const bf16* Kp, const bf16* Gp, const bf16* Qp, size_t mbase, int tid) {
#pragma unroll
    for (int ii = 0; ii < 2; ++ii) { const size_t o = mbase * 128 + (size_t)(tid + 512 * ii) * 8;
        if (FULL) { R.k[ii] = __builtin_nontemporal_load((const u32x4*)(Kp + o)); R.g[ii] = __builtin_nontemporal_load((const u32x4*)(Gp + o)); R.q[ii] = __builtin_nontemporal_load((const u32x4*)(Qp + o)); }
        else { R.k[ii] = *(const u32x4*)(Kp + o); R.g[ii] = *(const u32x4*)(Gp + o); } }
}
template <bool FULL> DI void gla_fetch_v(GlaPre<FULL>& R, const bf16* Vp, size_t mbase, int tid) {
#pragma unroll
    for (int ii = 0; ii < 4; ++ii) R.v[ii] = FULL ? __builtin_nontemporal_load((const u32x4*)(Vp + mbase * 256 + (size_t)(tid + 512 * ii) * 8)) : *(const u32x4*)(Vp + mbase * 256 + (size_t)(tid + 512 * ii) * 8);
}
template <bool FULL> DI void gla_fetch(GlaPre<FULL>& R, const bf16* Kp, const bf16* Gp, const bf16* Qp, const bf16* Vp, size_t mbase, int tid) { gla_fetch_kgq<FULL>(R, Kp, Gp, Qp, mbase, tid); gla_fetch_v<FULL>(R, Vp, mbase, tid); }
template <bool FULL> DI void gla_put(const GlaPre<FULL>& R, LAS unsigned char* lds, int tid) {
#pragma unroll
    for (int ii = 0; ii < 2; ++ii) { const int o = (tid + 512 * ii) * 16; *(LAS u32x4*)(lds + GL_RK + o) = R.k[ii]; *(LAS u32x4*)(lds + GL_RG + o) = R.g[ii]; if (FULL) *(LAS u32x4*)(lds + GL_RQ + o) = R.q[ii]; }
#pragma unroll
    for (int ii = 0; ii < 4; ++ii) { const int id = tid + 512 * ii, row = id >> 5, c32 = id & 31; *(LAS u32x4*)(lds + GL_V + (c32 >> 4) * 16384 + offb(row, c32 & 15)) = R.v[ii]; }
}
template <bool FULL> DI f32x2 gla_prep(LAS unsigned char* lds, int tid) {
    const int jp = tid & 63, tg = tid >> 6;
    f32x2 c[8], kv[8], qv[8]; f32x2 run = {0.f, 0.f};
#pragma unroll
    for (int ii = 0; ii < 8; ++ii) { const int o = (8 * tg + ii) * 256 + jp * 4; const unsigned gw = *(const LAS unsigned*)(lds + GL_RG + o), kw = *(const LAS unsigned*)(lds + GL_RK + o);
        run.x += bflo(gw); run.y += bfhi(gw); c[ii] = run; kv[ii] = (f32x2){bflo(kw), bfhi(kw)};
        if (FULL) { const unsigned qw = *(const LAS unsigned*)(lds + GL_RQ + o); qv[ii] = (f32x2){bflo(qw), bfhi(qw)}; } }
    LAS f32x2* TOT = (LAS f32x2*)(lds + GL_TOT);
    TOT[tg * 64 + jp] = run;
    __syncthreads();
    f32x2 off = {0.f, 0.f}, blast = {0.f, 0.f};
#pragma unroll
    for (int t2 = 0; t2 < 8; ++t2) { const f32x2 v = TOT[t2 * 64 + jp]; blast = blast + v; if (t2 < tg) off = off + v; }
    const f32x2 eb = {__expf(blast.x), __expf(blast.y)};
#pragma unroll
    for (int ii = 0; ii < 8; ++ii) { const int s = 8 * tg + ii; const f32x2 bb = off + c[ii]; const f32x2 e = {__expf(bb.x), __expf(bb.y)}; const f32x2 km = {kv[ii].x * __builtin_amdgcn_rcpf(e.x), kv[ii].y * __builtin_amdgcn_rcpf(e.y)};
        const unsigned o = offb(s, jp >> 2) + (jp & 3) * 4; const f32x2 ke = km * eb;
        *(LAS unsigned*)(lds + GL_KE + o) = pk2(ke.x, ke.y);
        if (FULL) { const f32x2 qe = qv[ii] * e; *(LAS unsigned*)(lds + GL_QE + o) = pk2(qe.x, qe.y); *(LAS unsigned*)(lds + GL_KM + o) = pk2(km.x, km.y); } }
    if (tg == 0) ((LAS f32x2*)(lds + GL_DEC))[jp] = eb;
    __syncthreads();
    return blast;
}
DI void gla_state_update(f32x4 (&S)[8][2], const LAS unsigned char* lds, int w, int lane) {
    const int g4 = lane >> 4; const LAS unsigned char* Vimg = lds + GL_V + (w >> 2) * 16384; const int cv = 2 * (w & 3);
#pragma unroll
    for (int mt = 0; mt < 8; ++mt) { const f32x4 dc = *(const LAS f32x4*)(lds + GL_DEC + (16 * mt + 4 * g4) * 4); S[mt][0] = S[mt][0] * dc; S[mt][1] = S[mt][1] * dc; }
#pragma unroll
    for (int ks = 0; ks < 2; ++ks) { bf16x8 bfr[2];
#pragma unroll
        for (int nt = 0; nt < 2; ++nt) bfr[nt] = cat8(tr4(Vimg, 32 * ks + 8 * g4, cv + nt, lane), tr4(Vimg, 32 * ks + 8 * g4 + 4, cv + nt, lane));
#pragma unroll
        for (int mt = 0; mt < 8; ++mt) { const bf16x8 a = cat8(tr4(lds + GL_KE, 32 * ks + 8 * g4, mt, lane), tr4(lds + GL_KE, 32 * ks + 8 * g4 + 4, mt, lane));
            S[mt][0] = MFMA16(a, bfr[0], S[mt][0]); S[mt][1] = MFMA16(a, bfr[1], S[mt][1]); } }
}
DI void gla_pass1(const Ptrs& P, LAS unsigned char* lds, int unit, int tid0) {
    const int lane0 = tid0 & 63, w = __builtin_amdgcn_readfirstlane(tid0 >> 6); const int bh = unit >> 5, sc = unit & 31, b = bh >> 2, h = bh & 3;
    const bf16* Kp = proj_plane(P.ws, 40 + h); const bf16* Gp = proj_plane(P.ws, 60 + h); const bf16* Vp = proj_plane(P.ws, 44) + (size_t)h * T * 256;
    f32x4 S[8][2];
#pragma unroll
    for (int mt = 0; mt < 8; ++mt) { S[mt][0] = (f32x4){0.f, 0.f, 0.f, 0.f}; S[mt][1] = (f32x4){0.f, 0.f, 0.f, 0.f}; }
    f32x2 logd = {0.f, 0.f}; const size_t m0 = (size_t)b * SEQ + (size_t)(8 * sc) * 64;
    GlaPre<false> R; gla_fetch<false>(R, Kp, Gp, nullptr, Vp, m0, tid0); gla_put<false>(R, lds, tid0);
    __syncthreads();
#pragma unroll 1
    for (int ci = 0; ci < 8; ++ci) {
        int tid = tid0; asm volatile("" : "+v"(tid));
        if (ci < 7) gla_fetch<false>(R, Kp, Gp, nullptr, Vp, m0 + (size_t)(ci + 1) * 64, tid);
        logd = logd + gla_prep<false>(lds, tid);
        const int lane = tid & 63;
        gla_state_update(S, lds, w, lane);
        __syncthreads();
        if (ci < 7) { gla_put<false>(R, lds, tid); __syncthreads(); } }
    float* GS = (float*)(P.ws + WS_GSTATE) + (size_t)unit * 32768;
#pragma unroll
    for (int mt = 0; mt < 8; ++mt)
#pragma unroll
        for (int nt = 0; nt < 2; ++nt)
#pragma unroll
            for (int rg = 0; rg < 4; ++rg) GS[((w * 16 + mt * 2 + nt) * 4 + rg) * 64 + lane0] = S[mt][nt][rg];
    if (tid0 < 64) ((f32x2*)(P.ws + WS_GDEC))[unit * 64 + tid0] = (f32x2){__expf(logd.x), __expf(logd.y)};
}
DI void gla_scan(const Ptrs& P, int vcu, int G, int tid) {
    float* GS = (float*)(P.ws + WS_GSTATE); const float* GD = (const float*)(P.ws + WS_GDEC);
    for (int cid = vcu * 512 + tid; cid < 8 * 32768; cid += G * 512) { const int bh = cid >> 15, e = cid & 32767, ln = e & 63, rg = (e >> 6) & 3, mt = ((e >> 8) & 15) >> 1, dk = 16 * mt + 4 * (ln >> 4) + rg;
        float ev[32], dv[32];
#pragma unroll
        for (int sc = 0; sc < 32; ++sc) { ev[sc] = GS[((size_t)(bh * 32 + sc) << 15) + e]; dv[sc] = GD[(bh * 32 + sc) * 128 + dk]; }
        float carry = 0.f;
#pragma unroll
        for (int sc = 0; sc < 32; ++sc) { GS[((size_t)(bh * 32 + sc) << 15) + e] = carry; carry = dv[sc] * carry + ev[sc]; } }
}
DI void gla_pass2(const Ptrs& P, LAS unsigned char* lds, int unit, int tid0) {
    const int lane0 = tid0 & 63, w = __builtin_amdgcn_readfirstlane(tid0 >> 6); const int bh = unit >> 5, sc = unit & 31, b = bh >> 2, h = bh & 3;
    const bf16* Qp = proj_plane(P.ws, 36 + h); const bf16* Kp = proj_plane(P.ws, 40 + h); const bf16* Gp = proj_plane(P.ws, 60 + h);
    const bf16* Vp = proj_plane(P.ws, 44) + (size_t)h * T * 256; const bf16* Op = proj_plane(P.ws, 52) + (size_t)h * T * 256; bf16* OB = (bf16*)(P.ws + WS_OB);
    f32x4 S[8][2];
    { const float* GS = (const float*)(P.ws + WS_GSTATE) + (size_t)unit * 32768;
#pragma unroll
      for (int mt = 0; mt < 8; ++mt)
#pragma unroll
          for (int nt = 0; nt < 2; ++nt)
#pragma unroll
              for (int rg = 0; rg < 4; ++rg) S[mt][nt][rg] = GS[((w * 16 + mt * 2 + nt) * 4 + rg) * 64 + lane0]; }
    const size_t m0 = (size_t)b * SEQ + (size_t)(8 * sc) * 64;
    GlaPre<true> R; gla_fetch<true>(R, Kp, Gp, Qp, Vp, m0, tid0); gla_put<true>(R, lds, tid0);
    __syncthreads();
#pragma unroll 1
    for (int ci = 0; ci < 8; ++ci) { const size_t mbase = m0 + (size_t)ci * 64;
        int tid = tid0; asm volatile("" : "+v"(tid));
        const int erow = tid >> 3, ep = tid & 7;
        if (ci < 7) gla_fetch_kgq<true>(R, Kp, Gp, Qp, mbase + 64, tid);
        (void)gla_prep<true>(lds, tid);
        if (ci < 7) gla_fetch_v<true>(R, Vp, mbase + 64, tid);
        u32x4 gog[4];
#pragma unroll
        for (int k = 0; k < 4; ++k) gog[k] = __builtin_nontemporal_load((const u32x4*)(Op + (mbase + erow) * 256 + 8 * (ep + 8 * k)));
        const int lane = tid & 63, i = lane & 15, g4 = lane >> 4;
        const LAS unsigned char* Vimg = lds + GL_V + (w >> 2) * 16384; const int cv = 2 * (w & 3);
        { const int mi = w >> 1;
#pragma unroll
          for (int nn = 0; nn < 2; ++nn) { const int nj = 2 * (w & 1) + nn; f32x4 a = {0.f, 0.f, 0.f, 0.f};
#pragma unroll
              for (int ks = 0; ks < 4; ++ks) { const bf16x8 af = *(const LAS bf16x8*)(lds + GL_QE + offb(16 * mi + i, 4 * ks + g4)), bfr = *(const LAS bf16x8*)(lds + GL_KM + offb(16 * nj + i, 4 * ks + g4)); a = MFMA16(af, bfr, a); }
#pragma unroll
              for (int rg = 0; rg < 4; ++rg) { const int sq = 16 * mi + 4 * g4 + rg, sk = 16 * nj + i; *(LAS bf16*)(lds + GL_ATT + sq * 144 + sk * 2) = f2bf(sk <= sq ? a[rg] : 0.f); } } }
        __syncthreads();
        f32x4 o[4][2];
#pragma unroll
        for (int mt = 0; mt < 4; ++mt) { o[mt][0] = (f32x4){0.f, 0.f, 0.f, 0.f}; o[mt][1] = (f32x4){0.f, 0.f, 0.f, 0.f}; }
#pragma unroll
        for (int ks = 0; ks < 2; ++ks) { bf16x8 bfr[2];
#pragma unroll
            for (int nt = 0; nt < 2; ++nt) bfr[nt] = cat8(tr4(Vimg, 32 * ks + 8 * g4, cv + nt, lane), tr4(Vimg, 32 * ks + 8 * g4 + 4, cv + nt, lane));
#pragma unroll
            for (int mt = 0; mt < 4; ++mt) { const bf16x8 a = *(const LAS bf16x8*)(lds + GL_ATT + (16 * mt + i) * 144 + 64 * ks + 16 * g4); o[mt][0] = MFMA16(a, bfr[0], o[mt][0]); o[mt][1] = MFMA16(a, bfr[1], o[mt][1]); } }
#pragma unroll
        for (int ks = 0; ks < 4; ++ks) { bf16x8 sb[2];
#pragma unroll
            for (int nt = 0; nt < 2; ++nt) { u32x4 pw; pw.x = pk2(S[2 * ks][nt][0], S[2 * ks][nt][1]); pw.y = pk2(S[2 * ks][nt][2], S[2 * ks][nt][3]); pw.z = pk2(S[2 * ks + 1][nt][0], S[2 * ks + 1][nt][1]); pw.w = pk2(S[2 * ks + 1][nt][2], S[2 * ks + 1][nt][3]); sb[nt] = __builtin_bit_cast(bf16x8, pw); }
#pragma unroll
            for (int mt = 0; mt < 4; ++mt) { const u32x2 lo = *(const LAS u32x2*)(lds + GL_QE + offb(16 * mt + i, 4 * ks + (g4 >> 1)) + (g4 & 1) * 8), hi = *(const LAS u32x2*)(lds + GL_QE + offb(16 * mt + i, 4 * ks + 2 + (g4 >> 1)) + (g4 & 1) * 8);
                u32x4 aw; aw.x = lo.x; aw.y = lo.y; aw.z = hi.x; aw.w = hi.y; const bf16x8 a = __builtin_bit_cast(bf16x8, aw);
                o[mt][0] = MFMA16(a, sb[0], o[mt][0]); o[mt][1] = MFMA16(a, sb[1], o[mt][1]); } }
#pragma unroll
        for (int mt = 0; mt < 4; ++mt)
#pragma unroll
            for (int rg = 0; rg < 4; ++rg) { const int sq = 16 * mt + 4 * g4 + rg; LAS bf16* op = (LAS bf16*)(lds + GL_OST + sq * 512 + (32 * w + i) * 2); op[0] = f2bf(o[mt][0][rg]); op[16] = f2bf(o[mt][1][rg]); }
        gla_state_update(S, lds, w, lane);
        __syncthreads();
        { u32x4 ov[4]; float ss = 0.f;
#pragma unroll
          for (int k = 0; k < 4; ++k) { ov[k] = *(const LAS u32x4*)(lds + GL_OST + erow * 512 + 16 * (ep + 8 * k));
              const float a0 = bflo(ov[k].x), a1 = bfhi(ov[k].x), a2 = bflo(ov[k].y), a3 = bfhi(ov[k].y), a4 = bflo(ov[k].z), a5 = bfhi(ov[k].z), a6 = bflo(ov[k].w), a7 = bfhi(ov[k].w);
              ss += (a0 * a0 + a1 * a1) + (a2 * a2 + a3 * a3) + (a4 * a4 + a5 * a5) + (a6 * a6 + a7 * a7); }
          ss += __shfl_xor(ss, 1); ss += __shfl_xor(ss, 2); ss += __shfl_xor(ss, 4);
          const float rstd = 1.0f / sqrtf(ss * (1.0f / 256.0f) + RMS_EPS);
#pragma unroll
          for (int k = 0; k < 4; ++k) { const int col = 8 * (ep + 8 * k); const f32x4 n0v = *(const f32x4*)(P.gnorm + col), n1v = *(const f32x4*)(P.gnorm + col + 4);
              const unsigned ow[4] = {ov[k].x, ov[k].y, ov[k].z, ov[k].w}, gw[4] = {gog[k].x, gog[k].y, gog[k].z, gog[k].w}; const float nw[8] = {n0v.x, n0v.y, n0v.z, n0v.w, n1v.x, n1v.y, n1v.z, n1v.w}; unsigned rw[4];
#pragma unroll
              for (int q = 0; q < 4; ++q) { const float ga = bflo(gw[q]), gb = bfhi(gw[q]); rw[q] = pk2(bflo(ow[q]) * rstd * nw[2 * q] * ga * sigmoidf_fast(ga), bfhi(ow[q]) * rstd * nw[2 * q + 1] * gb * sigmoidf_fast(gb)); }
              u32x4 res; res.x = rw[0]; res.y = rw[1]; res.z = rw[2]; res.w = rw[3];
              *(u32x4*)(OB + (mbase + erow) * D + h * 256 + col) = res; } }
        __syncthreads();
        if (ci < 7) { gla_put<true>(R, lds, tid); __syncthreads(); } }
}

DI void attn_merge(const Ptrs& P, int vcu, int G, int tid) {
    const int lane = tid & 63, wave = tid >> 6, gw = vcu * 8 + wave, NGW = G * 8, h = lane >> 4;
    const unsigned char* OG8 = (const unsigned char*)P.out + OUT_OG; const float* LSE = (const float*)((const unsigned char*)P.out + OUT_LSE); bf16* OA = (bf16*)(P.ws + WS_OA);
    for (int m0 = gw * 4; m0 < T; m0 += NGW * 4) {
        float l[4][3]; u32x2 v[4][3];
#pragma unroll
        for (int q = 0; q < 4; ++q)
#pragma unroll
            for (int g = 0; g < 3; ++g) { l[q][g] = LSE[((size_t)g * T + m0 + q) * 4 + h]; v[q][g] = *(const u32x2*)(OG8 + ((size_t)g * T + m0 + q) * 512 + 8 * lane); }
        __builtin_amdgcn_sched_barrier(0);
#pragma unroll
        for (int q = 0; q < 4; ++q) { const float mx = fmaxf(l[q][0], fmaxf(l[q][1], l[q][2])); float w0 = __expf(l[q][0] - mx), w1 = __expf(l[q][1] - mx), w2 = __expf(l[q][2] - mx); const float inv = 1.0f / (w0 + w1 + w2); w0 *= inv; w1 *= inv; w2 *= inv;
            const u32x2 a = v[q][0], bq = v[q][1], c = v[q][2];
            const f32x2 a0 = __builtin_amdgcn_cvt_pk_f32_fp8((int)a.x, false), a1 = __builtin_amdgcn_cvt_pk_f32_fp8((int)a.x, true), a2 = __builtin_amdgcn_cvt_pk_f32_fp8((int)a.y, false), a3 = __builtin_amdgcn_cvt_pk_f32_fp8((int)a.y, true);
            const f32x2 b0 = __builtin_amdgcn_cvt_pk_f32_fp8((int)bq.x, false), b1 = __builtin_amdgcn_cvt_pk_f32_fp8((int)bq.x, true), b2 = __builtin_amdgcn_cvt_pk_f32_fp8((int)bq.y, false), b3 = __builtin_amdgcn_cvt_pk_f32_fp8((int)bq.y, true);
            const f32x2 c0 = __builtin_amdgcn_cvt_pk_f32_fp8((int)c.x, false), c1 = __builtin_amdgcn_cvt_pk_f32_fp8((int)c.x, true), c2 = __builtin_amdgcn_cvt_pk_f32_fp8((int)c.y, false), c3 = __builtin_amdgcn_cvt_pk_f32_fp8((int)c.y, true);
            u32x4 o;
            o.x = pk2(w0 * a0.x + w1 * b0.x + w2 * c0.x, w0 * a0.y + w1 * b0.y + w2 * c0.y);
            o.y = pk2(w0 * a1.x + w1 * b1.x + w2 * c1.x, w0 * a1.y + w1 * b1.y + w2 * c1.y);
            o.z = pk2(w0 * a2.x + w1 * b2.x + w2 * c2.x, w0 * a2.y + w1 * b2.y + w2 * c2.y);
            o.w = pk2(w0 * a3.x + w1 * b3.x + w2 * c3.x, w0 * a3.y + w1 * b3.y + w2 * c3.y);
            *(u32x4*)(OA + (size_t)(m0 + q) * 512 + 8 * lane) = o; } }
}

DI void router_phase(const Ptrs& P, LAS unsigned char* lds, int G, int tid0) {
    int tid = tid0;
    const bf16* H1 = (const bf16*)(P.ws + WS_H1); unsigned char* HN8 = P.ws + WS_HN; const bf16* WRT = (const bf16*)(P.ws + WS_WRT);
    { int* RT = (int*)(P.ws + WS_ROWTOK); for (int idx = blockIdx.x * 512 + tid; idx < MAXTILES * 256; idx += G * 512) RT[idx] = 0; }
    int* ASG_E = (int*)(P.ws + WS_ASG_E); int* ASG_SLOT = (int*)(P.ws + WS_ASG_SLOT); float* ASG_G = (float*)(P.ws + WS_ASG_G);
    LAS float* LG = (LAS float*)lds; LAS int* lcnt = (LAS int*)(lds + 17408); LAS int* lbase = (LAS int*)(lds + 17536);
    unsigned* gcnt = (unsigned*)(P.ctl + CW_CNT);
    constexpr int RW_OFF = 32768, RW_PITCH = 2064, RL_OFF = RW_OFF + 32 * RW_PITCH;
    {
#pragma unroll
      for (int j = 0; j < 8; ++j) { const int p = tid0 + 512 * j, row = p >> 7, c16 = p & 127; *(LAS u32x4*)(lds + RW_OFF + row * RW_PITCH + c16 * 16) = *(const u32x4*)(WRT + (size_t)row * D + c16 * 8); }
      if (tid0 < 256) *(LAS f32x4*)(lds + RL_OFF + tid0 * 16) = *(const f32x4*)(P.ln2 + tid0 * 4); }
    for (int tb = ((G % 8 == 0) ? (int)(blockIdx.x % 8) * (G / 8) + (int)(blockIdx.x / 8) : (int)blockIdx.x); tb < T / 128; tb += G) {
        asm volatile("" : "+v"(tid));
        const int lane = tid & 63, w = tid >> 6, i = lane & 15, g4 = lane >> 4;
        if (tid < 32) lcnt[tid] = 0;
        __syncthreads();
        const int t = tb * 128 + 16 * w + i; const bf16* hrow = H1 + (size_t)t * D + 16 * g4;
        u32x4 hv[32]; float psv[16];
#pragma unroll
        for (int q = 0; q < 16; ++q) { hv[2 * q] = *(const u32x4*)(hrow + 64 * q); hv[2 * q + 1] = *(const u32x4*)(hrow + 64 * q + 8); }
        { const float* ps = (const float*)(P.ws + WS_PS) + t;
#pragma unroll
          for (int j = 0; j < 16; ++j) psv[j] = ps[(size_t)j * T]; }
        __builtin_amdgcn_sched_barrier(0);
        float ss = 0.f;
#pragma unroll
        for (int j = 0; j < 16; ++j) ss += psv[j];
        const float rstd = 1.0f / sqrtf(ss * (1.0f / D) + RMS_EPS);
        f32x4 a0 = {0.f, 0.f, 0.f, 0.f}, a1 = {0.f, 0.f, 0.f, 0.f};
#pragma unroll
        for (int q = 0; q < 16; ++q) { u32x4 st8;
#pragma unroll
            for (int hf = 0; hf < 2; ++hf) { const int col = 64 * q + 16 * g4 + 8 * hf; const u32x4 h = hv[2 * q + hf];
                const f32x4 u0 = *(const LAS f32x4*)(lds + RL_OFF + col * 4) * rstd, u1 = *(const LAS f32x4*)(lds + RL_OFF + col * 4 + 16) * rstd;
                const bf16x8 b0 = *(const LAS bf16x8*)(lds + RW_OFF + i * RW_PITCH + col * 2), b1 = *(const LAS bf16x8*)(lds + RW_OFF + (16 + i) * RW_PITCH + col * 2);
                const float y0 = bflo(h.x) * u0.x, y1 = bfhi(h.x) * u0.y, y2 = bflo(h.y) * u0.z, y3 = bfhi(h.y) * u0.w, y4 = bflo(h.z) * u1.x, y5 = bfhi(h.z) * u1.y, y6 = bflo(h.w) * u1.z, y7 = bfhi(h.w) * u1.w;
                int q0 = 0, q1 = 0; q0 = __builtin_amdgcn_cvt_pk_fp8_f32(y0, y1, q0, false); q0 = __builtin_amdgcn_cvt_pk_fp8_f32(y2, y3, q0, true); q1 = __builtin_amdgcn_cvt_pk_fp8_f32(y4, y5, q1, false); q1 = __builtin_amdgcn_cvt_pk_fp8_f32(y6, y7, q1, true);
                if (hf == 0) { st8.x = (unsigned)q0; st8.y = (unsigned)q1; } else { st8.z = (unsigned)q0; st8.w = (unsigned)q1; }
                u32x4 y; y.x = pk2(y0, y1); y.y = pk2(y2, y3); y.z = pk2(y4, y5); y.w = pk2(y6, y7);
                const bf16x8 af = __builtin_bit_cast(bf16x8, y); a0 = MFMA16(af, b0, a0); a1 = MFMA16(af, b1, a1); }
            *(u32x4*)(HN8 + (size_t)t * D + 64 * q + 16 * g4) = st8; }
        const float br0 = P.br[i], br1 = P.br[16 + i];
#pragma unroll
        for (int rg = 0; rg < 4; ++rg) { LG[(w * 16 + 4 * g4 + rg) * 33 + i] = a0[rg] + br0; LG[(w * 16 + 4 * g4 + rg) * 33 + 16 + i] = a1[rg] + br1; }
        LDS_WAIT(); asm volatile("" ::: "memory");
        int es[4] = {0, 0, 0, 0}, ls[4] = {0, 0, 0, 0}; float gs[4] = {0.f, 0.f, 0.f, 0.f};
        if (lane < 16) { float lg[32];
#pragma unroll
            for (int e = 0; e < 32; ++e) lg[e] = LG[(w * 16 + lane) * 33 + e];
            unsigned taken = 0u; float tv[4];
#pragma unroll
            for (int k = 0; k < 4; ++k) { float best = -3.0e38f; int bi = 0;
#pragma unroll
                for (int e = 0; e < 32; ++e) { const bool ok = !((taken >> e) & 1u) && lg[e] > best; best = ok ? lg[e] : best; bi = ok ? e : bi; }
                taken |= 1u << bi; es[k] = bi; tv[k] = best; }
            const float e1 = __expf(tv[1] - tv[0]), e2 = __expf(tv[2] - tv[0]), e3 = __expf(tv[3] - tv[0]), inv = 1.0f / (1.0f + e1 + e2 + e3);
            gs[0] = inv; gs[1] = e1 * inv; gs[2] = e2 * inv; gs[3] = e3 * inv;
#pragma unroll
            for (int k = 0; k < 4; ++k) ls[k] = __hip_atomic_fetch_add(lcnt + es[k], 1, __ATOMIC_RELAXED, __HIP_MEMORY_SCOPE_WORKGROUP); }
        if (lane < 16) { const int tt = tb * 128 + 16 * w + lane;
#pragma unroll
            for (int k = 0; k < 4; ++k) { ASG_E[4 * tt + k] = es[k]; ASG_SLOT[4 * tt + k] = ls[k]; ASG_G[4 * tt + k] = gs[k]; } }
        __syncthreads();
        if (tid < 32) gcnt[tb * 32 + tid] = (unsigned)lcnt[tid];
        __syncthreads();
    }
}
DI void moe_colsum(const unsigned* cnt, int nrows, LAS int* red, int tid, int& out) {
    const int e = tid & 31, part = tid >> 5; unsigned c = 0;
#pragma unroll 4
    for (int r = part; r < nrows; r += 16) c += cnt[r * 32 + e];
    red[tid] = (int)c;
    __syncthreads();
    if (tid < 32) { int t = 0;
#pragma unroll
        for (int p = 0; p < 16; ++p) t += red[p * 32 + tid];
        out = t; }
}
static_assert(T / 128 == 256, "moe_colsum_all / moe_scatter read the count matrix as 16 x 16 rows per column");
DI void moe_colsum_all(const unsigned* cnt, LAS int* red, int tid, int& out) {
    const int e = tid & 31, part = tid >> 5; unsigned v[16];
#pragma unroll
    for (int j = 0; j < 16; ++j) v[j] = cnt[(part + 16 * j) * 32 + e];
    unsigned c = 0;
#pragma unroll
    for (int j = 0; j < 16; ++j) c += v[j];
    red[tid] = (int)c;
    __syncthreads();
    if (tid < 32) { int t = 0;
#pragma unroll
        for (int p = 0; p < 16; ++p) t += red[p * 32 + tid];
        out = t; }
}
DI void moe_tables(const Ptrs& P, LAS int* ts, int tid) {
    int c = 0; moe_colsum_all((const unsigned*)(P.ctl + CW_CNT), ts + 128, tid, c);
    if (tid < 64) { int tiles = (tid < 32) ? ((c + 255) >> 8) : 0, inc = tiles;
#pragma unroll
        for (int o = 1; o < 32; o <<= 1) { const int v = __shfl_up(inc, o); if ((tid & 63) >= o) inc += v; }
        if (tid < 32) { ts[tid] = inc - tiles; ts[40 + tid] = c; } if (tid == 31) ts[32] = inc; }
    __syncthreads();
}
DI void moe_scatter(const Ptrs& P, LAS unsigned char* lds, int vcu, int G, int tid) {
    LAS int* ts = (LAS int*)(lds + TBL_OFF); LAS int* bs = ts + 80; LAS int* red1 = ts + 128; LAS int* red2 = ts + 640;
    const int* ASG_E = (const int*)(P.ws + WS_ASG_E); const int* ASG_SLOT = (const int*)(P.ws + WS_ASG_SLOT); int* ASG_ROW = (int*)(P.ws + WS_ASG_ROW); int* RT = (int*)(P.ws + WS_ROWTOK);
    const unsigned* cnt = (const unsigned*)(P.ctl + CW_CNT);
    for (int tb = ((G % 8 == 0) ? (int)(blockIdx.x % 8) * (G / 8) + (int)(blockIdx.x / 8) : (int)blockIdx.x); tb < T / 128; tb += G) {
        const int a = tb * 512 + tid, e = ASG_E[a], sl = ASG_SLOT[a];
        const int ce = tid & 31, part = tid >> 5; unsigned v[16];
#pragma unroll
        for (int j = 0; j < 16; ++j) v[j] = cnt[(part + 16 * j) * 32 + ce];
        unsigned call = 0, cpre = 0;
#pragma unroll
        for (int j = 0; j < 16; ++j) { call += v[j]; cpre += (part + 16 * j < tb) ? v[j] : 0u; }
        red1[tid] = (int)call; red2[tid] = (int)cpre;
        __syncthreads();
        if (tid < 64) { int c = 0, b = 0;
            if (tid < 32) {
#pragma unroll
                for (int p = 0; p < 16; ++p) { c += red1[p * 32 + tid]; b += red2[p * 32 + tid]; } }
            int tiles = (tid < 32) ? ((c + 255) >> 8) : 0, inc = tiles;
#pragma unroll
            for (int o = 1; o < 32; o <<= 1) { const int u = __shfl_up(inc, o); if ((tid & 63) >= o) inc += u; }
            if (tid < 32) { ts[tid] = inc - tiles; ts[40 + tid] = c; bs[tid] = b; } if (tid == 31) ts[32] = inc; }
        __syncthreads();
        { const int row = ts[e] * 256 + bs[e] + sl; ASG_ROW[a] = row; RT[row] = a >> 2; }
        __syncthreads(); }
}
constexpr int LT_OFF = 131072 + 2048;
template <class Sched> DI void moe_unit_tokens(const Ptrs& P, const Sched& S, LAS unsigned short* lt, int tid) {
    const int* RT = (const int*)(P.ws + WS_ROWTOK); int pmv[17];
#pragma unroll
    for (int i = 0; i < 17; ++i) { pg8::Unit u; pmv[i] = S.next(i, u) ? u.pm : -1; }
    if (tid < 256) { int tk[17];
#pragma unroll
        for (int i = 0; i < 17; ++i) tk[i] = (pmv[i] >= 0) ? RT[pmv[i] * 256 + tid] : 0;
#pragma unroll
        for (int i = 0; i < 17; ++i) if (pmv[i] >= 0) lt[i * 256 + tid] = (unsigned short)tk[i]; }
    __syncthreads();
}
DI void final_phase(const Ptrs& P, int vcu, int G, int tid) {
    const int lane = tid & 63, wave = tid >> 6, gw = vcu * 8 + wave, NGW = G * 8;
    const int* ASG_ROW = (const int*)(P.ws + WS_ASG_ROW); const float* ASG_G = (const float*)(P.ws + WS_ASG_G); const unsigned char* YB8 = P.ws + WS_YB;
#if BRINGUP == 1
    for (int t = gw; t < T; t += NGW) { const f32x4* hr = (const f32x4*)(P.x + (size_t)t * D) + lane; f32x4 v[4]; float s = 0.f;
#pragma unroll
        for (int j = 0; j < 4; ++j) { v[j] = hr[64 * j]; s += (v[j].x * v[j].x + v[j].y * v[j].y) + (v[j].z * v[j].z + v[j].w * v[j].w); }
        const float rstd = 1.f / sqrtf(wave_sum(s) * (1.f / D) + RMS_EPS); f32x4* orow = (f32x4*)(P.out + (size_t)t * D) + lane; const f32x4* wr = (const f32x4*)P.lnf + lane;
#pragma unroll
        for (int j = 0; j < 4; ++j) orow[64 * j] = v[j] * rstd * wr[64 * j]; }
#else
    const bf16* H1 = (const bf16*)(P.ws + WS_H1);
    f32x4 lw[4];
#pragma unroll
    for (int j = 0; j < 4; ++j) lw[j] = ((const f32x4*)P.lnf + lane)[64 * j];
    typedef int i32x4 __attribute__((ext_vector_type(4)));
    constexpr int TPI = 4;
    int t0 = gw * TPI;
    i32x4 rws[TPI]; f32x4 gts[TPI];
    if (t0 < T) {
#pragma unroll
        for (int q = 0; q < TPI; ++q) { rws[q] = *(const i32x4*)(ASG_ROW + 4 * (t0 + q)); gts[q] = *(const f32x4*)(ASG_G + 4 * (t0 + q)); } }
    for (; t0 < T; t0 += NGW * TPI) {
        u32x2 hq[TPI][4]; unsigned yq[TPI][4][4];
#pragma unroll
        for (int q = 0; q < TPI; ++q) { const u32x2* hr = (const u32x2*)(H1 + (size_t)(t0 + q) * D) + lane;
#pragma unroll
            for (int j = 0; j < 4; ++j) hq[q][j] = __builtin_nontemporal_load(hr + 64 * j);
#pragma unroll
            for (int k = 0; k < 4; ++k) { const unsigned* yr = (const unsigned*)(YB8 + (size_t)rws[q][k] * D) + lane;
#pragma unroll
                for (int j = 0; j < 4; ++j) yq[q][k][j] = yr[64 * j]; } }
        f32x4 gc[TPI];
#pragma unroll
        for (int q = 0; q < TPI; ++q) gc[q] = gts[q];
        const int tn = t0 + NGW * TPI;
        if (tn < T) {
#pragma unroll
            for (int q = 0; q < TPI; ++q) { rws[q] = *(const i32x4*)(ASG_ROW + 4 * (tn + q)); gts[q] = *(const f32x4*)(ASG_G + 4 * (tn + q)); } }
#pragma unroll
        for (int q = 0; q < TPI; ++q) { f32x4 v[4]; float s = 0.f;
#pragma unroll
            for (int j = 0; j < 4; ++j) { v[j].x = bflo(hq[q][j].x); v[j].y = bfhi(hq[q][j].x); v[j].z = bflo(hq[q][j].y); v[j].w = bfhi(hq[q][j].y);
#pragma unroll
                for (int k = 0; k < 4; ++k) { const float gk = gc[q][k]; const int y = (int)yq[q][k][j]; const f32x2 lo = __builtin_amdgcn_cvt_pk_f32_fp8(y, false), hi = __builtin_amdgcn_cvt_pk_f32_fp8(y, true);
                    v[j].x += gk * lo.x; v[j].y += gk * lo.y; v[j].z += gk * hi.x; v[j].w += gk * hi.y; }
                s += (v[j].x * v[j].x + v[j].y * v[j].y) + (v[j].z * v[j].z + v[j].w * v[j].w); }
            const float rstd = 1.f / sqrtf(wave_sum(s) * (1.f / D) + RMS_EPS);
            f32x4* orow = (f32x4*)(P.out + (size_t)(t0 + q) * D) + lane;
#pragma unroll
            for (int j = 0; j < 4; ++j) { f32x4 ov = v[j] * rstd * lw[j];
#if STAMP_PHASE >= 0 && STAMP_PHASE < 12
                if (t0 + q == 0 && lane == 0 && j == 0) { const unsigned long long* st = (const unsigned long long*)(P.ws + WS_CTL + 65536); ov.x += (float)(st[STAMP_PHASE + 1] - st[STAMP_PHASE]) * 0.0005f; }
#endif
                __builtin_nontemporal_store(ov, orow + 64 * j); } }
    }
#endif
}

constexpr int N_PHASES = 12;
struct Args { const float* in[17]; float* out; unsigned char* ws; int ph_lo, ph_hi; };
__global__ void __launch_bounds__(512, 2) fwd(Args args) {
    extern __shared__ __attribute__((aligned(16))) unsigned char lds_raw[];
    LAS unsigned char* lds = (LAS unsigned char*)lds_raw;
    const int tid = threadIdx.x, G = gridDim.x; const int bx = blockIdx.x; const int vcu = (G % 8 == 0) ? (bx % 8) * (G / 8) + bx / 8 : bx;
#if STAMP_PHASE == 14
    const unsigned long long t_entry_ = wall_clock64();
#endif
    Ptrs P;
    P.x = args.in[0]; P.ln1 = args.in[1]; P.w_in = args.in[2]; P.w_gk2 = args.in[3]; P.b_gk2 = args.in[4]; P.gnorm = args.in[5]; P.wpa = args.in[6]; P.wpb = args.in[7]; P.wout = args.in[8];
    P.ln2 = args.in[9]; P.wr = args.in[10]; P.br = args.in[11]; P.wup = args.in[12]; P.bup = args.in[13]; P.wdn = args.in[14]; P.bdn = args.in[15]; P.lnf = args.in[16];
    P.out = args.out; P.ws = args.ws; P.ctl = (gu32*)(args.ws + WS_CTL);
    volatile LAS unsigned* MISC = (volatile LAS unsigned*)(lds + MISC_OFF);
    for (int u = tid; u < (LDS_BYTES - MISC_OFF) / 4; u += 512) ((LAS unsigned*)(lds + MISC_OFF))[u] = 0u;
    __syncthreads();
    XcdBarrier bar; bar.bar = (unsigned*)(P.ctl + CW_BAR); bar.x = 0; bar.st = nullptr;
    if (MK_N_LAUNCHES == 1) bar = xcd_barrier_post((unsigned*)(P.ctl + CW_BAR), MISC + 8);
    const int lo = args.ph_lo, hi = args.ph_hi;
#ifndef PH_MASK
#define PH_MASK 0xFFF
#endif
#define IN(k) (((PH_MASK >> (k)) & 1) && lo <= (k) && (k) < hi)
#define SEAM(k) do { if (IN(k) && IN((k) + 1)) xcd_barrier(bar); } while (0)
#define STAMP(k) do { if (STAMP_PHASE >= 0 && bx == 0 && tid == 0) ((unsigned long long*)(P.ws + WS_CTL + 65536))[k] = wall_clock64(); } while (0)
#define DUP(k, ...) do { __VA_ARGS__; if ((DUP_MASK >> (k)) & 1) { __syncthreads(); __VA_ARGS__; } } while (0)
    bf16* PROJ = (bf16*)(P.ws + WS_PROJ); bf16* XN = (bf16*)(P.ws + WS_XN); bf16* MIXED = XN;

    STAMP(0);
#if STAMP_PHASE == 13
    if (bx == 0) { if (tid == 0) { unsigned long long t0_ = wall_clock64(); while (wall_clock64() - t0_ < 50000ull) __builtin_amdgcn_s_sleep(8); } __syncthreads(); }
#endif
    if (IN(0)) { DUP(0, p0_prologue(P, lds, vcu, G, tid)); } SEAM(0);
#if BRINGUP == 0
    STAMP(1);
    if (IN(1)) { pg8::Gemm g{XN, (const bf16*)(P.ws + WS_WIN), T, NP, D / 2, 0}; pg8::StaticOrder S; S.init(T, NP, G, bx);
        pg8::EpiProj<true> E{PROJ, P.b_gk2, (const float*)(P.ws + WS_SX), (const float*)(P.ws + WS_SWIN)};
        const int nq_items = (32 * 64 + 32 * 32 + G - 1) / G, rounds = (S.nwg + G - 1) / G, phs = bx & 1;
        const int nb_items = phs ? ((bx >> 3) % 4) : nq_items - ((bx >> 3) % 4);
        if (nb_items > 0) { p0_quant_all(P, lds, vcu, G, tid, 0, nb_items); __syncthreads(); }
        { int t_ = tid; asm volatile("" : "+v"(t_)); pg8::gemm_phase<pg8::EpiProj<true>, pg8::StaticOrder, 2>(lds, g, S, E, t_); }
        if (nb_items < nq_items) { __syncthreads(); p0_quant_all(P, lds, vcu, G, tid, nb_items, nq_items); }
    } SEAM(1);
    STAMP(2);
    if (IN(2)) { bf16* OG = (bf16*)((unsigned char*)P.out + OUT_OG); float* LSE = (float*)((unsigned char*)P.out + OUT_LSE);
        DUP(13, for (int u = bx; u < 256; u += G) gla_pass1(P, lds, u, tid)); __syncthreads();
        DUP(12, { AttPre apre; bool ahave = false; for (int u = vcu; u < 768; u += G) { attn_task(P.ws, OG, LSE, lds, u, tid, (u + G < 768) ? u + G : -1, apre, ahave); ahave = true; } }); } SEAM(2);
    STAMP(3);
    if (IN(3)) { gla_scan(P, vcu, G, tid); attn_merge(P, vcu, G, tid); } SEAM(3);
    STAMP(4);
    if (IN(4)) { DUP(4, for (int u = bx; u < 256; u += G) gla_pass2(P, lds, u, tid)); } SEAM(4);
    STAMP(5);
    if (IN(5)) { { pg8::Gemm g{(const bf16*)(P.ws + WS_OA), (const bf16*)(P.ws + WS_WPA), T, D, 512, 0}; pg8::StaticOrder S; S.init(T, D, G, bx); pg8::EpiGate<false> E{MIXED, (const unsigned char*)(PROJ + 64 * PLANE), (unsigned char*)P.out  }; pg8::gemm_phase(lds, g, S, E); }
                 { pg8::Gemm g{(const bf16*)(P.ws + WS_OB), (const bf16*)(P.ws + WS_WPB), T, D, D, 0}; pg8::StaticOrder S; S.init(T, D, G, bx); pg8::EpiGate<true> E{MIXED, (const unsigned char*)(PROJ + 64 * PLANE) + 1024, (unsigned char*)P.out}; pg8::gemm_phase(lds, g, S, E); } } SEAM(5);
    STAMP(6);
    if (IN(6)) { pg8::Gemm g{MIXED, (const bf16*)(P.ws + WS_WOUT), T, D, D, 0}; pg8::StaticOrder S; S.init(T, D, G, bx); pg8::EpiResBf16 E{P.x, (bf16*)(P.ws + WS_H1), (float*)(P.ws + WS_PS)}; pg8::gemm_phase(lds, g, S, E); } SEAM(6);
#elif BRINGUP == 2
    if (IN(6)) { for (size_t idx = (size_t)vcu * 512 + tid; idx < (size_t)T * D / 2; idx += (size_t)G * 512) ((unsigned*)(P.ws + WS_H1))[idx] = pk2(P.x[2 * idx], P.x[2 * idx + 1]); } SEAM(6);
#endif
#if BRINGUP != 1
    STAMP(7);
    if (IN(7)) { router_phase(P, lds, G, tid); } SEAM(7);
    STAMP(8);
    if (IN(8)) { moe_scatter(P, lds, vcu, G, tid); } SEAM(8);
    STAMP(9);
    if (IN(9)) { LAS int* ts = (LAS int*)(lds + TBL_OFF); moe_tables(P, ts, tid); LAS unsigned short* lt = (LAS unsigned short*)(lds + LT_OFF);
        pg8::MoeOrder S; S.init(ts[32] * 256, 2048, G, bx); S.ts = ts; moe_unit_tokens(P, S, lt, tid);
        pg8::Gemm g{(const bf16*)(P.ws + WS_HN), (const bf16*)(P.ws + WS_WUP), 0, 2048, D / 2, (size_t)2048 * 512, lt};
        pg8::EpiSwiGLU8 E{P.ws + WS_ACT, P.bup, (const float*)(P.ws + WS_SUP)}; DUP(9, pg8::gemm_phase<pg8::EpiSwiGLU8, pg8::MoeOrder, 1, true>(lds, g, S, E)); } SEAM(9);
    STAMP(10);
    if (IN(10)) { LAS int* ts = (LAS int*)(lds + TBL_OFF); moe_tables(P, ts, tid);
        pg8::Gemm g{(const bf16*)(P.ws + WS_ACT), (const bf16*)(P.ws + WS_WDN), 0, D, D / 2, (size_t)1024 * 512, nullptr}; pg8::MoeOrder S; S.init(ts[32] * 256, D, G, bx); S.ts = ts;
        pg8::EpiDown8 E{P.ws + WS_YB, P.bdn, (const float*)(P.ws + WS_SDN)}; DUP(10, pg8::gemm_phase<pg8::EpiDown8, pg8::MoeOrder, 1, false>(lds, g, S, E)); } SEAM(10);
#endif
    STAMP(11);
    if (IN(11)) { DUP(11, final_phase(P, vcu, G, tid));
#if STAMP_PHASE == 14
        asm volatile("s_waitcnt vmcnt(0)" ::: "memory");
        { unsigned long long* st = (unsigned long long*)(P.ws + WS_CTL + 65536 + 512);
          if (tid == 0) { atomicMax(st + 0, ~t_entry_); atomicMax(st + 1, wall_clock64()); }
          __syncthreads(); xcd_barrier(bar);
          if (bx == 0 && tid == 0) { unsigned long long a = __hip_atomic_load(st + 0, __ATOMIC_RELAXED, __HIP_MEMORY_SCOPE_AGENT), b = __hip_atomic_load(st + 1, __ATOMIC_RELAXED, __HIP_MEMORY_SCOPE_AGENT);
            P.out[0] += ((float)(b - ~a) * 0.01f - 1300.0f) * 0.02f; } }
#endif
#if STAMP_PHASE == 15
        if (bx == 0 && tid == 0) { unsigned long long t0_ = wall_clock64(); while (wall_clock64() - t0_ < 50000ull) __builtin_amdgcn_s_sleep(8); }
#endif
#if STAMP_PHASE == 12
        asm volatile("s_waitcnt vmcnt(0)" ::: "memory");
        if (bx == 0 && tid == 0) { const unsigned long long* st = (const unsigned long long*)(P.ws + WS_CTL + 65536); P.out[0] += ((float)(wall_clock64() - st[0]) * 0.01f - 1300.0f) * 0.02f; }
#endif
    }
#undef IN
#undef SEAM
}

extern "C" void kernel_launch(void* const* d_in, const int* in_sizes, int n_in, void* d_out, int out_size, void* d_ws, size_t ws_size, hipStream_t stream) {
    static int grid = 0;
    if (grid == 0) {
        if (n_in != 17 || out_size != T * D || ws_size < WS_END) { fprintf(stderr, "kernel_launch: unexpected shapes (n_in %d out %d ws %zu, need %zu)\n", n_in, out_size, ws_size, (size_t)WS_END); grid = -1; return; }
        int dev = 0, cus = 0;
        if (hipGetDevice(&dev) != hipSuccess || hipDeviceGetAttribute(&cus, hipDeviceAttributeMultiprocessorCount, dev) != hipSuccess) { grid = -1; return; }
        if (hipFuncSetAttribute((const void*)fwd, hipFuncAttributeMaxDynamicSharedMemorySize, LDS_BYTES) != hipSuccess) { grid = -1; return; }
        int per_cu = 0; (void)hipOccupancyMaxActiveBlocksPerMultiprocessor(&per_cu, (const void*)fwd, 512, LDS_BYTES); (void)hipGetLastError();
        grid = cus;
    }
    if (grid < 0) return;
    (void)hipMemsetAsync((char*)d_ws + WS_CTL, 0, CTL_ZERO_BYTES, stream);
    Args a{};
    for (int i = 0; i < 17; ++i) a.in[i] = (const float*)d_in[i];
    a.out = (float*)d_out; a.ws = (unsigned char*)d_ws;
    if (MK_N_LAUNCHES == 1) { a.ph_lo = 0; a.ph_hi = N_PHASES; hipLaunchKernelGGL(fwd, dim3(grid), dim3(512), LDS_BYTES, stream, a); }
    else { for (int p = 0; p < N_PHASES; ++p) { a.ph_lo = p; a.ph_hi = p + 1; hipLaunchKernelGGL(fwd, dim3(grid), dim3(512), LDS_BYTES, stream, a); } }
}
```
